# Optimizing an MI355X kernel written in HIP

```python
import math
import jax, jax.numpy as jnp
from jax import lax
import numpy as np

D_MODEL = 2048
BATCH = 4
SEQ = 4096
DEPTH = 2
DEC_BATCH = 32
DEC_SEQ = 32
PAST_LEN = 4096

F32 = jnp.float32
EPS = 1e-6
CHUNK = 64
Q_BLOCK = 128
HEAD_DIM = 64
ROPE_DIM = HEAD_DIM // 4
ROPE_THETA = 500000.0
A_HEADS = D_MODEL // 4 // HEAD_DIM
A_KV_HEADS = 2
A_WIDTH = A_HEADS * HEAD_DIM
IDX_HEADS = 16
IDX_DIM = 64
TOPK_MAX = 256
B_HEADS = D_MODEL // 4 // HEAD_DIM
B_WIDTH = B_HEADS * HEAD_DIM
C_D_INNER = D_MODEL // 2
C_HEAD_DIM = 64
C_HEADS = C_D_INNER // C_HEAD_DIM
C_GROUPS = 4
D_STATE = 128
CONV_WIDTH = 4
C_CONV_DIM = C_D_INNER + 2 * C_GROUPS * D_STATE
SSD_CHUNK = CHUNK
MIX_WIDTH = A_WIDTH + B_WIDTH + C_D_INNER
D_FF = -(-8 * D_MODEL // (3 * 256)) * 256
IN_SIZES = (A_WIDTH, A_KV_HEADS * HEAD_DIM, A_KV_HEADS * HEAD_DIM,
            IDX_HEADS * IDX_DIM, IDX_DIM, IDX_HEADS,
            B_WIDTH, B_WIDTH, B_WIDTH,
            C_D_INNER, C_CONV_DIM, C_HEADS)
IN_COLS = sum(IN_SIZES)

kernel_name = 'hybrid_dsa_stickbreak_ssd_stream_step'


def split_cols(p):
    outs = []
    off = 0
    for n in IN_SIZES:
        outs.append(p[..., off:off + n])
        off += n
    return outs


def rms_norm(x, g):
    xf = x.astype(F32)
    y = xf * lax.rsqrt(jnp.mean(xf * xf, axis=-1, keepdims=True) + EPS)
    return (y * g.astype(F32)).astype(x.dtype)


def rope_tables(pos):
    inv = 1.0 / (ROPE_THETA ** (jnp.arange(0, ROPE_DIM, 2, dtype=F32) / ROPE_DIM))
    ang = pos.astype(F32)[:, None] * inv[None, :]
    return jnp.cos(ang), jnp.sin(ang)


def partial_rope(x, cos, sin):
    half = ROPE_DIM // 2
    x1 = x[..., :half].astype(F32)
    x2 = x[..., half:ROPE_DIM].astype(F32)
    c = cos[None, :, None, :]
    s = sin[None, :, None, :]
    rot = jnp.concatenate([x1 * c - x2 * s, x2 * c + x1 * s], axis=-1).astype(x.dtype)
    return jnp.concatenate([rot, x[..., ROPE_DIM:]], axis=-1)


def sweep_query_blocks(block_fn, q_args, qpos):
    b, t = q_args[0].shape[:2]
    nb = t // Q_BLOCK
    blocks = tuple(jnp.moveaxis(a.reshape((b, nb, Q_BLOCK) + a.shape[2:]), 1, 0) for a in q_args)
    out = lax.map(lambda xs: block_fn(*xs), blocks + (qpos.reshape(nb, Q_BLOCK),))
    return jnp.moveaxis(out, 0, 1).reshape(b, t, out.shape[-1])


def dsa_block(q, iq, iw, qpos, k, v, ik, kpos):
    b, tq = q.shape[:2]
    topk = min(TOPK_MAX, k.shape[1] // 4)
    admissible = (kpos[None, :] // CHUNK) <= (qpos[:, None] // CHUNK)
    idx_logits = jnp.einsum('bqhd,bsd->bhqs', iq, ik, preferred_element_type=F32) * (IDX_DIM ** -0.5)
    score = jnp.einsum('bhqs,bqh->bqs', jax.nn.relu(idx_logits), iw.astype(F32))
    score = jnp.where(admissible[None], score, -jnp.inf)
    top_val, top_idx = lax.top_k(score, topk)
    valid = jnp.isfinite(top_val)
    gather = jax.vmap(lambda arr, ix: arr[ix])
    k_sel = gather(k, top_idx)
    v_sel = gather(v, top_idx)
    qg = q.reshape(b, tq, A_KV_HEADS, A_HEADS // A_KV_HEADS, HEAD_DIM)
    s = jnp.einsum('bqngd,bqknd->bqngk', qg, k_sel, preferred_element_type=F32) * (HEAD_DIM ** -0.5)
    s = jnp.where(valid[:, :, None, None, :], s, -jnp.inf)
    p = jax.nn.softmax(s, axis=-1)
    o = jnp.einsum('bqngk,bqknd->bqngd', p.astype(v.dtype), v_sel)
    return o.reshape(b, tq, A_WIDTH)


def stick_breaking_block(q, qpos, k, v, kpos):
    b, tq = q.shape[:2]
    z = jnp.einsum('bqhd,bshd->bhqs', q, k, preferred_element_type=F32) * (HEAD_DIM ** -0.5)
    causal = (kpos[None, :] < qpos[:, None])[None, None]
    log_keep = jnp.where(causal, jax.nn.log_sigmoid(-z), 0.0)
    later = lax.cumsum(log_keep, axis=3, reverse=True) - log_keep
    a = jnp.where(causal, jnp.exp(jax.nn.log_sigmoid(z) + later), 0.0)
    o = jnp.einsum('bhqs,bshd->bqhd', a.astype(v.dtype), v)
    return o.reshape(b, tq, B_WIDTH)


def causal_conv(xbc, prev, w, bias):
    xpad = jnp.concatenate([prev.astype(xbc.dtype), xbc], axis=1)
    y = lax.conv_general_dilated(xpad, w[:, None, :].astype(xbc.dtype), window_strides=(1,),
                                 padding='VALID', dimension_numbers=('NWC', 'WIO', 'NWC'),
                                 feature_group_count=xbc.shape[-1])
    return y + bias.astype(xbc.dtype), xpad[:, -(CONV_WIDTH - 1):]


def ssd_scan(x, dt, a_neg, bm, cm, init_state, chunk):
    b, l, h, p = x.shape
    g, n = bm.shape[2], bm.shape[3]
    r = h // g
    nc = l // chunk
    xd = (x * dt[..., None]).reshape(b, nc, chunk, g, r, p)
    a_cum = jnp.cumsum((dt * a_neg).reshape(b, nc, chunk, g, r), axis=2)
    bm = bm.reshape(b, nc, chunk, g, n)
    cm = cm.reshape(b, nc, chunk, g, n)
    seg = a_cum[:, :, :, None] - a_cum[:, :, None, :]
    tril = jnp.tril(jnp.ones((chunk, chunk), bool))[None, None, :, :, None, None]
    decay = jnp.where(tril, jnp.exp(jnp.where(tril, seg, 0.0)), 0.0)
    cb = jnp.einsum('bctgn,bcsgn->bctsg', cm, bm)
    y_diag = jnp.einsum('bctsg,bctsgr,bcsgrp->bctgrp', cb, decay, xd)
    decay_to_end = jnp.exp(a_cum[:, :, -1:] - a_cum)
    chunk_states = jnp.einsum('bcsgn,bcsgr,bcsgrp->bcgrpn', bm, decay_to_end, xd)
    chunk_decay = jnp.exp(a_cum[:, :, -1])

    def step(state, inp):
        st, dec = inp
        return state * dec[..., None, None] + st, state

    final, entering = lax.scan(step, init_state.reshape(b, g, r, p, n),
                               (jnp.moveaxis(chunk_states, 1, 0), jnp.moveaxis(chunk_decay, 1, 0)))
    entering = jnp.moveaxis(entering, 0, 1)
    y_off = jnp.einsum('bctgn,bcgrpn,bctgr->bctgrp', cm, entering, jnp.exp(a_cum))
    return (y_diag + y_off).reshape(b, l, h, p), final.reshape(b, h, p, n)


def ssd_mixer(z, xbc, dt_raw, conv_prev, ssm_prev, conv_w, conv_b, dt_bias, a_log, d_skip, norm_g, chunk):
    b, t, _ = xbc.shape
    xc, conv_new = causal_conv(xbc, conv_prev, conv_w, conv_b)
    xc = jax.nn.silu(xc.astype(F32))
    xs = xc[..., :C_D_INNER].reshape(b, t, C_HEADS, C_HEAD_DIM)
    bm = xc[..., C_D_INNER:C_D_INNER + C_GROUPS * D_STATE].reshape(b, t, C_GROUPS, D_STATE)
    cm = xc[..., C_D_INNER + C_GROUPS * D_STATE:].reshape(b, t, C_GROUPS, D_STATE)
    dt = jax.nn.softplus(dt_raw.astype(F32) + dt_bias.astype(F32))
    a_neg = -jnp.exp(a_log.astype(F32))
    y, ssm_new = ssd_scan(xs, dt, a_neg, bm, cm, ssm_prev.astype(F32), chunk)
    y = y + xs * d_skip.astype(F32)[:, None]
    y = y.reshape(b, t, C_D_INNER) * jax.nn.silu(z.astype(F32))
    yg = y.reshape(b, t, C_GROUPS, C_D_INNER // C_GROUPS)
    yg = yg * lax.rsqrt(jnp.mean(yg * yg, axis=-1, keepdims=True) + EPS)
    y = yg.reshape(b, t, C_D_INNER) * norm_g.astype(F32)
    return y.astype(xbc.dtype), conv_new, ssm_new


def layer_forward(x, pos, past, lp, ssd_chunk):
    (norm1_g, w_in, a_q_norm_g, a_k_norm_g, idx_k_norm_g, b_q_norm_g, b_k_norm_g,
     c_conv_w, c_conv_b, c_dt_bias, c_a_log, c_d, c_norm_g, w_out, norm2_g,
     w_gate, w_up, w_down) = lp
    b, t, _ = x.shape
    h = rms_norm(x, norm1_g)
    (a_q, a_k, a_v, i_q, i_k, i_w, b_q, b_k, b_v, c_z, c_xbc, c_dt) = split_cols(h @ w_in)
    cos, sin = rope_tables(pos)
    aq = partial_rope(rms_norm(a_q.reshape(b, t, A_HEADS, HEAD_DIM), a_q_norm_g), cos, sin)
    ak = partial_rope(rms_norm(a_k.reshape(b, t, A_KV_HEADS, HEAD_DIM), a_k_norm_g), cos, sin)
    av = a_v.reshape(b, t, A_KV_HEADS, HEAD_DIM)
    iq = partial_rope(i_q.reshape(b, t, IDX_HEADS, IDX_DIM), cos, sin)
    ik = partial_rope(rms_norm(i_k, idx_k_norm_g)[:, :, None, :], cos, sin)[:, :, 0]
    iw = i_w.astype(F32) * (IDX_HEADS ** -0.5)
    bq = rms_norm(b_q.reshape(b, t, B_HEADS, HEAD_DIM), b_q_norm_g)
    bk = rms_norm(b_k.reshape(b, t, B_HEADS, HEAD_DIM), b_k_norm_g)
    bv = b_v.reshape(b, t, B_HEADS, HEAD_DIM)
    if past is None:
        kpos = pos
        ka, va, ika, kb, vb = ak, av, ik, bk, bv
        conv_prev = jnp.zeros((b, CONV_WIDTH - 1, C_CONV_DIM), x.dtype)
        ssm_prev = jnp.zeros((b, C_HEADS, C_HEAD_DIM, D_STATE), F32)
        y_a = sweep_query_blocks(lambda q_, iq_, iw_, qp: dsa_block(q_, iq_, iw_, qp, ka, va, ika, kpos),
                                 (aq, iq, iw), pos)
        y_b = sweep_query_blocks(lambda q_, qp: stick_breaking_block(q_, qp, kb, vb, kpos), (bq,), pos)
    else:
        (pk_a, pv_a, pik, pk_b, pv_b, ssm_prev, conv_prev) = past
        kpos = jnp.arange(pk_a.shape[1] + t, dtype=jnp.int32)
        ka = jnp.concatenate([pk_a.astype(x.dtype), ak], axis=1)
        va = jnp.concatenate([pv_a.astype(x.dtype), av], axis=1)
        ika = jnp.concatenate([pik.astype(x.dtype), ik], axis=1)
        kb = jnp.concatenate([pk_b.astype(x.dtype), bk], axis=1)
        vb = jnp.concatenate([pv_b.astype(x.dtype), bv], axis=1)
        y_a = dsa_block(aq, iq, iw, pos, ka, va, ika, kpos)
        y_b = stick_breaking_block(bq, pos, kb, vb, kpos)
    y_c, conv_new, ssm_new = ssd_mixer(c_z, c_xbc, c_dt, conv_prev, ssm_prev, c_conv_w, c_conv_b,
                                       c_dt_bias, c_a_log, c_d, c_norm_g, ssd_chunk)
    x = x + jnp.concatenate([y_a, y_b, y_c], axis=-1) @ w_out
    h2 = rms_norm(x, norm2_g)
    x = x + (jax.nn.silu(h2 @ w_gate) * (h2 @ w_up)) @ w_down
    return x, (ak, av, ik, bk, bv, ssm_new.astype(x.dtype), conv_new)


def setup_inputs(seed: int = 0) -> dict:
    key = jax.random.key(seed)
    ks = jax.random.split(key, 32)

    def nrm(k, shape, scale):
        return jax.random.normal(k, shape, F32) * scale

    def gain(k, shape):
        return 1.0 + 0.02 * jax.random.normal(k, shape, F32)

    dt0 = jnp.exp(jax.random.uniform(ks[20], (DEPTH, C_HEADS), F32,
                                     minval=math.log(1e-3), maxval=math.log(1e-1)))
    return {
        'x_prompt': nrm(ks[0], (BATCH, SEQ, D_MODEL), 1.0),
        'x_sample': nrm(ks[1], (DEC_BATCH, DEC_SEQ, D_MODEL), 1.0),
        'cache_a_k': nrm(ks[2], (DEPTH, DEC_BATCH, PAST_LEN, A_KV_HEADS, HEAD_DIM), 1.0),
        'cache_a_v': nrm(ks[3], (DEPTH, DEC_BATCH, PAST_LEN, A_KV_HEADS, HEAD_DIM), 1.0),
        'cache_a_idx_k': nrm(ks[4], (DEPTH, DEC_BATCH, PAST_LEN, IDX_DIM), 1.0),
        'cache_b_k': nrm(ks[5], (DEPTH, DEC_BATCH, PAST_LEN, B_HEADS, HEAD_DIM), 1.0),
        'cache_b_v': nrm(ks[6], (DEPTH, DEC_BATCH, PAST_LEN, B_HEADS, HEAD_DIM), 1.0),
        'state_c_ssm': nrm(ks[7], (DEPTH, DEC_BATCH, C_HEADS, C_HEAD_DIM, D_STATE), 0.5),
        'state_c_conv': nrm(ks[8], (DEPTH, DEC_BATCH, CONV_WIDTH - 1, C_CONV_DIM), 1.0),
        'norm1_g': gain(ks[9], (DEPTH, D_MODEL)),
        'w_in': nrm(ks[10], (DEPTH, D_MODEL, IN_COLS), D_MODEL ** -0.5),
        'a_q_norm_g': gain(ks[11], (DEPTH, HEAD_DIM)),
        'a_k_norm_g': gain(ks[12], (DEPTH, HEAD_DIM)),
        'idx_k_norm_g': gain(ks[13], (DEPTH, IDX_DIM)),
        'b_q_norm_g': gain(ks[14], (DEPTH, HEAD_DIM)),
        'b_k_norm_g': gain(ks[15], (DEPTH, HEAD_DIM)),
        'c_conv_w': nrm(ks[16], (DEPTH, CONV_WIDTH, C_CONV_DIM), CONV_WIDTH ** -0.5),
        'c_conv_b': nrm(ks[17], (DEPTH, C_CONV_DIM), 0.01),
        'c_dt_bias': dt0 + jnp.log(-jnp.expm1(-dt0)),
        'c_a_log': jnp.log(jax.random.uniform(ks[18], (DEPTH, C_HEADS), F32, minval=1.0, maxval=16.0)),
        'c_d': 1.0 + 0.1 * jax.random.normal(ks[19], (DEPTH, C_HEADS), F32),
        'c_norm_g': gain(ks[21], (DEPTH, C_D_INNER)),
        'w_out': nrm(ks[22], (DEPTH, MIX_WIDTH, D_MODEL), MIX_WIDTH ** -0.5),
        'norm2_g': gain(ks[23], (DEPTH, D_MODEL)),
        'w_gate': nrm(ks[24], (DEPTH, D_MODEL, D_FF), D_MODEL ** -0.5),
        'w_up': nrm(ks[25], (DEPTH, D_MODEL, D_FF), D_MODEL ** -0.5),
        'w_down': nrm(ks[26], (DEPTH, D_FF, D_MODEL), D_FF ** -0.5),
    }


def reference(x_prompt, x_sample, cache_a_k, cache_a_v, cache_a_idx_k, cache_b_k, cache_b_v,
              state_c_ssm, state_c_conv, norm1_g, w_in, a_q_norm_g, a_k_norm_g, idx_k_norm_g,
              b_q_norm_g, b_k_norm_g, c_conv_w, c_conv_b, c_dt_bias, c_a_log, c_d, c_norm_g,
              w_out, norm2_g, w_gate, w_up, w_down):
    seq_p = x_prompt.shape[1]
    seq_s = x_sample.shape[1]
    past_len = cache_a_k.shape[2]
    pos_p = jnp.arange(seq_p, dtype=jnp.int32)
    pos_s = past_len + jnp.arange(seq_s, dtype=jnp.int32)
    yp = x_prompt
    ys = x_sample
    p_states = []
    s_states = []
    for l in range(DEPTH):
        lp = (norm1_g[l], w_in[l], a_q_norm_g[l], a_k_norm_g[l], idx_k_norm_g[l], b_q_norm_g[l],
              b_k_norm_g[l], c_conv_w[l], c_conv_b[l], c_dt_bias[l], c_a_log[l], c_d[l], c_norm_g[l],
              w_out[l], norm2_g[l], w_gate[l], w_up[l], w_down[l])
        yp, st_p = layer_forward(yp, pos_p, None, lp, min(SSD_CHUNK, seq_p))
        past = (cache_a_k[l], cache_a_v[l], cache_a_idx_k[l], cache_b_k[l], cache_b_v[l],
                state_c_ssm[l], state_c_conv[l])
        ys, st_s = layer_forward(ys, pos_s, past, lp, seq_s)
        p_states.append(st_p)
        s_states.append(st_s)
    (p_a_k, p_a_v, p_a_idx_k, p_b_k, p_b_v, p_c_ssm, p_c_conv) = [jnp.stack(z) for z in zip(*p_states)]
    (s_a_k, s_a_v, s_a_idx_k, s_b_k, s_b_v, s_c_ssm, s_c_conv) = [jnp.stack(z) for z in zip(*s_states)]
    return (yp, ys, p_a_k, p_a_v, p_a_idx_k, p_b_k, p_b_v, p_c_ssm, p_c_conv,
            s_a_k, s_a_v, s_a_idx_k, s_b_k, s_b_v, s_c_ssm, s_c_conv)
```

```cpp
#ifndef HOST_EMU
#include <hip/hip_runtime.h>
#endif
#include <cstdio>
#include <cstdint>
#include <cmath>

#ifndef CFG_BATCH
#define CFG_BATCH 4
#endif
#ifndef CFG_SEQ
#define CFG_SEQ 4096
#endif
#ifndef CFG_DEC_BATCH
#define CFG_DEC_BATCH 32
#endif
#ifndef CFG_PAST
#define CFG_PAST 4096
#endif
#ifndef CFG_DFF
#define CFG_DFF 5632
#endif
#ifndef ONE_LAUNCH
#define ONE_LAUNCH 1
#endif

#ifdef HOST_EMU
#define LAS
#define GAS
#define DYN_LDS(name) unsigned char* name = emu::B->lds
#define WAVE_SYNC() emu::wave_barrier()
#define MFMA32(a, b, c) emu_mfma32(a, b, c)
#define FAST_EXP2(x) exp2f(x)
#define FAST_LOG2(x) log2f(x)
#define FAST_RCP(x) (1.0f / (x))
#define FAST_RSQ(x) (1.0f / sqrtf(x))
#define MFMA16(a, b, c) emu_mfma16(a, b, c)
#else
#define LAS __attribute__((address_space(3)))
#define GAS __attribute__((address_space(1)))
#define DYN_LDS(name) extern __shared__ __attribute__((aligned(16))) unsigned char name[]
#define WAVE_SYNC() do { asm volatile("s_waitcnt lgkmcnt(0)" ::: "memory"); __builtin_amdgcn_wave_barrier(); } while (0)
#define MFMA32(a, b, c) __builtin_amdgcn_mfma_f32_32x32x16_bf16(a, b, c, 0, 0, 0)
#define FAST_EXP2(x) __builtin_amdgcn_exp2f(x)
#define FAST_LOG2(x) __builtin_amdgcn_logf(x)
#define FAST_RCP(x) __builtin_amdgcn_rcpf(x)
#define FAST_RSQ(x) __builtin_amdgcn_rsqf(x)
#define MFMA16(a, b, c) __builtin_amdgcn_mfma_f32_16x16x32_bf16(a, b, c, 0, 0, 0)
#endif
namespace pg8 {
#define PG8_LAS __attribute__((address_space(3)))
typedef unsigned short bf16_t;
typedef short bf16x8 __attribute__((ext_vector_type(8)));
typedef float f32x4 __attribute__((ext_vector_type(4)));
typedef unsigned u32x4 __attribute__((ext_vector_type(4)));
constexpr int BM = 256, BK = 64, HALF = 128, HTB = HALF * BK * 2  , STAGE_BYTES = 8 * HTB, NXCD = 8, WGM = 8;

__host__ __device__ __forceinline__ int lds_byte(int r, int c) { const int st = (r >> 4) * 2 + (c >> 5), rr = r & 15, cc = c & 31, ob = rr * 64 + cc * 2; return st * 1024 + (ob ^ (((ob >> 9) & 1) << 5)); }
__host__ __device__ __forceinline__ void stage_rc(int b, int& R, int& C) { const int st = b / 1024, sb = b % 1024, swz = sb ^ (((sb >> 9) & 1) << 5); R = (st >> 1) * 16 + swz / 64; C = (st & 1) * 32 + (swz % 64) / 2; }
__host__ __device__ __forceinline__ int perm32(int rho) { const int n = rho >> 4, i = rho & 15; return 8 * (i >> 2) + 4 * n + (i & 3); }

struct Unit { int pm, pn, kofs; };
struct Gemm { const bf16_t* A; const bf16_t* Bt; int M, N, K, Klen; };

struct StaticOrder {
    int nM, nN, nwg, G, c;
    __host__ __device__ void init(int M, int N, int G_, int c_) { nM = M / BM; nN = N / BM; nwg = nM * nN; G = G_; c = c_; }
    __host__ __device__ bool next(int i, Unit& u) const {
        const long L = (long)i * G + c; if (L >= nwg) return false;
        int wgid = (int)L; { const int q = nwg / NXCD, r = nwg % NXCD, xcd = wgid % NXCD, off = wgid / NXCD; wgid = (xcd < r ? xcd * (q + 1) : r * (q + 1) + (xcd - r) * q) + off; }
        const int nig = WGM * nN, gid = wgid / nig, fm = gid * WGM, gsz = (nM - fm) < WGM ? (nM - fm) : WGM;
        u.pm = fm + ((wgid % nig) % gsz); u.pn = (wgid % nig) / gsz; u.kofs = 0; return true;
    }
    __device__ __forceinline__ void a_ready(const Unit&) const {}
    __device__ __forceinline__ void done(const Unit&) const {}
};

struct TailOrder {
    int pm0, nN, ntile, nsl, klen_bytes, G, c;
    __host__ __device__ void init(int pm0_, int nM_, int N, int nsl_, int Klen, int G_, int c_) { pm0 = pm0_; nN = N / BM; ntile = nM_ * nN; nsl = nsl_; klen_bytes = Klen * 2; G = G_; c = c_; }
    __host__ __device__ bool next(int i, Unit& u) const {
        const long L = (long)i * G + c; if (L >= (long)ntile * nsl) return false;
        const int tile = (int)(L / nsl), sl = (int)(L % nsl); u.pm = pm0 + tile / nN; u.pn = tile % nN; u.kofs = sl * klen_bytes; return true;
    }
    __device__ __forceinline__ void a_ready(const Unit&) const {}
    __device__ __forceinline__ void done(const Unit&) const {}
};

#ifdef HOST_EMU
__device__ __forceinline__ unsigned cvt_pk_bf16(float lo, float hi) {
    auto f2b = [](float f) { unsigned u = __builtin_bit_cast(unsigned, f); return (u + 0x7fffu + ((u >> 16) & 1u)) >> 16; };
    return f2b(lo) | (f2b(hi) << 16);
}
#else
__device__ __forceinline__ unsigned cvt_pk_bf16(float lo, float hi) { unsigned r; asm volatile("v_cvt_pk_bf16_f32 %0, %1, %2" : "=v"(r) : "v"(lo), "v"(hi)); return r; }
#endif
typedef unsigned u32x4 __attribute__((ext_vector_type(4)));
#ifndef HOST_EMU
template <class Epi, class Sched, bool ALIGN_EPI = false, bool SP2 = false>
__device__ __forceinline__ void gemm_phase(PG8_LAS unsigned char* lds, const Gemm g, const Sched& S, const Epi& E) {
    int tid_l = threadIdx.x; asm volatile("" : "+v"(tid_l));
    const int tid = tid_l, wid = __builtin_amdgcn_readfirstlane(tid >> 6), lane = tid & 63, wr = wid >> 2, wc = wid & 3, fr = lane & 15, fq = lane >> 4;
    const int K = g.K, nt = g.Klen / BK;
    unsigned voffA[2], voffB[2];
#pragma unroll
    for (int i = 0; i < 2; ++i) { int R, C; stage_rc(tid * 16 + i * 8192, R, C); const int Rb = Epi::PERM ? ((R & ~31) + perm32(R & 31)) : R;
        voffA[i] = (unsigned)(R * K + C) * 2u; voffB[i] = (unsigned)(Rb * K + C) * 2u; }
    const size_t kstep = (size_t)(BK * 2);
    const size_t hstep = (size_t)HALF * K * 2;
    const size_t tstep = 2 * hstep;
    const unsigned ldsw = (unsigned)wid * 1024u;
    const int aoff = lds_byte(wr * 64 + fr, fq * 8), boff = lds_byte(wc * 32 + fr, fq * 8);
#define PG8_SA(b, h) (((b) * 2 + (h)) * HTB)
#define PG8_SB(b, h) ((4 + (b) * 2 + (h)) * HTB)
#define PG8_STAGE(bufoff, gbase, voff) do { _Pragma("unroll") for (int _i = 0; _i < 2; ++_i) \
        __builtin_amdgcn_global_load_lds((const unsigned*)((const char*)(gbase) + (voff)[_i]), (PG8_LAS unsigned*)(lds + (bufoff) + ldsw + _i * 8192), 16, 0, 0); } while (0)
#define PG8_LDA(dst, b, h) do { _Pragma("unroll") for (int m = 0; m < 4; ++m) _Pragma("unroll") for (int k = 0; k < 2; ++k) dst[m][k] = *(const PG8_LAS bf16x8*)(lds + PG8_SA(b, h) + aoff + m * 2048 + k * 1024); } while (0)
#define PG8_LDB(dst, b, h) do { _Pragma("unroll") for (int n = 0; n < 2; ++n) _Pragma("unroll") for (int k = 0; k < 2; ++k) dst[n][k] = *(const PG8_LAS bf16x8*)(lds + PG8_SB(b, h) + boff + n * 2048 + k * 1024); } while (0)
#define PG8_MMA(ai, bj, At, Bt) do { __builtin_amdgcn_s_setprio(1); _Pragma("unroll") for (int m = 0; m < 4; ++m) _Pragma("unroll") for (int n = 0; n < 2; ++n) _Pragma("unroll") for (int k = 0; k < 2; ++k) \
        acc[ai][bj][m][n] = __builtin_amdgcn_mfma_f32_16x16x32_bf16(Bt[n][k], At[m][k], acc[ai][bj][m][n], 0, 0, 0); __builtin_amdgcn_s_setprio(0); } while (0)
#define PG8_WAIT_V(n) asm volatile("s_waitcnt vmcnt(" #n ")" ::: "memory")
#define PG8_WAIT_L(n) asm volatile("s_waitcnt lgkmcnt(" #n ")" ::: "memory")
#define PG8_BAR __builtin_amdgcn_s_barrier()
#define PG8_SCHED __builtin_amdgcn_sched_barrier(0)
    Unit cur, nxt; int ui = 0;
    if (!S.next(0, cur)) return;
    f32x4 acc[2][2][4][2];
#pragma unroll
    for (int a = 0; a < 2; ++a)
#pragma unroll
        for (int b = 0; b < 2; ++b)
#pragma unroll
            for (int m = 0; m < 4; ++m)
#pragma unroll
                for (int n = 0; n < 2; ++n) acc[a][b][m][n] = (f32x4){0.f, 0.f, 0.f, 0.f};
    bf16x8 At[4][2], B0[2][2], B1[2][2];
    const char* cA = (const char*)g.A + (size_t)cur.pm * tstep + cur.kofs; const char* cB = (const char*)g.Bt + (size_t)cur.pn * tstep + cur.kofs;
    S.a_ready(cur);
    if constexpr (SP2) {
        PG8_STAGE(PG8_SB(0, 0), cB, voffB); PG8_STAGE(PG8_SB(0, 1), cB + hstep, voffB); PG8_STAGE(PG8_SA(0, 0), cA, voffA); PG8_STAGE(PG8_SA(0, 1), cA + hstep, voffA);
        if (wr == 1) PG8_BAR;
        PG8_WAIT_V(2); PG8_BAR;
        PG8_STAGE(PG8_SB(1, 0), cB + kstep, voffB); PG8_STAGE(PG8_SA(1, 0), cA + kstep, voffA); PG8_STAGE(PG8_SB(1, 1), cB + hstep + kstep, voffB);
        PG8_WAIT_V(6); PG8_BAR;
    } else {
        PG8_STAGE(PG8_SB(0, 0), cB, voffB); PG8_STAGE(PG8_SA(0, 0), cA, voffA); PG8_STAGE(PG8_SB(0, 1), cB + hstep, voffB); PG8_STAGE(PG8_SA(0, 1), cA + hstep, voffA);
        if (wr == 1) PG8_BAR;
        PG8_WAIT_V(4); PG8_BAR;
        PG8_STAGE(PG8_SB(1, 0), cB + kstep, voffB); PG8_STAGE(PG8_SA(1, 0), cA + kstep, voffA); PG8_STAGE(PG8_SB(1, 1), cB + hstep + kstep, voffB);
        PG8_WAIT_V(6); PG8_BAR;
    }
    for (;;) {
        const bool has_next = S.next(ui + 1, nxt);
        const char* nA = has_next ? (const char*)g.A + (size_t)nxt.pm * tstep + nxt.kofs : cA; const char* nB = has_next ? (const char*)g.Bt + (size_t)nxt.pn * tstep + nxt.kofs : cB;
        for (int t = 0; t < nt; t += 2) {
            const bool last = (t == nt - 2);
            const char* a1 = cA + (size_t)(t + 1) * kstep;
            const char* a2 = last ? nA : cA + (size_t)(t + 2) * kstep; const char* b2 = last ? nB : cB + (size_t)(t + 2) * kstep;
            const char* a3 = a2 + kstep; const char* b3 = b2 + kstep;
            if (last && has_next) S.a_ready(nxt);
            if constexpr (SP2) {
            PG8_LDB(B0, 0, 0); PG8_LDB(B1, 0, 1); PG8_SCHED; PG8_LDA(At, 0, 0); PG8_STAGE(PG8_SA(1, 1), a1 + hstep, voffA);
            PG8_WAIT_V(8); PG8_WAIT_L(0); PG8_BAR; PG8_MMA(0, 0, At, B0); PG8_MMA(0, 1, At, B1); PG8_BAR; PG8_SCHED;
            PG8_LDA(At, 0, 1); PG8_STAGE(PG8_SB(0, 0), b2, voffB); PG8_STAGE(PG8_SB(0, 1), b2 + hstep, voffB); PG8_STAGE(PG8_SA(0, 0), a2, voffA);
            PG8_WAIT_V(8); PG8_WAIT_L(0); PG8_BAR; PG8_MMA(1, 0, At, B0); PG8_MMA(1, 1, At, B1); PG8_BAR; PG8_SCHED;
            PG8_LDB(B0, 1, 0); PG8_LDB(B1, 1, 1); PG8_SCHED; PG8_LDA(At, 1, 0); PG8_STAGE(PG8_SA(0, 1), a2 + hstep, voffA);
            PG8_WAIT_V(8); PG8_WAIT_L(0); PG8_BAR; PG8_MMA(0, 0, At, B0); PG8_MMA(0, 1, At, B1); PG8_BAR; PG8_SCHED;
            PG8_LDA(At, 1, 1); PG8_STAGE(PG8_SB(1, 0), b3, voffB); PG8_STAGE(PG8_SB(1, 1), b3 + hstep, voffB); PG8_STAGE(PG8_SA(1, 0), a3, voffA);
            PG8_WAIT_V(8); PG8_WAIT_L(0); PG8_BAR; PG8_MMA(1, 0, At, B0); PG8_MMA(1, 1, At, B1); PG8_BAR; PG8_SCHED;
            } else {
            PG8_LDB(B0, 0, 0); PG8_SCHED; PG8_LDA(At, 0, 0); PG8_STAGE(PG8_SA(1, 1), a1 + hstep, voffA);
            PG8_WAIT_L(8); PG8_BAR; PG8_WAIT_L(0); PG8_MMA(0, 0, At, B0); PG8_BAR; PG8_SCHED;
            PG8_LDB(B1, 0, 1); PG8_STAGE(PG8_SB(0, 0), b2, voffB);
            PG8_BAR; PG8_WAIT_L(0); PG8_MMA(0, 1, At, B1); PG8_BAR;
            PG8_LDA(At, 0, 1); PG8_STAGE(PG8_SA(0, 0), a2, voffA);
            PG8_BAR; PG8_WAIT_L(0); PG8_MMA(1, 0, At, B0); PG8_BAR; PG8_SCHED;
            PG8_STAGE(PG8_SB(0, 1), b2 + hstep, voffB);
            PG8_WAIT_V(6); PG8_BAR; PG8_MMA(1, 1, At, B1); PG8_BAR;
            PG8_LDB(B0, 1, 0); PG8_SCHED; PG8_LDA(At, 1, 0); PG8_STAGE(PG8_SA(0, 1), a2 + hstep, voffA);
            PG8_WAIT_L(8); PG8_BAR; PG8_WAIT_L(0); PG8_MMA(0, 0, At, B0); PG8_BAR; PG8_SCHED;
            PG8_LDB(B1, 1, 1); PG8_STAGE(PG8_SB(1, 0), b3, voffB);
            PG8_BAR; PG8_WAIT_L(0); PG8_MMA(0, 1, At, B1); PG8_BAR;
            PG8_LDA(At, 1, 1); PG8_STAGE(PG8_SA(1, 0), a3, voffA);
            PG8_BAR; PG8_WAIT_L(0); PG8_MMA(1, 0, At, B0); PG8_BAR; PG8_SCHED;
            PG8_STAGE(PG8_SB(1, 1), b3 + hstep, voffB);
            PG8_WAIT_V(6); PG8_BAR; PG8_MMA(1, 1, At, B1); PG8_BAR;
            }
        }
        if constexpr (ALIGN_EPI) { if (wr == 0) PG8_BAR; }
        if constexpr (!Epi::AFTER_DRAIN) { int fr_e = fr, fq_e = fq; asm volatile("" : "+v"(fr_e), "+v"(fq_e));
            E(acc, cur, wr, wc, fr_e, fq_e); S.done(cur); }
        if (!has_next) break;
#pragma unroll
        for (int a = 0; a < 2; ++a)
#pragma unroll
            for (int b = 0; b < 2; ++b)
#pragma unroll
                for (int m = 0; m < 4; ++m)
#pragma unroll
                    for (int n = 0; n < 2; ++n) acc[a][b][m][n] = (f32x4){0.f, 0.f, 0.f, 0.f};
        cur = nxt; cA = nA; cB = nB; ++ui;
        if constexpr (ALIGN_EPI) { if (wr == 1) PG8_BAR; }
    }
    PG8_WAIT_V(0);
    if constexpr (!ALIGN_EPI) { if (wr == 0) PG8_BAR; }
    PG8_BAR;
    if constexpr (Epi::AFTER_DRAIN) { E.fused(acc, cur, wr, wc, fr, fq, lds, wid, lane); S.done(cur); }
#undef PG8_SA
#undef PG8_SB
#undef PG8_STAGE
#undef PG8_LDA
#undef PG8_LDB
#undef PG8_MMA
#undef PG8_WAIT_V
#undef PG8_WAIT_L
#undef PG8_BAR
#undef PG8_SCHED
}
#else
template <class Epi, class Sched, bool ALIGN_EPI = false, bool SP2 = false>
inline void gemm_phase(unsigned char* lds, const Gemm g, const Sched& S, const Epi& E) {
    (void)lds;
    static thread_local float* pa = nullptr; static thread_local float* pb = nullptr;
    const int tid = threadIdx.x, wid = tid >> 6, lane = tid & 63, wr = wid >> 2, wc = wid & 3, fr = lane & 15, fq = lane >> 4;
    const int K = g.K, KL = g.Klen;
    if (tid == 0 && !pa) { pa = (float*)malloc(256 * 8192 * 4); pb = (float*)malloc(256 * 8192 * 4); }
    __syncthreads();
    Unit cur;
    for (int ui = 0; S.next(ui, cur); ++ui) {
        { const int r = tid >> 1, h = tid & 1; const bf16_t* ar = g.A + (size_t)(cur.pm * 256 + r) * K + h * (K / 2); const bf16_t* br = g.Bt + (size_t)(cur.pn * 256 + r) * K + h * (K / 2);
          for (int k = 0; k < K / 2; ++k) { unsigned ua = (unsigned)ar[k] << 16, ub = (unsigned)br[k] << 16; pa[(size_t)r * K + h * (K / 2) + k] = __builtin_bit_cast(float, ua); pb[(size_t)r * K + h * (K / 2) + k] = __builtin_bit_cast(float, ub); } }
        __syncthreads();
        f32x4 acc[2][2][4][2];
        for (int ai = 0; ai < 2; ++ai) for (int bj = 0; bj < 2; ++bj) for (int m = 0; m < 4; ++m) for (int n = 0; n < 2; ++n) for (int e = 0; e < 4; ++e) {
            const int r = ai * 128 + wr * 64 + m * 16 + fr; const int c = bj * 128 + wc * 32 + (Epi::PERM ? 8 * fq + 4 * n + e : 16 * n + 4 * fq + e);
            const float* x = pa + (size_t)r * K + cur.kofs / 2; const float* y = pb + (size_t)c * K + cur.kofs / 2; float s = 0.f; for (int k = 0; k < KL; ++k) s += x[k] * y[k]; acc[ai][bj][m][n][e] = s; }
        E(acc, cur, wr, wc, fr, fq);
        __syncthreads();
    }
}
#endif
}
constexpr int D = 2048, NB = CFG_BATCH, T = CFG_SEQ, NL = 2, SB = CFG_DEC_BATCH, ST = 32, PAST = CFG_PAST, DFF = CFG_DFF;
constexpr int MP = NB * T, MS = SB * ST, M = MP + MS, LS = PAST + ST;
constexpr int NIN = 6656, NGU = 2 * DFF, WIN_COLS = 6496;
constexpr int KTOP_P = (T / 4 < 256) ? T / 4 : 256, KTOP_S = (LS / 4 < 256) ? LS / 4 : 256;
constexpr int LMAXV = (T > LS) ? T : LS, LPAD = (LMAXV + 63) / 64 * 64;
constexpr float EPSN = 1e-6f;
static_assert(M % 256 == 0 && T % 64 == 0 && DFF % 128 == 0 && PAST % 64 == 0, "tile divisibility");
constexpr size_t O_Y = 0;
constexpr size_t O_PAK = (size_t)M * D, O_PAV = O_PAK + (size_t)NL * MP * 128, O_PIK = O_PAV + (size_t)NL * MP * 128, O_PBK = O_PIK + (size_t)NL * MP * 64,
                 O_PBV = O_PBK + (size_t)NL * MP * 512, O_PSSM = O_PBV + (size_t)NL * MP * 512, O_PCONV = O_PSSM + (size_t)NL * NB * 131072,
                 O_SAK = O_PCONV + (size_t)NL * NB * 6144, O_SAV = O_SAK + (size_t)NL * MS * 128, O_SIK = O_SAV + (size_t)NL * MS * 128, O_SBK = O_SIK + (size_t)NL * MS * 64,
                 O_SBV = O_SBK + (size_t)NL * MS * 512, O_SSSM = O_SBV + (size_t)NL * MS * 512, O_SCONV = O_SSSM + (size_t)NL * SB * 131072, O_END = O_SCONV + (size_t)NL * SB * 6144;
constexpr size_t al256(size_t x) { return (x + 255) & ~(size_t)255; }
constexpr size_t WS_CTL = 0, CTL_ZERO_BYTES = 1u << 20;
constexpr int CW_BAR = 4096;
constexpr size_t CTL_QUEUE = 8192;
constexpr size_t CTL_QUEUE2 = 12288;
static_assert(NB + 1 <= 8 && CTL_QUEUE2 + (size_t)NL * 8 * 256 <= (size_t)CW_BAR * 4, "attention queues fit below the barrier words");
constexpr size_t CTL_RSS = 65536;
static_assert(CTL_RSS + (size_t)4 * M * 4 <= CTL_ZERO_BYTES, "RSS inside the memset region");
constexpr size_t WS_WIN = CTL_ZERO_BYTES;
constexpr size_t WS_WOUT = WS_WIN + al256((size_t)NL * NIN * D * 2);
constexpr size_t WS_WGU = WS_WOUT + al256((size_t)NL * D * D * 2);
constexpr size_t WS_WDN = WS_WGU + al256((size_t)NL * NGU * D * 2);
constexpr size_t WS_XB = WS_WDN + al256((size_t)NL * D * DFF * 2);
constexpr size_t WS_ROPE = WS_XB + al256((size_t)M * D * 2);
constexpr size_t WS_AQ = WS_ROPE + al256((size_t)LS * 16 * 4);
constexpr size_t WS_IQ = WS_AQ + al256((size_t)M * 512 * 2);
constexpr size_t WS_IW = WS_IQ + al256((size_t)M * 1024 * 2);
constexpr size_t WS_BQ = WS_IW + al256((size_t)M * 16 * 4);
constexpr size_t WS_CZ = WS_BQ + al256((size_t)M * 512 * 2);
constexpr size_t WS_CX = WS_CZ + al256((size_t)M * 1024 * 2);
constexpr size_t WS_DT = WS_CX + al256((size_t)M * 2048 * 2);
constexpr int NC = T / 64, NCU = NB * NC + SB, MPADT = M + 64;
constexpr size_t WS_XC = WS_DT + al256((size_t)M * 16 * 4);
constexpr size_t WS_XCT = WS_XC + al256((size_t)M * 2048 * 2);
constexpr size_t WS_CS = WS_XCT + al256((size_t)2048 * MPADT * 2);
constexpr size_t WS_CD = WS_CS + al256((size_t)NCU * 16 * 8192 * 4);
constexpr size_t WS_ENT = WS_CD + al256((size_t)NCU * 16 * 4);
constexpr size_t WS_YC = WS_ENT + al256((size_t)NCU * 16 * 8192 * 2);
constexpr int LSP = LPAD;
constexpr size_t WS_IKBP = WS_YC + al256((size_t)M * 1024 * 4);
constexpr size_t WS_IKBS = WS_IKBP + al256((size_t)MP * 64 * 2);
constexpr size_t WS_AKBP = WS_IKBS + al256((size_t)NL * SB * LSP * 64 * 2);
constexpr size_t WS_AKBS = WS_AKBP + al256((size_t)MP * 128 * 2);
constexpr size_t WS_AVTP = WS_AKBS + al256((size_t)NL * SB * LSP * 128 * 2);
constexpr size_t WS_AVTS = WS_AVTP + al256((size_t)NB * 128 * T * 2);
constexpr size_t WS_NSEL = WS_AVTS + al256((size_t)NL * SB * 128 * LSP * 2);
constexpr int MASK_W = LPAD / 32;
constexpr size_t WS_MASK = WS_NSEL + al256((size_t)M * 4);
constexpr size_t WS_MIX = WS_MASK + al256((size_t)M * MASK_W * 4);
constexpr size_t WS_HMID = WS_MIX + al256((size_t)M * 2048 * 2);
constexpr size_t WS_PART = WS_HMID + al256((size_t)M * DFF * 2);
constexpr size_t WS_GT = WS_PART + al256((size_t)4 * MS * D * 4);
constexpr size_t WS_PT = WS_GT + 4096;
constexpr size_t WS_END = WS_PT + 4096;
constexpr int A1_NEED = LPAD * 4;
constexpr int A1_WAVE_BYTES = (A1_NEED > 9216) ? A1_NEED : 9216;
constexpr int A1_TILE_OFF = 8 * A1_WAVE_BYTES, A1_TILE_B = 64 * 144;
constexpr int LDS_PHASE_BYTES = (A1_TILE_OFF + 2 * A1_TILE_B > 139264) ? A1_TILE_OFF + 2 * A1_TILE_B : 139264;
constexpr int MISC_OFF = (LDS_PHASE_BYTES + 255) / 256 * 256, LDS_BYTES = MISC_OFF + 256;
static_assert(LDS_BYTES <= 163840 && A1_WAVE_BYTES >= 6144, "LDS budget");
constexpr int PH_PER_LAYER = 14, NPH = 1 + NL * PH_PER_LAYER;
enum { PH_G1 = 0, PH_A1, PH_CONV, PH_A2, PH_B, PH_C1, PH_C2, PH_C3, PH_GN, PH_G2, PH_F2, PH_G3, PH_G4, PH_F4 };
constexpr int NSL2 = 4, NSL4 = ((DFF / 4) % 128 == 0) ? 4 : (((DFF / 2) % 128 == 0) ? 2 : 1);

typedef unsigned short bf16_t;
typedef float f32x4 __attribute__((ext_vector_type(4)));
typedef unsigned u32x4 __attribute__((ext_vector_type(4)));
typedef unsigned u32x2 __attribute__((ext_vector_type(2)));
typedef float f32x2 __attribute__((ext_vector_type(2)));
typedef short bf16x8 __attribute__((ext_vector_type(8)));
typedef float f32x16 __attribute__((ext_vector_type(16)));

__device__ __forceinline__ unsigned f2bf(float f) { unsigned u = __builtin_bit_cast(unsigned, f); return (u + 0x7fffu + ((u >> 16) & 1u)) >> 16; }
__device__ __forceinline__ float bf2f(unsigned h) { return __builtin_bit_cast(float, h << 16); }
__device__ __forceinline__ float bflo(unsigned w) { return __builtin_bit_cast(float, w << 16); }
__device__ __forceinline__ float bfhi(unsigned w) { return __builtin_bit_cast(float, w & 0xffff0000u); }
#ifdef HOST_EMU
__device__ __forceinline__ unsigned pk2(float lo, float hi) { return f2bf(lo) | (f2bf(hi) << 16); }
#else
__device__ __forceinline__ unsigned pk2(float lo, float hi) { unsigned r; asm("v_cvt_pk_bf16_f32 %0, %1, %2" : "=v"(r) : "v"(lo), "v"(hi)); return r; }
#endif
__device__ __forceinline__ float exp_f(float x) { return FAST_EXP2(x * 1.4426950408889634f); }
__device__ __forceinline__ float silu_f(float x) { return x * FAST_RCP(1.f + FAST_EXP2(-1.4426950408889634f * x)); }
__device__ __forceinline__ float softplus_f(float x) { return fmaxf(x, 0.f) + 0.6931471805599453f * FAST_LOG2(1.f + FAST_EXP2(-1.4426950408889634f * fabsf(x))); }
__device__ __forceinline__ float wave_sum(float v) {
#pragma unroll
    for (int o = 1; o < 64; o <<= 1) v += __shfl_xor(v, o);
    return v;
}
__device__ __forceinline__ float wave_max(float v) {
#pragma unroll
    for (int o = 1; o < 64; o <<= 1) v = fmaxf(v, __shfl_xor(v, o));
    return v;
}
__device__ __forceinline__ float wave_incl_scan(float v, int lane) {
#pragma unroll
    for (int off = 1; off < 64; off <<= 1) { const float tt = __shfl_up(v, off); if (lane >= off) v += tt; }
    return v;
}
__device__ __forceinline__ bf16x8 pack_bf16x8(const float (&v)[8]) { u32x4 w; w.x = pk2(v[0], v[1]); w.y = pk2(v[2], v[3]); w.z = pk2(v[4], v[5]); w.w = pk2(v[6], v[7]); return __builtin_bit_cast(bf16x8, w); }
__device__ __forceinline__ unsigned sortable_key(float s) { const unsigned u = __builtin_bit_cast(unsigned, s); return (u & 0x80000000u) ? ~u : (u | 0x80000000u); }

#ifndef HOST_EMU
#define XB_TMO      128
#define XB_XCNT(j)  (256  + 64 * (j))
#define XB_XSUB(j)  (1280 + 64 * (j))
#define XB_XGEN(j)  (2304 + 64 * (j))
#define XB_TOP      3328
#define XB_TOPGEN   3392
#define XCD_BAR_WORDS 3456
#define XB_SPIN_CAP (1u << 18)

__device__ __forceinline__ unsigned xb_ld(unsigned* p)              { return __hip_atomic_load(p, __ATOMIC_RELAXED, __HIP_MEMORY_SCOPE_AGENT); }
__device__ __forceinline__ unsigned xb_add(unsigned* p, unsigned v) { return __hip_atomic_fetch_add(p, v, __ATOMIC_RELAXED, __HIP_MEMORY_SCOPE_AGENT); }
__device__ __forceinline__ unsigned xb_xcc_id() { return (unsigned)__builtin_amdgcn_s_getreg((3 << 11) | 20) & 0xFu; }
#define XB_SPIN(cond, bar) do { unsigned _sp = 0; while (cond) { __builtin_amdgcn_s_sleep(1); \
    if ((++_sp & 255u) == 0u) { if (xb_ld(&(bar)[XB_TMO])) break; if (_sp > XB_SPIN_CAP) { atomicAdd(&(bar)[XB_TMO], 1u); break; } } } } while (0)

struct XcdBarrier {
    unsigned* bar; unsigned x;
    volatile LAS unsigned* st;
};

__device__ __forceinline__ XcdBarrier xcd_barrier_post(unsigned* bar, volatile LAS unsigned* st) {
    XcdBarrier b; b.bar = bar; b.x = xb_xcc_id(); b.st = st;
    if (threadIdx.x == 0) (void)xb_add(&bar[XB_XCNT(b.x)], 1u);
    return b;
}
__device__ __forceinline__ void xcd_barrier_complete(unsigned* bar, unsigned x, unsigned& nloc, unsigned& nx) {
    const unsigned G = gridDim.x * gridDim.y * gridDim.z;
    unsigned sum, cnt, mine, sp = 0u;
    for (;;) {
        sum = 0u; cnt = 0u; mine = 0u;
#pragma unroll
        for (unsigned j = 0; j < 16; ++j) { const unsigned c = xb_ld(&bar[XB_XCNT(j)]); sum += c; cnt += (c > 0u) ? 1u : 0u; mine = (j == x) ? c : mine; }
        if (sum == G) break;
        __builtin_amdgcn_s_sleep(1);
        if ((++sp & 255u) == 0u) { if (xb_ld(&bar[XB_TMO])) break; if (sp > XB_SPIN_CAP) { atomicAdd(&bar[XB_TMO], 1u); break; } }
    }
    nloc = mine > 0u ? mine : 1u; nx = cnt > 0u ? cnt : 1u;
}

__device__ __forceinline__ void xcd_barrier(const XcdBarrier& b) {
    asm volatile("s_waitcnt vmcnt(0)" ::: "memory");
    __syncthreads();
    if (threadIdx.x == 0) {
        unsigned* bar = b.bar;
        __builtin_amdgcn_s_waitcnt(0);
        unsigned nloc = b.st[0], nx = b.st[1];
        if (nloc == 0u) { xcd_barrier_complete(bar, b.x, nloc, nx); b.st[0] = nloc; b.st[1] = nx; }
        const unsigned old = xb_add(&bar[XB_XSUB(b.x)], 1u);
        const unsigned gen = old / nloc;
        if (old + 1u == (gen + 1u) * nloc) {
            __builtin_amdgcn_fence(__ATOMIC_RELEASE, "agent");
            asm volatile("s_waitcnt vmcnt(0)" ::: "memory");
            const unsigned og = xb_add(&bar[XB_TOP], 1u);
            const unsigned tg = og / nx;
            if (og + 1u == (tg + 1u) * nx) xb_add(&bar[XB_TOPGEN], 1u);
            else XB_SPIN(xb_ld(&bar[XB_TOPGEN]) == tg, bar);
            __builtin_amdgcn_fence(__ATOMIC_ACQUIRE, "agent");
            xb_add(&bar[XB_XGEN(b.x)], 1u);
            asm volatile("s_waitcnt vmcnt(0)" ::: "memory");
        } else {
            XB_SPIN(xb_ld(&bar[XB_XGEN(b.x)]) == gen, bar);
            __builtin_amdgcn_fence(__ATOMIC_ACQUIRE, "agent");
            asm volatile("s_waitcnt vmcnt(0)" ::: "memory");
        }
    }
    __syncthreads();
}
#endif

struct Args { const float* in[27]; float* out; unsigned char* ws; int ph_lo, ph_hi; };
struct Frame {
    LAS unsigned char* lds;
    int tid, lane, wave, G, gw, NGW;
    float* out; unsigned char* ws;
};
#define WSP(Tp, off) ((Tp*)(ws + (off)))
#ifdef HOST_EMU
#define EPI_FENCE() do { } while (0)
#define LAUNDER(p) do { } while (0)
#define LAUNDER_V(p) do { } while (0)
#else
#define EPI_FENCE() asm volatile("" ::: "memory")
#define LAUNDER(p) asm volatile("" : "+s"(p))
#define LAUNDER_V(p) asm volatile("" : "+v"(p))
#endif
#ifdef HOST_EMU
#define GPT(k) (PT[k])
#define PHASE_BASES() unsigned char* ws = F.ws; float* outp = F.out; const float* const* PT = (const float* const*)(ws + WS_PT); (void)PT; (void)outp; int tidl = threadIdx.x; LAUNDER_V(tidl); const int lane = tidl & 63; (void)lane
#else
#define GPT(k) ((const float*)(GAS const float*)PT[k])
#define PHASE_BASES() unsigned long long ws_u_ = (unsigned long long)F.ws, out_u_ = (unsigned long long)F.out; LAUNDER(ws_u_); LAUNDER(out_u_); unsigned char* ws = (unsigned char*)(GAS unsigned char*)ws_u_; float* outp = (float*)(GAS float*)out_u_; const unsigned long long* PT = (const unsigned long long*)(ws + WS_PT); (void)PT; (void)outp; int tidl = threadIdx.x; LAUNDER_V(tidl); const int lane = tidl & 63; (void)lane
#endif
enum { IN_XP = 0, IN_XS, IN_CAK, IN_CAV, IN_CAIK, IN_CBK, IN_CBV, IN_SSM, IN_SCONV, IN_N1G, IN_WIN, IN_GAQ, IN_GAK, IN_GIK, IN_GBQ, IN_GBK, IN_CONVW, IN_CONVB, IN_DTB, IN_ALOG, IN_CD, IN_CNG, IN_WOUT, IN_N2G, IN_WGATE, IN_WUP, IN_WDOWN };
constexpr int GT_STRIDE = 384;

struct RowInfo { bool prompt; int b, t, pos, rg; };
__device__ __forceinline__ RowInfo row_info(int row) {
    RowInfo r; r.prompt = row < MP;
    if (r.prompt) { r.rg = row; r.b = row / T; r.t = row - r.b * T; r.pos = r.t; }
    else { r.rg = row - MP; r.b = r.rg / ST; r.t = r.rg - r.b * ST; r.pos = PAST + r.t; }
    return r;
}
template <int W> __device__ __forceinline__ const float* kv_row(const float* outp, const float* outs, const float* cache, int l, bool prompt, int b, int s) {
    if (prompt) return outp + ((size_t)l * MP + (size_t)b * T + s) * W;
    if (s < PAST) return cache + (((size_t)l * SB + b) * PAST + s) * W;
    return outs + ((size_t)l * MS + (size_t)b * ST + (s - PAST)) * W;
}

__device__ __forceinline__ int inproj_src_col(int p) {
    const int pl = p & 255, L = (p & ~255) + 64 * ((pl >> 5) & 3) + 32 * ((pl >> 7) & 1) + (pl & 31);
    if (L < 1856) return L;
    if (L < 6464) return L + 16;
    if (L < 6480) return 1856 + (L - 6464);
    if (L < 6496) return L;
    return -1;
}
template <class ColFn>
__device__ __forceinline__ void transpose_load(f32x4 (&v)[2][8], const float* W, int ldw, ColFn colfn, const float* gain, int k0, int n0, int lane) {
    const int nq = lane & 15, kq = lane >> 4;
#pragma unroll
    for (int h = 0; h < 2; ++h) { const int col = colfn(n0 + 64 * h + 4 * nq);
#pragma unroll
        for (int j = 0; j < 8; ++j) v[h][j] = (col >= 0) ? *(const f32x4*)(W + (size_t)(k0 + 4 * j + kq) * ldw + col) : (f32x4){0.f, 0.f, 0.f, 0.f}; }
    if (gain) {
#pragma unroll
        for (int j = 0; j < 8; ++j) { const float g = gain[k0 + 4 * j + kq]; v[0][j] = v[0][j] * g; v[1][j] = v[1][j] * g; } }
}
__device__ __forceinline__ void transpose_store(const f32x4 (&v)[2][8], int K, bf16_t* WT, LAS float* scr, int k0, int n0, int lane) {
    const int nq = lane & 15, kq = lane >> 4;
#pragma unroll
    for (int h = 0; h < 2; ++h) {
#pragma unroll
        for (int j = 0; j < 8; ++j) *(LAS f32x4*)(scr + (4 * j + kq) * 68 + 4 * nq) = v[h][j];
        WAVE_SYNC();
        bf16_t* orow = WT + (size_t)(n0 + 64 * h + lane) * K + k0;
#pragma unroll
        for (int q = 0; q < 4; ++q) { u32x4 o;
            o.x = pk2(scr[(8 * q + 0) * 68 + lane], scr[(8 * q + 1) * 68 + lane]); o.y = pk2(scr[(8 * q + 2) * 68 + lane], scr[(8 * q + 3) * 68 + lane]);
            o.z = pk2(scr[(8 * q + 4) * 68 + lane], scr[(8 * q + 5) * 68 + lane]); o.w = pk2(scr[(8 * q + 6) * 68 + lane], scr[(8 * q + 7) * 68 + lane]);
            *(u32x4*)(orow + 8 * q) = o; }
        WAVE_SYNC();
    }
}
#define TRANSPOSE_MATRIX(NIT_, NBLK_, KB_, W_OF_NB, LDW_, COLFN_, GAIN_, KDIM_, WT_) do { const int nit_ = (NIT_); f32x4 va_[2][8], vb_[2][8]; \
        { const int c_ = (F.gw < nit_) ? F.gw : nit_ - 1; const int kb_ = c_ / (NBLK_), nb_ = c_ % (NBLK_); transpose_load(va_, W_OF_NB(nb_), (LDW_), COLFN_, (GAIN_), (KB_) * kb_, 128 * nb_, lane); } \
        for (int it_ = F.gw; it_ < nit_; it_ += 2 * F.NGW) { \
            { const int n_ = it_ + F.NGW, c_ = (n_ < nit_) ? n_ : nit_ - 1; const int kb_ = c_ / (NBLK_), nb_ = c_ % (NBLK_); transpose_load(vb_, W_OF_NB(nb_), (LDW_), COLFN_, (GAIN_), (KB_) * kb_, 128 * nb_, lane); } \
            { const int kb_ = it_ / (NBLK_), nb_ = it_ % (NBLK_); transpose_store(va_, (KDIM_), (WT_), scr, (KB_) * kb_, 128 * nb_, lane); } \
            { const int n_ = it_ + 2 * F.NGW, c_ = (n_ < nit_) ? n_ : nit_ - 1; const int kb_ = c_ / (NBLK_), nb_ = c_ % (NBLK_); transpose_load(va_, W_OF_NB(nb_), (LDW_), COLFN_, (GAIN_), (KB_) * kb_, 128 * nb_, lane); } \
            if (it_ + F.NGW < nit_) { const int n_ = it_ + F.NGW; const int kb_ = n_ / (NBLK_), nb_ = n_ % (NBLK_); transpose_store(vb_, (KDIM_), (WT_), scr, (KB_) * kb_, 128 * nb_, lane); } \
        } } while (0)
__device__ __forceinline__ void sincos_d(double x, double& s, double& c) {
    const double k = rint(x * 0.63661977236758134308); const double r = (x - k * 1.57079632679489655800) - k * 6.123233995736766036e-17; const double r2 = r * r;
    const double sp = r * (1.0 + r2 * (-1.0 / 6 + r2 * (1.0 / 120 + r2 * (-1.0 / 5040 + r2 * (1.0 / 362880 + r2 * (-1.0 / 39916800 + r2 * (1.0 / 6227020800.0)))))));
    const double cp = 1.0 + r2 * (-0.5 + r2 * (1.0 / 24 + r2 * (-1.0 / 720 + r2 * (1.0 / 40320 + r2 * (-1.0 / 3628800 + r2 * (1.0 / 479001600 + r2 * (-1.0 / 87178291200.0)))))));
    const int q = ((int)k) & 3;
    s = (q == 0) ? sp : (q == 1) ? cp : (q == 2) ? -sp : -cp; c = (q == 0) ? cp : (q == 1) ? -sp : (q == 2) ? -cp : sp;
}
__device__ __forceinline__ void phase_prologue(const Frame& F, const Args& A) {
    unsigned char* ws = F.ws;
    if (blockIdx.x == 0 && F.tid == 0) { const float** pt = (const float**)(ws + WS_PT);
#pragma unroll
        for (int i = 0; i < 27; ++i) pt[i] = A.in[i]; }
    LAS float* scr = (LAS float*)(F.lds + F.wave * 16384);
    const int lane = F.lane;
    for (int l = 0; l < NL; ++l) {
        { const float* W = A.in[IN_WIN] + (size_t)l * D * WIN_COLS; const float* gain = A.in[IN_N1G] + l * D; bf16_t* WT = WSP(bf16_t, WS_WIN) + (size_t)l * NIN * D;
#define W_SAME(nb_) W
          TRANSPOSE_MATRIX((D / 32) * (NIN / 128), (NIN / 128), 32, W_SAME, WIN_COLS, [](int p) { return inproj_src_col(p); }, gain, D, WT); }
        { const float* Wg = A.in[IN_WGATE] + (size_t)l * D * DFF; const float* Wu = A.in[IN_WUP] + (size_t)l * D * DFF; const float* gain = A.in[IN_N2G] + l * D; bf16_t* WT = WSP(bf16_t, WS_WGU) + (size_t)l * NGU * D;
#define W_GU(nb_) (((nb_) & 1) ? Wu : Wg)
          TRANSPOSE_MATRIX((D / 32) * (NGU / 128), (NGU / 128), 32, W_GU, DFF, [](int p) { const int pl = p & 255; return 128 * (p >> 8) + 32 * ((pl >> 5) & 3) + (pl & 31); }, gain, D, WT); }
        { const float* W = A.in[IN_WOUT] + (size_t)l * D * D; bf16_t* WT = WSP(bf16_t, WS_WOUT) + (size_t)l * D * D;
          TRANSPOSE_MATRIX((D / 32) * (D / 128), (D / 128), 32, W_SAME, D, [](int p) { return p; }, (const float*)nullptr, D, WT); }
        { const float* W = A.in[IN_WDOWN] + (size_t)l * DFF * D; bf16_t* WT = WSP(bf16_t, WS_WDN) + (size_t)l * D * DFF;
          TRANSPOSE_MATRIX((DFF / 32) * (D / 128), (D / 128), 32, W_SAME, D, [](int p) { return p; }, (const float*)nullptr, DFF, WT); }
    }
    { const float* cik = A.in[IN_CAIK];
      bf16_t* IKBS = WSP(bf16_t, WS_IKBS);
      const size_t gt_ = (size_t)blockIdx.x * 512 + F.tid, gs_ = (size_t)F.G * 512;
      for (size_t i = gt_; i < (size_t)NL * SB * PAST * 8; i += gs_) { const size_t rowi = i >> 3; const int c8 = (int)(i & 7) * 8; const size_t lb = rowi / PAST; const int sidx = (int)(rowi - lb * PAST);
          const f32x4 a = *(const f32x4*)(cik + rowi * 64 + c8), b4 = *(const f32x4*)(cik + rowi * 64 + c8 + 4);
          u32x4 w; w.x = pk2(a.x, a.y); w.y = pk2(a.z, a.w); w.z = pk2(b4.x, b4.y); w.w = pk2(b4.z, b4.w); *(u32x4*)(IKBS + (lb * LSP + sidx) * 64 + c8) = w; }
      for (size_t i = gt_; i < (size_t)NL * SB * (LSP - LS) * 8; i += gs_) { const size_t pr = i >> 3; const int c8 = (int)(i & 7) * 8; const size_t lb = pr / (LSP - LS); const int sidx = LS + (int)(pr - lb * (LSP - LS));
          *(u32x4*)(IKBS + (lb * LSP + sidx) * 64 + c8) = (u32x4){0u, 0u, 0u, 0u}; }
    }
    { const float* cak = A.in[IN_CAK]; bf16_t* AKBS = WSP(bf16_t, WS_AKBS); const size_t gt_ = (size_t)blockIdx.x * 512 + F.tid, gs_ = (size_t)F.G * 512;
      for (size_t i = gt_; i < (size_t)NL * SB * PAST * 16; i += gs_) { const size_t rowi = i >> 4; const int c8 = (int)(i & 15) * 8; const size_t lb = rowi / PAST; const int sidx = (int)(rowi - lb * PAST);
          const f32x4 a = *(const f32x4*)(cak + rowi * 128 + c8), b4 = *(const f32x4*)(cak + rowi * 128 + c8 + 4);
          u32x4 w; w.x = pk2(a.x, a.y); w.y = pk2(a.z, a.w); w.z = pk2(b4.x, b4.y); w.w = pk2(b4.z, b4.w); *(u32x4*)(AKBS + (lb * LSP + sidx) * 128 + c8) = w; }
      for (size_t i = gt_; i < (size_t)NL * SB * (LSP - LS) * 16; i += gs_) { const size_t pr = i >> 4; const int c8 = (int)(i & 15) * 8; const size_t lb = pr / (LSP - LS); const int sidx = LS + (int)(pr - lb * (LSP - LS));
          *(u32x4*)(AKBS + (lb * LSP + sidx) * 128 + c8) = (u32x4){0u, 0u, 0u, 0u}; }
    }
    { const float* cav = A.in[IN_CAV]; bf16_t* AVTS = WSP(bf16_t, WS_AVTS); const size_t gt_ = (size_t)blockIdx.x * 512 + F.tid, gs_ = (size_t)F.G * 512;
      LAS bf16_t* tile = (LAS bf16_t*)(F.lds + F.wave * 16384);
      constexpr int NTV = NL * SB * (PAST / 64) * 2;
      for (int it = F.gw; it < NTV; it += F.NGW) {
          const int tc = it & 1, tr = (it >> 1) % (PAST / 64), lb = (it >> 1) / (PAST / 64); const int g8 = lane & 7;
#pragma unroll 2
          for (int ps = 0; ps < 8; ++ps) { const int rl = ps * 8 + (lane >> 3); const float* sp = cav + ((size_t)lb * PAST + tr * 64 + rl) * 128 + tc * 64 + 8 * g8;
              const f32x4 a = *(const f32x4*)sp, b4 = *(const f32x4*)(sp + 4); u32x4 w; w.x = pk2(a.x, a.y); w.y = pk2(a.z, a.w); w.z = pk2(b4.x, b4.y); w.w = pk2(b4.z, b4.w);
              *(LAS u32x4*)(tile + rl * 72 + 8 * g8) = w; }
          WAVE_SYNC();
#pragma unroll 2
          for (int rg = 0; rg < 8; ++rg) { unsigned short h[8];
#pragma unroll
              for (int k = 0; k < 8; ++k) h[k] = tile[(8 * rg + k) * 72 + lane];
              u32x4 w; w.x = h[0] | ((unsigned)h[1] << 16); w.y = h[2] | ((unsigned)h[3] << 16); w.z = h[4] | ((unsigned)h[5] << 16); w.w = h[6] | ((unsigned)h[7] << 16);
              *(u32x4*)(AVTS + ((size_t)lb * 128 + tc * 64 + lane) * LSP + tr * 64 + 8 * rg) = w; }
          WAVE_SYNC();
      }
      for (size_t i = gt_; i < (size_t)NL * SB * 128 * ((LSP - LS) / 8); i += gs_) { const size_t rw = i / ((LSP - LS) / 8); const int c8 = (int)(i % ((LSP - LS) / 8)) * 8; *(u32x4*)(AVTS + rw * LSP + LS + c8) = (u32x4){0u, 0u, 0u, 0u}; }
    }
    if (blockIdx.x == 0) {
        float* gt = WSP(float, WS_GT);
        for (int i = F.tid; i < NL * GT_STRIDE; i += 512) { const int l = i / GT_STRIDE, j = i % GT_STRIDE; float v = 0.f;
            if (j < 64) v = A.in[IN_GAQ][l * 64 + j]; else if (j < 128) v = A.in[IN_GAK][l * 64 + j - 64]; else if (j < 192) v = A.in[IN_GIK][l * 64 + j - 128];
            else if (j < 256) v = A.in[IN_GBQ][l * 64 + j - 192]; else if (j < 320) v = A.in[IN_GBK][l * 64 + j - 256]; else if (j < 336) v = A.in[IN_DTB][l * 16 + j - 320];
            gt[i] = v; }
    }
    { const float* xs = A.in[IN_XS]; float* X = F.out + O_Y + (size_t)MP * D;
      for (size_t i = (size_t)blockIdx.x * 512 + F.tid; i < (size_t)MS * D / 4; i += (size_t)F.G * 512) *(f32x4*)(X + 4 * i) = *(const f32x4*)(xs + 4 * i); }
    { const float* xp = A.in[IN_XP]; const float* xs = A.in[IN_XS]; bf16_t* XB = WSP(bf16_t, WS_XB); float* RSS = WSP(float, CTL_RSS);
      for (int row0 = F.gw; row0 < M; row0 += 2 * F.NGW) {
        const int rowb = row0 + F.NGW; const bool hasb = rowb < M; const int rb2 = hasb ? rowb : row0;
        const float* xa = (row0 < MP) ? xp + (size_t)row0 * D : xs + (size_t)(row0 - MP) * D; const float* xb = (rb2 < MP) ? xp + (size_t)rb2 * D : xs + (size_t)(rb2 - MP) * D;
        f32x4 va[8], vb[8];
#pragma unroll
        for (int j = 0; j < 8; ++j) va[j] = *(const f32x4*)(xa + 4 * lane + 256 * j);
#pragma unroll
        for (int j = 0; j < 8; ++j) vb[j] = *(const f32x4*)(xb + 4 * lane + 256 * j);
        float sa = 0.f, sb = 0.f;
#pragma unroll
        for (int j = 0; j < 8; ++j) { sa += (va[j].x * va[j].x + va[j].y * va[j].y) + (va[j].z * va[j].z + va[j].w * va[j].w); u32x2 o; o.x = pk2(va[j].x, va[j].y); o.y = pk2(va[j].z, va[j].w); *(u32x2*)(XB + (size_t)row0 * D + 4 * lane + 256 * j) = o; }
        if (hasb) {
#pragma unroll
            for (int j = 0; j < 8; ++j) { sb += (vb[j].x * vb[j].x + vb[j].y * vb[j].y) + (vb[j].z * vb[j].z + vb[j].w * vb[j].w); u32x2 o; o.x = pk2(vb[j].x, vb[j].y); o.y = pk2(vb[j].z, vb[j].w); *(u32x2*)(XB + (size_t)rowb * D + 4 * lane + 256 * j) = o; } }
        sa = wave_sum(sa); sb = wave_sum(sb);
        if (lane == 0) { RSS[row0] = sa; if (hasb) RSS[rowb] = sb; }
      } }
    { float* ROPE = WSP(float, WS_ROPE);
      for (int i = blockIdx.x * 512 + F.tid; i < LS * 8; i += F.G * 512) {
        const int pos = i >> 3, j = i & 7;
        const float invf = (j == 0) ? 1.0f : (j == 1) ? 0.193922758102417f : (j == 2) ? 0.03760603070259094f : (j == 3) ? 0.00729266507551074f : (j == 4) ? 0.001414213445968926f
                         : (j == 5) ? 0.00027424818836152554f : (j == 6) ? 5.318296462064609e-05f : 1.0313385246263351e-05f;
        const float ang = (float)pos * invf; double sn, cs; sincos_d((double)ang, sn, cs);
        ROPE[pos * 16 + j] = (float)cs; ROPE[pos * 16 + 8 + j] = (float)sn;
      } }
}

__device__ __forceinline__ void st_bf16x8(bf16_t* p, const float (&v)[8]) { u32x4 w; w.x = pk2(v[0], v[1]); w.y = pk2(v[2], v[3]); w.z = pk2(v[4], v[5]); w.w = pk2(v[6], v[7]); *(u32x4*)p = w; }
__device__ __forceinline__ void st_f32x8(float* p, const float (&v)[8]) { *(f32x4*)p = (f32x4){v[0], v[1], v[2], v[3]}; *(f32x4*)(p + 4) = (f32x4){v[4], v[5], v[6], v[7]}; }

struct EpiIn {
    static constexpr bool PERM = true, AFTER_DRAIN = false;
    int l; unsigned char* ws; float* out;
    __device__ __forceinline__ void operator()(const f32x4 (&acc)[2][2][4][2], const pg8::Unit& u, int wr, int wc, int fr, int fq) const {
        const int grp = u.pn * 4 + wc;
        if (grp >= 102) return;
        const float* rss = (const float*)(ws + CTL_RSS) + (size_t)(2 * l) * M; const float* rope = (const float*)(ws + WS_ROPE); const float* gt = (const float*)(ws + WS_GT) + l * GT_STRIDE;
        int kind = 0, coff = 0, bstride = 0, fstride = 0; bool do_norm = false, do_rope = false, conv_tail = false; const float* gain = gt;
        bf16_t* bb = nullptr; float* fP = nullptr; float* fS = nullptr;
        int side = 0, sstride = 0; bf16_t* sP = nullptr; bf16_t* sS = nullptr;
        bool qscale = false;
        if (grp < 8) { kind = 0; bb = (bf16_t*)(ws + WS_AQ); bstride = 512; coff = grp * 64; do_norm = true; do_rope = true; gain = gt; qscale = true; }
        else if (grp < 10) { kind = 1; fP = out + O_PAK + (size_t)l * MP * 128; fS = out + O_SAK + (size_t)l * MS * 128; fstride = 128; coff = (grp - 8) * 64; do_norm = true; do_rope = true; gain = gt + 64;
            side = 1; sstride = 128; sP = (bf16_t*)(ws + WS_AKBP); sS = (bf16_t*)(ws + WS_AKBS) + (size_t)l * SB * LSP * 128; }
        else if (grp < 12) { kind = 1; fP = out + O_PAV + (size_t)l * MP * 128; fS = out + O_SAV + (size_t)l * MS * 128; fstride = 128; coff = (grp - 10) * 64; }
        else if (grp < 28) { kind = 0; bb = (bf16_t*)(ws + WS_IQ); bstride = 1024; coff = (grp - 12) * 64; do_rope = true; }
        else if (grp < 29) { kind = 1; fP = out + O_PIK + (size_t)l * MP * 64; fS = out + O_SIK + (size_t)l * MS * 64; fstride = 64; coff = 0; do_norm = true; do_rope = true; gain = gt + 128;
            side = 1; sstride = 64; sP = (bf16_t*)(ws + WS_IKBP); sS = (bf16_t*)(ws + WS_IKBS) + (size_t)l * SB * LSP * 64; }
        else if (grp < 37) { kind = 0; bb = (bf16_t*)(ws + WS_BQ); bstride = 512; coff = (grp - 29) * 64; do_norm = true; gain = gt + 192; }
        else if (grp < 45) { kind = 1; fP = out + O_PBK + (size_t)l * MP * 512; fS = out + O_SBK + (size_t)l * MS * 512; fstride = 512; coff = (grp - 37) * 64; do_norm = true; gain = gt + 256; }
        else if (grp < 53) { kind = 1; fP = out + O_PBV + (size_t)l * MP * 512; fS = out + O_SBV + (size_t)l * MS * 512; fstride = 512; coff = (grp - 45) * 64; }
        else if (grp < 69) { kind = 0; bb = (bf16_t*)(ws + WS_CZ); bstride = 1024; coff = (grp - 53) * 64; }
        else if (grp < 101) { kind = 0; bb = (bf16_t*)(ws + WS_CX); bstride = 2048; coff = (grp - 69) * 64; conv_tail = true; }
        else { kind = 2; }
        const int d0 = 8 * fq;
        float rsv[8];
#pragma unroll
        for (int q = 0; q < 8; ++q) rsv[q] = rss[u.pm * 256 + (q >> 2) * 128 + wr * 64 + (q & 3) * 16 + fr];
#pragma unroll
        for (int ai = 0; ai < 2; ++ai)
#pragma unroll
            for (int m = 0; m < 4; ++m) {
                const int r = u.pm * 256 + ai * 128 + wr * 64 + m * 16 + fr;
                const RowInfo ri = row_info(r);
                const float rs = FAST_RSQ(rsv[ai * 4 + m] * (1.0f / D) + EPSN);
                float v[2][8];
#pragma unroll
                for (int bj = 0; bj < 2; ++bj)
#pragma unroll
                    for (int n = 0; n < 2; ++n)
#pragma unroll
                        for (int e = 0; e < 4; ++e) v[bj][4 * n + e] = acc[ai][bj][m][n][e] * rs;
                if (do_norm) {
                    float ss = 0.f;
#pragma unroll
                    for (int bj = 0; bj < 2; ++bj)
#pragma unroll
                        for (int i = 0; i < 8; ++i) ss += v[bj][i] * v[bj][i];
                    ss += __shfl_xor(ss, 16); ss += __shfl_xor(ss, 32);
                    const float rn = FAST_RSQ(ss * (1.0f / 64.0f) + EPSN);
#pragma unroll
                    for (int bj = 0; bj < 2; ++bj) { const f32x4 g0 = *(const f32x4*)(gain + 32 * bj + d0), g1 = *(const f32x4*)(gain + 32 * bj + d0 + 4);
#pragma unroll
                        for (int e = 0; e < 4; ++e) { v[bj][e] = v[bj][e] * rn * g0[e]; v[bj][4 + e] = v[bj][4 + e] * rn * g1[e]; } }
                }
                if (do_rope) {
                    const float* rp = rope + (size_t)ri.pos * 16;
                    const f32x4 c0 = *(const f32x4*)rp, c1 = *(const f32x4*)(rp + 4), s0 = *(const f32x4*)(rp + 8), s1 = *(const f32x4*)(rp + 12);
                    const float sgn = (fq == 0) ? -1.f : 1.f;
#pragma unroll
                    for (int i = 0; i < 8; ++i) {
                        const float pv = __shfl_xor(v[0][i], 16);
                        const float c = (i < 4) ? c0[i & 3] : c1[i & 3], sn = (i < 4) ? s0[i & 3] : s1[i & 3];
                        if (fq < 2) v[0][i] = v[0][i] * c + sgn * pv * sn;
                    }
                }
                if (kind == 0) {
                    if (qscale) {
#pragma unroll
                        for (int bj = 0; bj < 2; ++bj)
#pragma unroll
                            for (int i = 0; i < 8; ++i) v[bj][i] *= 0.18033688011112042f; }
                    bf16_t* o = bb + (size_t)r * bstride + coff + d0; st_bf16x8(o, v[0]); st_bf16x8(o + 32, v[1]);
                    if (conv_tail) { const int Tg = ri.prompt ? T : ST;
                        if (ri.t >= Tg - 3) { float* of = (ri.prompt ? out + O_PCONV + ((size_t)(l * NB + ri.b) * 3 + (ri.t - (Tg - 3))) * 2048 : out + O_SCONV + ((size_t)(l * SB + ri.b) * 3 + (ri.t - (Tg - 3))) * 2048) + coff + d0;
                            st_f32x8(of, v[0]); st_f32x8(of + 32, v[1]); } }
                } else if (kind == 1) {
                    float* o = (ri.prompt ? fP : fS) + (size_t)ri.rg * fstride + coff + d0; st_f32x8(o, v[0]); st_f32x8(o + 32, v[1]);
                    if (side == 1) { bf16_t* o2 = (ri.prompt ? sP + (size_t)r * sstride : sS + ((size_t)ri.b * LSP + PAST + ri.t) * sstride) + coff + d0; st_bf16x8(o2, v[0]); st_bf16x8(o2 + 32, v[1]); }
                } else {
                    float w[8];
                    if (fq < 2) {
#pragma unroll
                        for (int i = 0; i < 8; ++i) w[i] = v[0][i] * 0.25f;
                        st_f32x8((float*)(ws + WS_IW) + (size_t)r * 16 + d0, w); }
                    else {
#pragma unroll
                        for (int i = 0; i < 8; ++i) w[i] = softplus_f(v[0][i] + gt[320 + (d0 - 16) + i]);
                        st_f32x8((float*)(ws + WS_DT) + (size_t)r * 16 + (d0 - 16), w); }
                }
                if (m & 1) EPI_FENCE();
            }
    }
};
struct EpiOut {
    static constexpr bool PERM = true, AFTER_DRAIN = false;
    float* X; unsigned char* ws; int l;
    __device__ __forceinline__ void operator()(const f32x4 (&acc)[2][2][4][2], const pg8::Unit& u, int wr, int wc, int fr, int fq) const {
        bf16_t* XB = (bf16_t*)(ws + WS_XB); float* rss = (float*)(ws + CTL_RSS) + (size_t)(2 * l + 1) * M;
        const float* const* PT = (const float* const*)(ws + WS_PT); const float* xp = GPT(IN_XP);
#pragma unroll
        for (int ai = 0; ai < 2; ++ai)
#pragma unroll
            for (int m = 0; m < 4; ++m) {
                const int r = u.pm * 256 + ai * 128 + wr * 64 + m * 16 + fr;
                const float* xr = (l == 0) ? xp + (size_t)r * D : X + (size_t)r * D;
                float ss = 0.f;
#pragma unroll
                for (int bj = 0; bj < 2; ++bj) {
                    const int c = u.pn * 256 + bj * 128 + wc * 32 + 8 * fq; float v[8];
                    const f32x4 a0 = *(const f32x4*)(xr + c), a1 = *(const f32x4*)(xr + c + 4);
#pragma unroll
                    for (int e = 0; e < 4; ++e) { v[e] = a0[e] + acc[ai][bj][m][0][e]; v[4 + e] = a1[e] + acc[ai][bj][m][1][e]; }
#pragma unroll
                    for (int i = 0; i < 8; ++i) ss += v[i] * v[i];
                    st_f32x8(X + (size_t)r * D + c, v); st_bf16x8(XB + (size_t)r * D + c, v);
                }
                ss += __shfl_xor(ss, 16); ss += __shfl_xor(ss, 32);
                if (fq == 0) atomicAdd(rss + r, ss);
                if (m & 1) EPI_FENCE();
            }
    }
};
struct EpiGU {
    static constexpr bool PERM = true, AFTER_DRAIN = false;
    unsigned char* ws; int l;
    __device__ __forceinline__ void operator()(const f32x4 (&acc)[2][2][4][2], const pg8::Unit& u, int wr, int wc, int fr, int fq) const {
        const float* rss = (const float*)(ws + CTL_RSS) + (size_t)(2 * l + 1) * M; bf16_t* H = (bf16_t*)(ws + WS_HMID);
        float rsv[8];
#pragma unroll
        for (int q = 0; q < 8; ++q) rsv[q] = rss[u.pm * 256 + (q >> 2) * 128 + wr * 64 + (q & 3) * 16 + fr];
#pragma unroll
        for (int ai = 0; ai < 2; ++ai)
#pragma unroll
            for (int m = 0; m < 4; ++m) {
                const int r = u.pm * 256 + ai * 128 + wr * 64 + m * 16 + fr;
                const float rs = FAST_RSQ(rsv[ai * 4 + m] * (1.0f / D) + EPSN);
                float v[8];
#pragma unroll
                for (int n = 0; n < 2; ++n)
#pragma unroll
                    for (int e = 0; e < 4; ++e) { const float g = acc[ai][0][m][n][e] * rs, up = acc[ai][1][m][n][e] * rs; v[4 * n + e] = silu_f(g) * up; }
                st_bf16x8(H + (size_t)r * DFF + u.pn * 128 + wc * 32 + 8 * fq, v);
                EPI_FENCE();
            }
    }
};
struct EpiDown {
    static constexpr bool PERM = true, AFTER_DRAIN = false;
    float* X; unsigned char* ws; int l;
    __device__ __forceinline__ void operator()(const f32x4 (&acc)[2][2][4][2], const pg8::Unit& u, int wr, int wc, int fr, int fq) const {
        bf16_t* XB = (bf16_t*)(ws + WS_XB); float* rss = (float*)(ws + CTL_RSS) + (size_t)(2 * l + 2) * M; const bool next = l + 1 < NL;
#pragma unroll
        for (int ai = 0; ai < 2; ++ai)
#pragma unroll
            for (int m = 0; m < 4; ++m) {
                const int r = u.pm * 256 + ai * 128 + wr * 64 + m * 16 + fr;
                float ss = 0.f;
#pragma unroll
                for (int bj = 0; bj < 2; ++bj) {
                    const int c = u.pn * 256 + bj * 128 + wc * 32 + 8 * fq; float v[8];
                    const f32x4 a0 = *(const f32x4*)(X + (size_t)r * D + c), a1 = *(const f32x4*)(X + (size_t)r * D + c + 4);
#pragma unroll
                    for (int e = 0; e < 4; ++e) { v[e] = a0[e] + acc[ai][bj][m][0][e]; v[4 + e] = a1[e] + acc[ai][bj][m][1][e]; }
#pragma unroll
                    for (int i = 0; i < 8; ++i) ss += v[i] * v[i];
                    st_f32x8(X + (size_t)r * D + c, v);
                    if (next) st_bf16x8(XB + (size_t)r * D + c, v);
                }
                if (next) { ss += __shfl_xor(ss, 16); ss += __shfl_xor(ss, 32); if (fq == 0) atomicAdd(rss + r, ss); }
                if (m & 1) EPI_FENCE();
            }
    }
};

struct EpiTail {
    static constexpr bool PERM = true, AFTER_DRAIN = false;
    float* P; int klen_bytes;
    __device__ __forceinline__ void operator()(const f32x4 (&acc)[2][2][4][2], const pg8::Unit& u, int wr, int wc, int fr, int fq) const {
        float* slab = P + (size_t)(u.kofs / klen_bytes) * MS * D;
#pragma unroll
        for (int ai = 0; ai < 2; ++ai)
#pragma unroll
            for (int m = 0; m < 4; ++m) {
                const int r = u.pm * 256 + ai * 128 + wr * 64 + m * 16 + fr - MP;
#pragma unroll
                for (int bj = 0; bj < 2; ++bj) { float* xo = slab + (size_t)r * D + u.pn * 256 + bj * 128 + wc * 32 + 8 * fq; *(f32x4*)xo = acc[ai][bj][m][0]; *(f32x4*)(xo + 4) = acc[ai][bj][m][1]; }
                EPI_FENCE();
            }
    }
};
__device__ __forceinline__ void phase_fin(const Frame& F, int idx, int nsl, bool next) {
    PHASE_BASES();
    float* X = outp + O_Y; bf16_t* XB = WSP(bf16_t, WS_XB); float* RSS = WSP(float, CTL_RSS) + (size_t)idx * M; const float* P = WSP(float, WS_PART);
    for (int row = MP + F.gw; row < M; row += F.NGW) {
        float ss = 0.f;
#pragma unroll
        for (int j = 0; j < 8; ++j) { const size_t o = (size_t)row * D + 4 * lane + 256 * j; f32x4 v = *(const f32x4*)(X + o);
            for (int sl = 0; sl < nsl; ++sl) v += *(const f32x4*)(P + ((size_t)sl * MS + (row - MP)) * D + 4 * lane + 256 * j);
            *(f32x4*)(X + o) = v; ss += (v.x * v.x + v.y * v.y) + (v.z * v.z + v.w * v.w);
            if (next) { u32x2 w; w.x = pk2(v.x, v.y); w.y = pk2(v.z, v.w); *(u32x2*)(XB + o) = w; } }
        ss = wave_sum(ss);
        if (next && lane == 0) RSS[row] = ss;
    }
}

__device__ __forceinline__ void phase_a1(const Frame& F, int l, int qs = 0) {
    PHASE_BASES();
    const bf16_t* IQ = WSP(bf16_t, WS_IQ); const float* IW = WSP(float, WS_IW); unsigned* MASK = WSP(unsigned, WS_MASK);
    unsigned* qhead = (unsigned*)(ws + CTL_QUEUE) + (l * 8 + 0 + qs) * 64;
    volatile LAS int* qslot = (volatile LAS int*)(F.lds + MISC_OFF + 64);
    LAS float* iwt = (LAS float*)(F.lds + A1_TILE_OFF);
    LAS unsigned* cand_list = (LAS unsigned*)(F.lds + A1_TILE_OFF + 1024) + F.wave * 64;
    const int r32 = lane & 31, hh = lane >> 5, wave = F.wave;
    constexpr int NUS = MS / 8, NUP = MP / 8, NUNITS = NUS + NUP;
    for (;;) {
        __syncthreads();
        if (tidl == 0) qslot[0] = (int)atomicAdd(qhead, 1u);
        __syncthreads();
        const int u = qslot[0];
        if (u >= NUNITS) break;
        bool prompt; int b, row0, L, Ktop;
        if (u < NUS) { prompt = false; b = (u * 8) / ST; row0 = MP + u * 8; L = LS; Ktop = KTOP_S; }
        else { const int k = u - NUS, c = NC - 1 - k / (NB * 8), j = k % (NB * 8); prompt = true; b = j >> 3; row0 = b * T + 64 * c + 8 * (j & 7); L = 64 * (c + 1); Ktop = KTOP_P; }
        const int nb32 = (L + 31) / 32;
        if (tidl < 128) iwt[tidl] = IW[(size_t)row0 * 16 + tidl] * 0.125f;
        bf16x8 af[4][4];
#pragma unroll
        for (int rb = 0; rb < 4; ++rb) { const bf16_t* ap = IQ + (size_t)(row0 + 2 * rb + ((r32 >> 2) & 1)) * 1024 + ((r32 & 3) + 4 * (r32 >> 3)) * 64 + 8 * hh;
#pragma unroll
            for (int ks = 0; ks < 4; ++ks) af[rb][ks] = *(const bf16x8*)(ap + 16 * ks); }
        __syncthreads();
        const bf16_t* ikb = (prompt ? WSP(bf16_t, WS_IKBP) + (size_t)b * T * 64 : WSP(bf16_t, WS_IKBS) + ((size_t)l * SB + b) * LSP * 64) + (size_t)r32 * 64 + 8 * hh;
        bf16x8 ring[4][4];
#define A1_LOAD_B(dst, kb_) do { const bf16_t* kp_ = ikb + (size_t)(kb_) * 32 * 64; _Pragma("unroll") for (int ks_ = 0; ks_ < 4; ++ks_) dst[ks_] = *(const bf16x8*)(kp_ + 16 * ks_); } while (0)
#pragma unroll
        for (int j = 0; j < 4; ++j) { const int kl = wave + 8 * j; A1_LOAD_B(ring[j], kl < nb32 ? kl : nb32 - 1); }
#pragma unroll 1
        for (int kb0 = wave; kb0 < nb32; kb0 += 32) {
#pragma unroll
            for (int j = 0; j < 4; ++j) {
                const int kb = kb0 + 8 * j;
                if (kb < nb32) {
                    const int s = 32 * kb + r32; const bool kvalid = s < L;
#pragma unroll
                    for (int rb = 0; rb < 4; ++rb) {
                        f32x16 acc;
#pragma unroll
                        for (int i = 0; i < 16; ++i) acc[i] = 0.f;
#pragma unroll
                        for (int ks = 0; ks < 4; ++ks) acc = MFMA32(af[rb][ks], ring[j][ks], acc);
                        float score = 0.f;
#pragma unroll
                        for (int q = 0; q < 4; ++q) { const f32x4 w4 = *(const LAS f32x4*)(iwt + (2 * rb + hh) * 16 + 4 * q);
                            score += w4.x * fmaxf(acc[4 * q], 0.f) + w4.y * fmaxf(acc[4 * q + 1], 0.f) + w4.z * fmaxf(acc[4 * q + 2], 0.f) + w4.w * fmaxf(acc[4 * q + 3], 0.f); }
                        *(LAS unsigned*)(F.lds + (2 * rb + hh) * A1_WAVE_BYTES + (size_t)s * 4) = kvalid ? sortable_key(score) : 0u;
                    }
                }
                { const int kl = kb + 32; A1_LOAD_B(ring[j], kl < nb32 ? kl : nb32 - 1); }
            }
        }
        __syncthreads();
        const LAS unsigned* sc = (const LAS unsigned*)(F.lds + wave * A1_WAVE_BYTES);
        const int nt = (nb32 + 1) / 2, row = row0 + wave;
        if (2 * nt > nb32 && lane >= 32) ((LAS unsigned*)sc)[32 * nb32 + (lane - 32)] = 0u;
        WAVE_SYNC();
        const int n4 = nt / 4, nrem = nt - 4 * n4;
        constexpr int G4MAX = LPAD / 256;
        u32x4 kq[G4MAX]; unsigned kr_[3];
#pragma unroll
        for (int g = 0; g < G4MAX; ++g) kq[g] = (g < n4) ? *(const LAS u32x4*)(sc + 256 * g + 4 * lane) : (u32x4){0u, 0u, 0u, 0u};
#pragma unroll
        for (int r = 0; r < 3; ++r) kr_[r] = (r < nrem) ? sc[256 * n4 + 64 * r + lane] : 0u;
        unsigned tau = 1u;
        if (L > Ktop) {
            tau = 0u; int c_lo = 64 * nt, c_hi = 0, bit = 31; bool found = false;
            while (bit >= 0 && c_lo - c_hi > 64) {
                const unsigned cand = tau | (1u << bit); int cnt = 0;
#pragma unroll
                for (int g = 0; g < G4MAX; ++g) if (g < n4) cnt += __popcll(__ballot(kq[g].x >= cand)) + __popcll(__ballot(kq[g].y >= cand)) + __popcll(__ballot(kq[g].z >= cand)) + __popcll(__ballot(kq[g].w >= cand));
#pragma unroll
                for (int r = 0; r < 3; ++r) if (r < nrem) cnt += __popcll(__ballot(kr_[r] >= cand));
                if (cnt >= Ktop) { tau = cand; c_lo = cnt; } else c_hi = cnt;
                --bit;
                if (cnt == Ktop) { found = true; break; }
            }
            if (!found && bit >= 0) {
                const bool whole = (bit == 31); const unsigned hi_excl = whole ? 0u : tau + (2u << bit);
                int nb = 0;
#define A1_COMPACT(kval) do { const unsigned k_ = (kval); const bool in_ = (k_ >= tau) && (whole || k_ < hi_excl); const unsigned long long bal_ = __ballot(in_); \
                    if (in_) cand_list[nb + __popcll(bal_ & ((1ull << lane) - 1ull))] = k_; nb += __popcll(bal_); } while (0)
#pragma unroll
                for (int g = 0; g < G4MAX; ++g) if (g < n4) { A1_COMPACT(kq[g].x); A1_COMPACT(kq[g].y); A1_COMPACT(kq[g].z); A1_COMPACT(kq[g].w); }
#pragma unroll
                for (int r = 0; r < 3; ++r) if (r < nrem) A1_COMPACT(kr_[r]);
                WAVE_SYNC();
                const unsigned mine = (lane < nb) ? cand_list[lane] : 0u;
                for (; bit >= 0; --bit) {
                    const unsigned cand = tau | (1u << bit);
                    const int cnt = c_hi + __popcll(__ballot((lane < nb) && mine >= cand));
                    if (cnt >= Ktop) tau = cand;
                    if (cnt == Ktop) break;
                }
            }
            if (tau == 0u) tau = 1u;
        }
        unsigned* mrow = MASK + (size_t)row * MASK_W;
#pragma unroll
        for (int g = 0; g < G4MAX; ++g) if (g < n4) {
            unsigned nib = ((kq[g].x >= tau && kq[g].x != 0u) ? 1u : 0u) | ((kq[g].y >= tau && kq[g].y != 0u) ? 2u : 0u) | ((kq[g].z >= tau && kq[g].z != 0u) ? 4u : 0u) | ((kq[g].w >= tau && kq[g].w != 0u) ? 8u : 0u);
            unsigned wv = nib << (4 * (lane & 7));
            wv |= __shfl_xor(wv, 1); wv |= __shfl_xor(wv, 2); wv |= __shfl_xor(wv, 4);
            if ((lane & 7) == 0) mrow[8 * g + (lane >> 3)] = wv;
        }
#pragma unroll
        for (int r = 0; r < 3; ++r) if (r < nrem) {
            const unsigned long long bal = __ballot(kr_[r] >= tau && kr_[r] != 0u);
            if (lane == 0) { mrow[8 * n4 + 2 * r] = (unsigned)bal; mrow[8 * n4 + 2 * r + 1] = (unsigned)(bal >> 32); }
        }
    }
}
constexpr int A2_KP = 272, A2_VP = 136, A2_KT = 64 * A2_KP, A2_VT = 128 * A2_VP, A2_BUF = A2_KT + A2_VT;
static_assert(2 * A2_BUF <= LDS_PHASE_BYTES, "A2 LDS");
__device__ __forceinline__ void phase_a2(const Frame& F, int l, int qs = 0) {
    PHASE_BASES();
    const bf16_t* AQ = WSP(bf16_t, WS_AQ); const unsigned* MASK = WSP(unsigned, WS_MASK); bf16_t* MIX = WSP(bf16_t, WS_MIX);
    const float* kp_p = outp + O_PAK; const float* kp_s = outp + O_SAK; const float* kp_c = GPT(IN_CAK);
    const float* vp_p = outp + O_PAV; const float* vp_s = outp + O_SAV; const float* vp_c = GPT(IN_CAV);
    unsigned* qbase = (unsigned*)(ws + CTL_QUEUE2) + (size_t)(l * 8) * 64; (void)qs;
    volatile LAS int* qslot = (volatile LAS int*)(F.lds + MISC_OFF + 96);
    const int r32 = lane & 31, hh = lane >> 5, wave = F.wave, kvh = wave >> 2, qsub = wave & 3, qq = r32 & 15;
    constexpr int NUS = SB, NUP = NB * NC, NUNITS = NUS + NUP; (void)NUNITS; (void)NUP;
#ifdef HOST_EMU
    const int home = (int)(blockIdx.x % NB);
#else
    const int home = (int)(xb_xcc_id() % (unsigned)NB);
#endif
    int qstage = 0;
    const int kkey = tidl >> 3, kd = 16 * (tidl & 7), vkp = 2 * (tidl & 31), vd = 8 * (tidl >> 5);
    for (;;) {
        __syncthreads();
        if (tidl == 0) {
            int uu = -1;
            while (qstage <= NB) {
                const int qi = qstage == 0 ? NB : (home + qstage - 1) % NB;
                const int v = (int)atomicAdd(qbase + qi * 64, 1u);
                if (v < (qstage == 0 ? NUS : NC)) { uu = qstage == 0 ? v : NUS + v * NB + qi; break; }
                ++qstage;
            }
            qslot[0] = uu;
        }
        __syncthreads();
        const int u = qslot[0];
        if (u < 0) break;
        bool prompt; int b, row0, L, nq;
        if (u < NUS) { prompt = false; b = u; row0 = MP + u * ST; L = LS; nq = ST; }
        else { const int k = u - NUS, c = NC - 1 - k / NB; prompt = true; b = k % NB; row0 = b * T + 64 * c; L = 64 * (c + 1); nq = 64; }
        const int nt = (L + 63) / 64; const bool active = 16 * qsub < nq;
        const int qrow = row0 + (active ? 16 * qsub + qq : 0);
        bf16x8 qf[2][4];
#pragma unroll
        for (int cb = 0; cb < 2; ++cb)
#pragma unroll
            for (int ks = 0; ks < 4; ++ks) qf[cb][ks] = *(const bf16x8*)(AQ + (size_t)qrow * 512 + (kvh * 4 + 2 * cb + (r32 >> 4)) * 64 + 16 * ks + 8 * hh);
        f32x16 o[2][2]; float mrun[2] = {-1.0e30f, -1.0e30f}, lrun[2] = {0.f, 0.f};
#pragma unroll
        for (int db = 0; db < 2; ++db)
#pragma unroll
            for (int cb = 0; cb < 2; ++cb)
#pragma unroll
                for (int i = 0; i < 16; ++i) o[db][cb][i] = 0.f;
        const bf16_t* akb_base = prompt ? WSP(bf16_t, WS_AKBP) + (size_t)b * T * 128 : WSP(bf16_t, WS_AKBS) + ((size_t)l * SB + b) * LSP * 128;
        const bf16_t* avt_base = prompt ? WSP(bf16_t, WS_AVTP) + (size_t)b * 128 * T : WSP(bf16_t, WS_AVTS) + ((size_t)l * SB + b) * 128 * LSP; const size_t avt_pitch = prompt ? (size_t)T : (size_t)LSP;
        u32x4 kA[2], vA[2], kB[2], vB[2];
#define A2_LOAD_TT(K_, V_, t_) do { const bf16_t* kp_ = akb_base + (size_t)(64 * (t_) + kkey) * 128 + kd; K_[0] = *(const u32x4*)kp_; K_[1] = *(const u32x4*)(kp_ + 8); \
            const bf16_t* vp_ = avt_base + (size_t)(tidl >> 2) * avt_pitch + 64 * (t_) + 16 * (tidl & 3); V_[0] = *(const u32x4*)vp_; V_[1] = *(const u32x4*)(vp_ + 8); } while (0)
#define A2_STORE_TT(K_, V_, buf_) do { LAS unsigned char* kb_ = F.lds + (buf_) * A2_BUF + kkey * A2_KP + kd * 2; *(LAS u32x4*)kb_ = K_[0]; *(LAS u32x4*)(kb_ + 16) = K_[1]; \
            LAS unsigned char* vb_ = F.lds + (buf_) * A2_BUF + A2_KT + (tidl >> 2) * A2_VP + 32 * (tidl & 3); \
            *(LAS u32x2*)(vb_) = (u32x2){V_[0].x, V_[0].y}; *(LAS u32x2*)(vb_ + 8) = (u32x2){V_[0].z, V_[0].w}; *(LAS u32x2*)(vb_ + 16) = (u32x2){V_[1].x, V_[1].y}; *(LAS u32x2*)(vb_ + 24) = (u32x2){V_[1].z, V_[1].w}; } while (0)
#define A2_COMPUTE(BUF_) do { \
            if (active) { \
                const LAS unsigned char* kt = F.lds + (BUF_) * A2_BUF; const LAS unsigned char* vt = kt + A2_KT; \
                _Pragma("unroll") \
                for (int kblk = 0; kblk < 2; ++kblk) { \
                    f32x16 sacc[2]; \
                _Pragma("unroll") \
                    for (int cb = 0; cb < 2; ++cb) \
                _Pragma("unroll") \
                        for (int i = 0; i < 16; ++i) sacc[cb][i] = 0.f; \
                _Pragma("unroll") \
                    for (int ks = 0; ks < 4; ++ks) { const bf16x8 kf = *(const LAS bf16x8*)(kt + (32 * kblk + r32) * A2_KP + (kvh * 64 + 16 * ks + 8 * hh) * 2); \
                        sacc[0] = MFMA32(kf, qf[0][ks], sacc[0]); sacc[1] = MFMA32(kf, qf[1][ks], sacc[1]); } \
                    const unsigned mw = kblk ? mcur1 : mcur0; \
                    bf16x8 pf[2][2]; \
                _Pragma("unroll") \
                    for (int cb = 0; cb < 2; ++cb) { \
                        float sv[16]; float bm = -1.0e30f; const unsigned mwh = mw >> (4 * hh); \
                _Pragma("unroll") \
                        for (int i = 0; i < 16; ++i) { const bool on = (mwh & (1u << ((i & 3) + 8 * (i >> 2)))) != 0u; sv[i] = on ? sacc[cb][i] : -1.0e30f; bm = fmaxf(bm, sv[i]); } \
                        bm = fmaxf(bm, __shfl_xor(bm, 32)); \
                          \
                        if (__any(bm - mrun[cb] > 8.0f)) { \
                            const float mnew = fmaxf(mrun[cb], bm); \
                            const float alpha = FAST_EXP2(mrun[cb] - mnew); \
                            lrun[cb] *= alpha; mrun[cb] = mnew; \
                _Pragma("unroll") \
                            for (int db = 0; db < 2; ++db) \
                _Pragma("unroll") \
                                for (int i = 0; i < 16; ++i) o[db][cb][i] *= alpha; \
                        } \
                        const float mref = mrun[cb]; \
                        float ps = 0.f; float pv[16]; \
                _Pragma("unroll") \
                        for (int i = 0; i < 16; ++i) { pv[i] = FAST_EXP2(sv[i] - mref); ps += pv[i]; } \
                        if (mref < -1.0e29f) { \
                _Pragma("unroll") \
                            for (int i = 0; i < 16; ++i) pv[i] = 0.f; \
                            ps = 0.f; } \
                        ps += __shfl_xor(ps, 32); \
                        lrun[cb] += ps; \
                _Pragma("unroll") \
                        for (int ks2 = 0; ks2 < 2; ++ks2) { float t8[8]; \
                _Pragma("unroll") \
                            for (int j = 0; j < 8; ++j) t8[j] = pv[8 * ks2 + j]; \
                            pf[cb][ks2] = pack_bf16x8(t8); } \
                    } \
                _Pragma("unroll") \
                    for (int db = 0; db < 2; ++db) \
                _Pragma("unroll") \
                        for (int ks2 = 0; ks2 < 2; ++ks2) { \
                            const LAS unsigned char* vp = vt + (kvh * 64 + 32 * db + r32) * A2_VP + (32 * kblk + 16 * ks2 + 4 * hh) * 2; \
                            const u32x2 v0 = *(const LAS u32x2*)vp, v1 = *(const LAS u32x2*)(vp + 16); \
                            const bf16x8 vf = __builtin_bit_cast(bf16x8, ((u32x4){v0.x, v0.y, v1.x, v1.y})); \
                            o[db][0] = MFMA32(vf, pf[0][ks2], o[db][0]); o[db][1] = MFMA32(vf, pf[1][ks2], o[db][1]); \
                        } \
                } \
            } \
            } while (0)
        A2_LOAD_TT(kA, vA, 0); A2_STORE_TT(kA, vA, 0);
        A2_LOAD_TT(kB, vB, (nt > 1 ? 1 : 0));
        const unsigned* mrow = MASK + (size_t)qrow * MASK_W;
        unsigned mcur0 = mrow[0], mcur1 = mrow[1], mnx0 = 0u, mnx1 = 0u;
        __syncthreads();
#pragma unroll 1
        for (int t = 0; t < nt; t += 2) {
            A2_LOAD_TT(kA, vA, (t + 2 < nt ? t + 2 : nt - 1));
            { const int tm = (t + 1 < nt) ? t + 1 : nt - 1; mnx0 = mrow[2 * tm]; mnx1 = mrow[2 * tm + 1]; }
            A2_COMPUTE(0);
            if (t + 1 < nt) A2_STORE_TT(kB, vB, 1);
            mcur0 = mnx0; mcur1 = mnx1;
            __syncthreads();
            if (t + 1 >= nt) break;
            A2_LOAD_TT(kB, vB, (t + 3 < nt ? t + 3 : nt - 1));
            { const int tm = (t + 2 < nt) ? t + 2 : nt - 1; mnx0 = mrow[2 * tm]; mnx1 = mrow[2 * tm + 1]; }
            A2_COMPUTE(1);
            if (t + 2 < nt) A2_STORE_TT(kA, vA, 0);
            mcur0 = mnx0; mcur1 = mnx1;
            __syncthreads();
        }
        if (active) {
#pragma unroll
            for (int cb = 0; cb < 2; ++cb) { const float inv = 1.0f / lrun[cb];
#pragma unroll
                for (int db = 0; db < 2; ++db)
#pragma unroll
                    for (int g = 0; g < 4; ++g) { u32x2 w; w.x = pk2(o[db][cb][4 * g] * inv, o[db][cb][4 * g + 1] * inv); w.y = pk2(o[db][cb][4 * g + 2] * inv, o[db][cb][4 * g + 3] * inv);
                        *(u32x2*)(MIX + (size_t)qrow * 2048 + (kvh * 4 + 2 * cb + (r32 >> 4)) * 64 + 32 * db + 8 * g + 4 * hh) = w; } }
        }
    }
}
__device__ __forceinline__ void phase_b(const Frame& F, int l) {
    PHASE_BASES();
    const bf16_t* BQ = WSP(bf16_t, WS_BQ); bf16_t* MIX = WSP(bf16_t, WS_MIX);
    const float* kp_p = outp + O_PBK; const float* kp_s = outp + O_SBK; const float* kp_c = GPT(IN_CBK);
    const float* vp_p = outp + O_PBV; const float* vp_s = outp + O_SBV; const float* vp_c = GPT(IN_CBV);
    const int r32 = lane & 31, hh = lane >> 5;
    constexpr int NUP = NB * (T / 32) * 8, NUS = SB * 8;
    for (int unit = F.gw; unit < NUP + NUS; unit += F.NGW) {
        const bool prompt = unit < NUP; const int uu = prompt ? unit : unit - NUP; const int h = uu & 7; int b, row0, qbase;
        if (prompt) { const int qb = (uu >> 3) % (T / 32); b = (uu >> 3) / (T / 32); row0 = b * T + 32 * qb; qbase = 32 * qb; } else { b = uu >> 3; row0 = MP + b * ST; qbase = PAST; }
        const int nk = prompt ? T : LS;
        bf16x8 qf[4];
#pragma unroll
        for (int ks = 0; ks < 4; ++ks) qf[ks] = *(const bf16x8*)(BQ + (size_t)(row0 + r32) * 512 + h * 64 + 16 * ks + 8 * hh);
        f32x16 o[2];
#pragma unroll
        for (int db = 0; db < 2; ++db)
#pragma unroll
            for (int i = 0; i < 16; ++i) o[db][i] = 0.f;
        float R = 0.f; const int qpos = qbase + r32;
        f32x4 kraw[8];
#define B_LOAD_K(kb_) do { const int s_ = 32 * (kb_) + r32; const float* kp_ = kv_row<512>(kp_p, kp_s, kp_c, l, prompt, b, (s_ < nk) ? s_ : 0) + h * 64 + 8 * hh; \
            _Pragma("unroll") for (int ks_ = 0; ks_ < 4; ++ks_) { kraw[2 * ks_] = *(const f32x4*)(kp_ + 16 * ks_); kraw[2 * ks_ + 1] = *(const f32x4*)(kp_ + 16 * ks_ + 4); } } while (0)
        B_LOAD_K((qbase + 31) / 32);
        for (int kb = (qbase + 31) / 32; kb >= 0; --kb) {
            f32x16 sacc;
#pragma unroll
            for (int i = 0; i < 16; ++i) sacc[i] = 0.f;
            { const bool kvalid = 32 * kb + r32 < nk;
#pragma unroll
              for (int ks = 0; ks < 4; ++ks) { f32x4 k0 = kraw[2 * ks], k1 = kraw[2 * ks + 1];
                  if (!kvalid) { k0 = (f32x4){0.f, 0.f, 0.f, 0.f}; k1 = k0; }
                  float kv[8] = {k0.x, k0.y, k0.z, k0.w, k1.x, k1.y, k1.z, k1.w};
                  sacc = MFMA32(pack_bf16x8(kv), qf[ks], sacc); } }
            B_LOAD_K(kb > 0 ? kb - 1 : 0);
            float vv[2][2][8];
#pragma unroll
            for (int ks2 = 0; ks2 < 2; ++ks2)
#pragma unroll
                for (int db = 0; db < 2; ++db)
#pragma unroll
                    for (int j = 0; j < 8; ++j) { const int s = 32 * kb + 16 * ks2 + 8 * (j >> 2) + 4 * hh + (j & 3); vv[ks2][db][j] = (s < nk) ? kv_row<512>(vp_p, vp_s, vp_c, l, prompt, b, s)[h * 64 + 32 * db + r32] : 0.f; }
            float lk[16], zz[16];
#pragma unroll
            for (int i = 0; i < 16; ++i) { const int kpos = 32 * kb + (i & 3) + 8 * (i >> 2) + 4 * hh; const float z = sacc[i] * 0.125f; zz[i] = z; lk[i] = (kpos < qpos) ? -softplus_f(z) : 0.f; }
            float G[4], Go[4];
#pragma unroll
            for (int g = 0; g < 4; ++g) { G[g] = (lk[4 * g] + lk[4 * g + 1]) + (lk[4 * g + 2] + lk[4 * g + 3]); Go[g] = __shfl_xor(G[g], 32); }
            float a[16]; float tail = 0.f;
#pragma unroll
            for (int g = 3; g >= 0; --g) {
                const float tg = tail + (hh == 0 ? Go[g] : 0.f);
                const float s3 = 0.f, s2 = lk[4 * g + 3], s1 = s2 + lk[4 * g + 2], s0 = s1 + lk[4 * g + 1];
                const float sf[4] = {s0, s1, s2, s3};
#pragma unroll
                for (int e = 0; e < 4; ++e) { const int i = 4 * g + e; const int kpos = 32 * kb + e + 8 * g + 4 * hh; a[i] = (kpos < qpos) ? exp_f(zz[i] + lk[i] + R + tg + sf[e]) : 0.f; }
                tail += G[g] + Go[g];
            }
            R += tail;
#pragma unroll
            for (int ks2 = 0; ks2 < 2; ++ks2) {
                float pv[8];
#pragma unroll
                for (int j = 0; j < 8; ++j) pv[j] = a[8 * ks2 + j];
                const bf16x8 pf = pack_bf16x8(pv);
#pragma unroll
                for (int db = 0; db < 2; ++db) o[db] = MFMA32(pack_bf16x8(vv[ks2][db]), pf, o[db]);
            }
            if (__all(R < -40.f)) break;
        }
#pragma unroll
        for (int db = 0; db < 2; ++db)
#pragma unroll
            for (int g = 0; g < 4; ++g) { u32x2 w; w.x = pk2(o[db][4 * g], o[db][4 * g + 1]); w.y = pk2(o[db][4 * g + 2], o[db][4 * g + 3]);
                *(u32x2*)(MIX + (size_t)(row0 + r32) * 2048 + 512 + h * 64 + 32 * db + 8 * g + 4 * hh) = w; }
    }
}
__device__ __forceinline__ void phase_conv(const Frame& F, int l) {
    PHASE_BASES();
    const float* cw = GPT(IN_CONVW) + (size_t)l * 4 * 2048; const float* cb = GPT(IN_CONVB) + (size_t)l * 2048; const float* sconv = GPT(IN_SCONV);
    const bf16_t* CX = WSP(bf16_t, WS_CX); bf16_t* XC = WSP(bf16_t, WS_XC); bf16_t* XCT = WSP(bf16_t, WS_XCT);
    LAS bf16_t* tile = (LAS bf16_t*)(F.lds + F.wave * A1_WAVE_BYTES);
    constexpr int NTILE = (M / 64) * 32, NVT = (M / 64) * 2;
    { bf16_t* AVTP = WSP(bf16_t, WS_AVTP); bf16_t* AVTS = WSP(bf16_t, WS_AVTS) + (size_t)l * SB * 128 * LSP; const float* avp = outp + O_PAV + (size_t)l * MP * 128; const float* avs = outp + O_SAV + (size_t)l * MS * 128;
      for (int it = F.gw; it < NVT; it += F.NGW) {
          const int tc = it & 1, tr = it >> 1, rbase = tr * 64, g8 = lane & 7; const bool pr = rbase < MP;
#pragma unroll 2
          for (int ps = 0; ps < 8; ++ps) { const int rl = ps * 8 + (lane >> 3), row = rbase + rl; const float* sp = (pr ? avp + (size_t)row * 128 : avs + (size_t)(row - MP) * 128) + tc * 64 + 8 * g8;
              const f32x4 a = *(const f32x4*)sp, b4 = *(const f32x4*)(sp + 4); u32x4 w; w.x = pk2(a.x, a.y); w.y = pk2(a.z, a.w); w.z = pk2(b4.x, b4.y); w.w = pk2(b4.z, b4.w);
              *(LAS u32x4*)(tile + rl * 72 + 8 * g8) = w; }
          WAVE_SYNC();
#pragma unroll 2
          for (int rg = 0; rg < 8; ++rg) { unsigned short h[8];
#pragma unroll
              for (int k = 0; k < 8; ++k) h[k] = tile[(8 * rg + k) * 72 + lane];
              u32x4 w; w.x = h[0] | ((unsigned)h[1] << 16); w.y = h[2] | ((unsigned)h[3] << 16); w.z = h[4] | ((unsigned)h[5] << 16); w.w = h[6] | ((unsigned)h[7] << 16);
              const int row = rbase + 8 * rg;
              bf16_t* dst = pr ? AVTP + ((size_t)(row / T) * 128 + tc * 64 + lane) * T + (row % T) : AVTS + ((size_t)((row - MP) / ST) * 128 + tc * 64 + lane) * LSP + PAST + ((row - MP) % ST);
              *(u32x4*)dst = w; }
          WAVE_SYNC();
      } }
    for (int it = F.gw; it < NTILE; it += F.NGW) {
        const int tr = it >> 5, tc = it & 31, rbase = tr * 64, cbase = tc * 64;
        const int g8 = lane & 7, c0 = cbase + 8 * g8;
        float wj[4][8], bs[8];
#pragma unroll
        for (int e = 0; e < 8; ++e) bs[e] = cb[c0 + e];
#pragma unroll
        for (int j = 0; j < 4; ++j)
#pragma unroll
            for (int e = 0; e < 8; ++e) wj[j][e] = cw[j * 2048 + c0 + e];
#pragma unroll 4
        for (int ps = 0; ps < 8; ++ps) {
            const int rl = ps * 8 + (lane >> 3), row = rbase + rl; const RowInfo ri = row_info(row);
            float a[8];
#pragma unroll
            for (int e = 0; e < 8; ++e) a[e] = bs[e];
#pragma unroll
            for (int j = 0; j < 4; ++j) {
                const int tau = ri.t - 3 + j; float x[8];
                if (tau >= 0) { const u32x4 w = *(const u32x4*)(CX + (size_t)(row - ri.t + tau) * 2048 + c0);
                    x[0] = bflo(w.x); x[1] = bfhi(w.x); x[2] = bflo(w.y); x[3] = bfhi(w.y); x[4] = bflo(w.z); x[5] = bfhi(w.z); x[6] = bflo(w.w); x[7] = bfhi(w.w); }
                else if (!ri.prompt) { const float* sp = sconv + ((size_t)(l * SB + ri.b) * 3 + (3 + tau)) * 2048 + c0;
#pragma unroll
                    for (int e = 0; e < 8; ++e) x[e] = sp[e]; }
                else {
#pragma unroll
                    for (int e = 0; e < 8; ++e) x[e] = 0.f; }
#pragma unroll
                for (int e = 0; e < 8; ++e) a[e] += wj[j][e] * x[e];
            }
            float o[8];
#pragma unroll
            for (int e = 0; e < 8; ++e) o[e] = silu_f(a[e]);
            u32x4 w; w.x = pk2(o[0], o[1]); w.y = pk2(o[2], o[3]); w.z = pk2(o[4], o[5]); w.w = pk2(o[6], o[7]);
            if (tc >= 16) *(u32x4*)(XC + (size_t)row * 2048 + c0) = w;
            *(LAS u32x4*)(tile + rl * 72 + 8 * g8) = w;
        }
        WAVE_SYNC();
        if (tc < 24) {
#pragma unroll 2
        for (int rg = 0; rg < 8; ++rg) {
            unsigned short h[8];
#pragma unroll
            for (int k = 0; k < 8; ++k) h[k] = tile[(8 * rg + k) * 72 + lane];
            u32x4 w; w.x = h[0] | ((unsigned)h[1] << 16); w.y = h[2] | ((unsigned)h[3] << 16); w.z = h[4] | ((unsigned)h[5] << 16); w.w = h[6] | ((unsigned)h[7] << 16);
            *(u32x4*)(XCT + (size_t)(cbase + lane) * MPADT + rbase + 8 * rg) = w;
        }
        }
        if (tc < 24 && tr == M / 64 - 1) {
#pragma unroll 2
            for (int rg = 0; rg < 8; ++rg) *(u32x4*)(XCT + (size_t)(cbase + lane) * MPADT + M + 8 * rg) = (u32x4){0u, 0u, 0u, 0u};
        }
        WAVE_SYNC();
    }
}
struct CuInfo { int row0, Tv; bool prompt; int b; };
__device__ __forceinline__ CuInfo cu_info(int cu) { CuInfo c; c.prompt = cu < NB * NC; if (c.prompt) { c.b = cu / NC; c.row0 = c.b * T + (cu - c.b * NC) * 64; c.Tv = 64; } else { c.b = cu - NB * NC; c.row0 = MP + c.b * ST; c.Tv = ST; } return c; }
__device__ __forceinline__ void phase_c1(const Frame& F, int l) {
    PHASE_BASES();
    const float* DT = WSP(float, WS_DT); const bf16_t* XCT = WSP(bf16_t, WS_XCT); bf16_t* CS = WSP(bf16_t, WS_CS); float* CD = WSP(float, WS_CD);
    LAS float* wbuf = (LAS float*)(F.lds + F.wave * A1_WAVE_BYTES);
    const int r32 = lane & 31, hh = lane >> 5;
    for (int it = F.gw; it < NCU * 32; it += F.NGW) {
        const int pb = it & 1, h = (it >> 1) & 15, cu = it >> 5, g = h >> 2; const CuInfo ci = cu_info(cu);
        const float Aneg = -expf(GPT(IN_ALOG)[l * 16 + h]);
        const float dt = (lane < ci.Tv) ? DT[(size_t)(ci.row0 + lane) * 16 + h] : 0.f;
        u32x4 araw[4]; bf16x8 bfr[4][4];
#pragma unroll
        for (int ks = 0; ks < 4; ++ks) araw[ks] = *(const u32x4*)(XCT + (size_t)(h * 64 + 32 * pb + r32) * MPADT + ci.row0 + 16 * ks + 8 * hh);
#pragma unroll
        for (int nb = 0; nb < 4; ++nb)
#pragma unroll
            for (int ks = 0; ks < 4; ++ks) bfr[nb][ks] = *(const bf16x8*)(XCT + (size_t)(1024 + g * 128 + 32 * nb + r32) * MPADT + ci.row0 + 16 * ks + 8 * hh);
        const float acum = wave_incl_scan(dt * Aneg, lane), tot = __shfl(acum, 63);
        wbuf[lane] = dt * exp_f(tot - acum);
        if (pb == 0 && lane == 0) CD[cu * 16 + h] = exp_f(tot);
        WAVE_SYNC();
        bf16x8 af[4];
#pragma unroll
        for (int ks = 0; ks < 4; ++ks) {
            const u32x4 raw = araw[ks];
            const f32x4 w0 = *(const LAS f32x4*)(wbuf + 16 * ks + 8 * hh), w1 = *(const LAS f32x4*)(wbuf + 16 * ks + 8 * hh + 4);
            float v[8] = {bflo(raw.x) * w0[0], bfhi(raw.x) * w0[1], bflo(raw.y) * w0[2], bfhi(raw.y) * w0[3], bflo(raw.z) * w1[0], bfhi(raw.z) * w1[1], bflo(raw.w) * w1[2], bfhi(raw.w) * w1[3]};
            af[ks] = pack_bf16x8(v);
        }
        f32x16 acc[4];
#pragma unroll
        for (int nb = 0; nb < 4; ++nb) {
#pragma unroll
            for (int i = 0; i < 16; ++i) acc[nb][i] = 0.f;
#pragma unroll
            for (int ks = 0; ks < 4; ++ks) acc[nb] = MFMA32(af[ks], bfr[nb][ks], acc[nb]);
        }
        bf16_t* cs = CS + (size_t)(cu * 16 + h) * 8192;
#pragma unroll
        for (int nb = 0; nb < 4; ++nb)
#pragma unroll
            for (int i = 0; i < 16; ++i) cs[(32 * pb + (i & 3) + 8 * (i >> 2) + 4 * hh) * 128 + 32 * nb + r32] = (bf16_t)f2bf(acc[nb][i]);
        WAVE_SYNC();
    }
}
__device__ __forceinline__ void phase_c2(const Frame& F, int l) {
    PHASE_BASES();
    const bf16_t* CS = WSP(bf16_t, WS_CS); const float* CD = WSP(float, WS_CD); bf16_t* ENT = WSP(bf16_t, WS_ENT);
    constexpr int NEP = NB * 16 * 2048, NES = SB * 16 * 2048;
    for (int it = blockIdx.x * 512 + tidl; it < NEP + NES; it += F.G * 512) {
        const bool prompt = it < NEP; const int e = prompt ? it : it - NEP; const int q = e & 2047, h = (e >> 11) & 15, b = e >> 15;
        if (prompt) {
            f32x4 st = (f32x4){0.f, 0.f, 0.f, 0.f};
            constexpr int CB = (NC % 8 == 0) ? 8 : ((NC % 4 == 0) ? 4 : 1);
#pragma unroll 1
            for (int c0 = 0; c0 < NC; c0 += CB) {
                u32x2 cw[CB]; float cdv[CB];
#pragma unroll
                for (int k = 0; k < CB; ++k) { const size_t u = (size_t)((b * NC + c0 + k) * 16 + h); cw[k] = *(const u32x2*)(CS + u * 8192 + q * 4); cdv[k] = CD[u]; }
#pragma unroll
                for (int k = 0; k < CB; ++k) { const size_t u = (size_t)((b * NC + c0 + k) * 16 + h); const f32x4 cs = (f32x4){bflo(cw[k].x), bfhi(cw[k].x), bflo(cw[k].y), bfhi(cw[k].y)};
                    u32x2 w; w.x = pk2(st.x, st.y); w.y = pk2(st.z, st.w); *(u32x2*)(ENT + u * 8192 + q * 4) = w;
                    st = st * cdv[k] + cs; }
            }
            *(f32x4*)(outp + O_PSSM + (((size_t)l * NB + b) * 16 + h) * 8192 + q * 4) = st;
        } else {
            const size_t u = (size_t)((NB * NC + b) * 16 + h);
            f32x4 st = *(const f32x4*)(GPT(IN_SSM) + (((size_t)l * SB + b) * 16 + h) * 8192 + q * 4);
            u32x2 w; w.x = pk2(st.x, st.y); w.y = pk2(st.z, st.w); *(u32x2*)(ENT + u * 8192 + q * 4) = w;
            const u32x2 cw = *(const u32x2*)(CS + u * 8192 + q * 4); const f32x4 cs = (f32x4){bflo(cw.x), bfhi(cw.x), bflo(cw.y), bfhi(cw.y)};
            st = st * CD[u] + cs;
            *(f32x4*)(outp + O_SSSM + (((size_t)l * SB + b) * 16 + h) * 8192 + q * 4) = st;
        }
    }
}
__device__ __forceinline__ void phase_c3(const Frame& F, int l) {
    PHASE_BASES();
    const float* DT = WSP(float, WS_DT); const bf16_t* XC = WSP(bf16_t, WS_XC); const bf16_t* XCT = WSP(bf16_t, WS_XCT); const bf16_t* ENT = WSP(bf16_t, WS_ENT); bf16_t* YC = WSP(bf16_t, WS_YC);
    LAS float* abuf = (LAS float*)(F.lds + F.wave * A1_WAVE_BYTES);
    LAS float* dbuf = abuf + 64;
    const int r32 = lane & 31, hh = lane >> 5;
    for (int it = F.gw; it < NCU * 32; it += F.NGW) {
        const int tb = it & 1, h = (it >> 1) & 15, cu = it >> 5, g = h >> 2; const CuInfo ci = cu_info(cu);
        if (32 * tb >= ci.Tv) continue;
        const float Aneg = -expf(GPT(IN_ALOG)[l * 16 + h]), Dk = GPT(IN_CD)[l * 16 + h];
        const float dt = (lane < ci.Tv) ? DT[(size_t)(ci.row0 + lane) * 16 + h] : 0.f;
        bf16x8 cmf[8], entf[2][8];
#pragma unroll
        for (int ks = 0; ks < 8; ++ks) cmf[ks] = *(const bf16x8*)(XC + (size_t)(ci.row0 + 32 * tb + r32) * 2048 + 1536 + g * 128 + 16 * ks + 8 * hh);
#pragma unroll
        for (int pb = 0; pb < 2; ++pb)
#pragma unroll
            for (int ks = 0; ks < 8; ++ks) entf[pb][ks] = *(const bf16x8*)(ENT + ((size_t)(cu * 16 + h) * 64 + 32 * pb + r32) * 128 + 16 * ks + 8 * hh);
        const float acum = wave_incl_scan(dt * Aneg, lane);
        abuf[lane] = acum; dbuf[lane] = dt;
        const float acum_t = __shfl(acum, 32 * tb + r32);
        WAVE_SYNC();
        f32x16 y[2];
#pragma unroll
        for (int pb = 0; pb < 2; ++pb)
#pragma unroll
            for (int i = 0; i < 16; ++i) y[pb][i] = 0.f;
        for (int sb = 0; sb <= tb; ++sb) {
            f32x16 ga;
#pragma unroll
            for (int i = 0; i < 16; ++i) ga[i] = 0.f;
#pragma unroll
            for (int ks = 0; ks < 8; ++ks) { const bf16x8 bmf = *(const bf16x8*)(XC + (size_t)(ci.row0 + 32 * sb + r32) * 2048 + 1024 + g * 128 + 16 * ks + 8 * hh); ga = MFMA32(bmf, cmf[ks], ga); }
            const int tt = 32 * tb + r32;
#pragma unroll
            for (int q = 0; q < 4; ++q) {
                const f32x4 as = *(const LAS f32x4*)(abuf + 32 * sb + 8 * q + 4 * hh), ds = *(const LAS f32x4*)(dbuf + 32 * sb + 8 * q + 4 * hh);
#pragma unroll
                for (int e = 0; e < 4; ++e) { const int ss = 32 * sb + 8 * q + 4 * hh + e; ga[4 * q + e] = (ss <= tt) ? ga[4 * q + e] * exp_f(acum_t - as[e]) * ds[e] : 0.f; }
            }
#pragma unroll
            for (int ks2 = 0; ks2 < 2; ++ks2) {
                float pv[8];
#pragma unroll
                for (int j = 0; j < 8; ++j) pv[j] = ga[8 * ks2 + j];
                const bf16x8 pa = pack_bf16x8(pv);
#pragma unroll
                for (int pb = 0; pb < 2; ++pb) {
                    const bf16_t* xp = XCT + (size_t)(h * 64 + 32 * pb + r32) * MPADT + ci.row0 + 32 * sb + 16 * ks2 + 4 * hh;
                    const u32x2 x0 = *(const u32x2*)xp, x1 = *(const u32x2*)(xp + 8);
                    const u32x4 xw = (u32x4){x0.x, x0.y, x1.x, x1.y};
                    y[pb] = MFMA32(pa, __builtin_bit_cast(bf16x8, xw), y[pb]);
                }
            }
        }
        float ea[16];
#pragma unroll
        for (int q = 0; q < 4; ++q) { const f32x4 at = *(const LAS f32x4*)(abuf + 32 * tb + 8 * q + 4 * hh);
#pragma unroll
            for (int e = 0; e < 4; ++e) ea[4 * q + e] = exp_f(at[e]); }
#pragma unroll
        for (int pb = 0; pb < 2; ++pb) {
            f32x16 yo;
#pragma unroll
            for (int i = 0; i < 16; ++i) yo[i] = 0.f;
#pragma unroll
            for (int ks = 0; ks < 8; ++ks) yo = MFMA32(cmf[ks], entf[pb][ks], yo);
            const bf16_t* xp = XCT + (size_t)(h * 64 + 32 * pb + r32) * MPADT + ci.row0 + 32 * tb + 4 * hh;
#pragma unroll
            for (int q = 0; q < 4; ++q) { const u32x2 xw = *(const u32x2*)(xp + 8 * q); const float xs[4] = {bflo(xw.x), bfhi(xw.x), bflo(xw.y), bfhi(xw.y)};
#pragma unroll
                for (int e = 0; e < 4; ++e) { const int i = 4 * q + e; const float val = y[pb][i] + ea[i] * yo[i] + Dk * xs[e]; const int tl = 32 * tb + 8 * q + 4 * hh + e;
                    if (tl < ci.Tv) YC[(size_t)(ci.row0 + tl) * 1024 + h * 64 + 32 * pb + r32] = (bf16_t)f2bf(val); } }
        }
        WAVE_SYNC();
    }
}
__device__ __forceinline__ void phase_gn(const Frame& F, int l) {
    PHASE_BASES();
    const bf16_t* YC = WSP(bf16_t, WS_YC); const bf16_t* CZ = WSP(bf16_t, WS_CZ); bf16_t* MIX = WSP(bf16_t, WS_MIX); const float* cng = GPT(IN_CNG) + l * 1024;
    f32x4 ng[4];
#pragma unroll
    for (int g = 0; g < 4; ++g) ng[g] = *(const f32x4*)(cng + g * 256 + 4 * lane);
    u32x2 yw[4], zw[4], ywn[4], zwn[4];
#define GN_LOAD(Y_, Z_, row_) do { _Pragma("unroll") for (int g = 0; g < 4; ++g) { Y_[g] = *(const u32x2*)(YC + (size_t)(row_) * 1024 + g * 256 + 4 * lane); Z_[g] = *(const u32x2*)(CZ + (size_t)(row_) * 1024 + g * 256 + 4 * lane); } } while (0)
    if (F.gw < M) GN_LOAD(yw, zw, F.gw);
    for (int row = F.gw; row < M; row += F.NGW) {
        { const int rn = (row + F.NGW < M) ? row + F.NGW : row; GN_LOAD(ywn, zwn, rn); }
        float v[4][4], ss[4];
#pragma unroll
        for (int g = 0; g < 4; ++g) { v[g][0] = bflo(yw[g].x) * silu_f(bflo(zw[g].x)); v[g][1] = bfhi(yw[g].x) * silu_f(bfhi(zw[g].x)); v[g][2] = bflo(yw[g].y) * silu_f(bflo(zw[g].y)); v[g][3] = bfhi(yw[g].y) * silu_f(bfhi(zw[g].y));
            ss[g] = (v[g][0] * v[g][0] + v[g][1] * v[g][1]) + (v[g][2] * v[g][2] + v[g][3] * v[g][3]); }
#pragma unroll
        for (int o = 1; o < 64; o <<= 1) {
#pragma unroll
            for (int g = 0; g < 4; ++g) ss[g] += __shfl_xor(ss[g], o); }
#pragma unroll
        for (int g = 0; g < 4; ++g) { const float rn = FAST_RSQ(ss[g] * (1.0f / 256.0f) + EPSN);
            u32x2 o; o.x = pk2(v[g][0] * rn * ng[g].x, v[g][1] * rn * ng[g].y); o.y = pk2(v[g][2] * rn * ng[g].z, v[g][3] * rn * ng[g].w);
            *(u32x2*)(MIX + (size_t)row * 2048 + 1024 + g * 256 + 4 * lane) = o; }
#pragma unroll
        for (int g = 0; g < 4; ++g) { yw[g] = ywn[g]; zw[g] = zwn[g]; }
    }
}

#ifndef PHMASK
#define PHMASK 0xFFFFFFFFu
#endif
#ifndef PROBE_DUP
#define PROBE_DUP 0u
#endif
#define DUP(j) ((PROBE_DUP >> (j)) & 1u)
__global__ void __launch_bounds__(512, 2) mega(Args args) {
    DYN_LDS(lds);
    Frame F;
    F.lds = (LAS unsigned char*)lds;
    F.tid = threadIdx.x; F.lane = F.tid & 63;
#ifdef HOST_EMU
    F.wave = F.tid >> 6;
#else
    F.wave = __builtin_amdgcn_readfirstlane(F.tid >> 6);
#endif
    F.G = gridDim.x; F.gw = blockIdx.x * 8 + F.wave; F.NGW = F.G * 8;
    F.out = args.out; F.ws = args.ws;
#ifndef HOST_EMU
    volatile LAS unsigned* MISC = (volatile LAS unsigned*)(F.lds + MISC_OFF);
    if (F.tid < 64) MISC[F.tid] = 0u;
    __syncthreads();
    XcdBarrier bar = xcd_barrier_post((unsigned*)(args.ws + WS_CTL) + CW_BAR, MISC + 8);
#define GRID_BAR() xcd_barrier(bar)
#else
#define GRID_BAR() do { } while (0)
#endif
    const int lo = args.ph_lo, hi = args.ph_hi;
#define IN(k) (lo <= (k) && (k) < hi)
#define SEAM(k) do { if (IN(k) && IN((k) + 1)) GRID_BAR(); } while (0)
#define PHON(j) ((PHMASK >> (j)) & 1u)
    if (IN(0) && PHON(31)) { phase_prologue(F, args); if (DUP(31)) { GRID_BAR(); phase_prologue(F, args); } }
    SEAM(0);
    for (int l = 0; l < NL; ++l) {
        const int pb = 1 + l * PH_PER_LAYER;
        if (IN(pb + PH_G1) && PHON(PH_G1)) {
            PHASE_BASES();
            pg8::Gemm g{WSP(bf16_t, WS_XB), WSP(bf16_t, WS_WIN) + (size_t)l * NIN * D, M, NIN, D, D}; pg8::StaticOrder S; S.init(M, NIN, F.G, (int)blockIdx.x);
            EpiIn E{l, ws, outp};
            pg8::gemm_phase<EpiIn, pg8::StaticOrder, true, true>(F.lds, g, S, E);
            if (DUP(PH_G1)) { GRID_BAR(); pg8::gemm_phase<EpiIn, pg8::StaticOrder, true, true>(F.lds, g, S, E); }
        }
        SEAM(pb + PH_G1);
        if (IN(pb + PH_A1) && PHON(PH_A1)) { phase_a1(F, l); if (DUP(PH_A1)) { GRID_BAR(); phase_a1(F, l, 2); } }
        if (IN(pb + PH_CONV) && PHON(PH_CONV)) { phase_conv(F, l); if (DUP(PH_CONV)) { GRID_BAR(); phase_conv(F, l); } }
        SEAM(pb + PH_CONV);
        if (IN(pb + PH_A2) && PHON(PH_A2)) { phase_a2(F, l); if (DUP(PH_A2)) { GRID_BAR(); phase_a2(F, l, 2); } }
        if (IN(pb + PH_B) && PHON(PH_B)) { phase_b(F, l); if (DUP(PH_B)) { GRID_BAR(); phase_b(F, l); } }
        if (IN(pb + PH_C1) && PHON(PH_C1)) { phase_c1(F, l); if (DUP(PH_C1)) { GRID_BAR(); phase_c1(F, l); } }
        SEAM(pb + PH_C1);
        if (IN(pb + PH_C2) && PHON(PH_C2)) { phase_c2(F, l); if (DUP(PH_C2)) { GRID_BAR(); phase_c2(F, l); } }
        SEAM(pb + PH_C2);
        if (IN(pb + PH_C3) && PHON(PH_C3)) { phase_c3(F, l); if (DUP(PH_C3)) { GRID_BAR(); phase_c3(F, l); } }
        SEAM(pb + PH_C3);
        if (IN(pb + PH_GN) && PHON(PH_GN)) { phase_gn(F, l); if (DUP(PH_GN)) { GRID_BAR(); phase_gn(F, l); } }
        SEAM(pb + PH_GN);
        if (IN(pb + PH_G2) && PHON(PH_G2)) {
            PHASE_BASES();
            { pg8::Gemm g{WSP(bf16_t, WS_MIX), WSP(bf16_t, WS_WOUT) + (size_t)l * D * D, MP, D, D, D}; pg8::StaticOrder S; S.init(MP, D, F.G, (int)blockIdx.x);
              EpiOut E{outp + O_Y, ws, l};
              pg8::gemm_phase<EpiOut, pg8::StaticOrder, true, true>(F.lds, g, S, E); }
            { pg8::Gemm g{WSP(bf16_t, WS_MIX), WSP(bf16_t, WS_WOUT) + (size_t)l * D * D, M, D, D, D / NSL2}; pg8::TailOrder S; S.init(MP / 256, MS / 256, D, NSL2, D / NSL2, F.G, (int)blockIdx.x);
              EpiTail E{WSP(float, WS_PART), (D / NSL2) * 2};
              pg8::gemm_phase<EpiTail, pg8::TailOrder, true, true>(F.lds, g, S, E); }
        }
        SEAM(pb + PH_G2);
        if (IN(pb + PH_F2) && PHON(PH_F2)) phase_fin(F, 2 * l + 1, NSL2, true);
        SEAM(pb + PH_F2);
        if (IN(pb + PH_G3) && PHON(PH_G3)) {
            PHASE_BASES();
            pg8::Gemm g{WSP(bf16_t, WS_XB), WSP(bf16_t, WS_WGU) + (size_t)l * NGU * D, M, NGU, D, D}; pg8::StaticOrder S; S.init(M, NGU, F.G, (int)blockIdx.x);
            EpiGU E{ws, l};
            pg8::gemm_phase<EpiGU, pg8::StaticOrder, true, true>(F.lds, g, S, E);
            if (DUP(PH_G3)) { GRID_BAR(); pg8::gemm_phase<EpiGU, pg8::StaticOrder, true, true>(F.lds, g, S, E); }
        }
        SEAM(pb + PH_G3);
        if (IN(pb + PH_G4) && PHON(PH_G4)) {
            PHASE_BASES();
            { pg8::Gemm g{WSP(bf16_t, WS_HMID), WSP(bf16_t, WS_WDN) + (size_t)l * D * DFF, MP, D, DFF, DFF}; pg8::StaticOrder S; S.init(MP, D, F.G, (int)blockIdx.x);
              EpiDown E{outp + O_Y, ws, l};
              pg8::gemm_phase<EpiDown, pg8::StaticOrder, true, true>(F.lds, g, S, E); }
            { pg8::Gemm g{WSP(bf16_t, WS_HMID), WSP(bf16_t, WS_WDN) + (size_t)l * D * DFF, M, D, DFF, DFF / NSL4}; pg8::TailOrder S; S.init(MP / 256, MS / 256, D, NSL4, DFF / NSL4, F.G, (int)blockIdx.x);
              EpiTail E{WSP(float, WS_PART), (DFF / NSL4) * 2};
              pg8::gemm_phase<EpiTail, pg8::TailOrder, true, true>(F.lds, g, S, E); }
        }
        SEAM(pb + PH_G4);
        if (IN(pb + PH_F4) && PHON(PH_F4)) phase_fin(F, 2 * l + 2, NSL4, l + 1 < NL);
        SEAM(pb + PH_F4);
    }
#undef IN
#undef SEAM
}

#ifndef HOST_EMU
extern "C" void kernel_launch(void* const* d_in, const int* in_sizes, int n_in, void* d_out, int out_size, void* d_ws, size_t ws_size, hipStream_t stream) {
    static int grid = 0;
    if (grid == 0) {
        if (n_in != 27 || (size_t)out_size != O_END || ws_size < WS_END) { fprintf(stderr, "kernel_launch: unexpected sizes (n_in %d, out %d, ws %zu; need %zu / %zu)\n", n_in, out_size, ws_size, (size_t)O_END, (size_t)WS_END); grid = -1; return; }
        int dev = 0, cus = 0, per_cu = 0;
        if (hipGetDevice(&dev) != hipSuccess || hipDeviceGetAttribute(&cus, hipDeviceAttributeMultiprocessorCount, dev) != hipSuccess) { grid = -1; return; }
        if (hipFuncSetAttribute((const void*)mega, hipFuncAttributeMaxDynamicSharedMemorySize, LDS_BYTES) != hipSuccess) { fprintf(stderr, "kernel_launch: hipFuncSetAttribute failed\n"); grid = -1; return; }
        if (hipOccupancyMaxActiveBlocksPerMultiprocessor(&per_cu, (const void*)mega, 512, LDS_BYTES) != hipSuccess || per_cu < 1) fprintf(stderr, "kernel_launch: occupancy query reports %d\n", per_cu);
        (void)hipGetLastError();
        grid = cus;
    }
    if (grid < 0) return;
    if (hipMemsetAsync((char*)d_ws + WS_CTL, 0, CTL_ZERO_BYTES, stream) != hipSuccess) return;
    Args a{};
    for (int i = 0; i < 27; ++i) a.in[i] = (const float*)d_in[i];
    a.out = (float*)d_out; a.ws = (unsigned char*)d_ws;
#if ONE_LAUNCH
    a.ph_lo = 0; a.ph_hi = NPH;
    hipLaunchKernelGGL(mega, dim3(grid), dim3(512), LDS_BYTES, stream, a);
#else
    for (int ph = 0; ph < NPH; ++ph) { a.ph_lo = ph; a.ph_hi = ph + 1; hipLaunchKernelGGL(mega, dim3(grid), dim3(512), LDS_BYTES, stream, a); }
#endif
}
#endif
```

```cpp
#ifndef HOST_EMU
#include <hip/hip_runtime.h>
#endif
#include <cstdio>
#include <cstdint>
#include <cmath>

#ifndef CFG_BATCH
#define CFG_BATCH 4
#endif
#ifndef CFG_SEQ
#define CFG_SEQ 4096
#endif
#ifndef CFG_DEC_BATCH
#define CFG_DEC_BATCH 32
#endif
#ifndef CFG_PAST
#define CFG_PAST 4096
#endif
#ifndef CFG_DFF
#define CFG_DFF 5632
#endif
#ifndef ONE_LAUNCH
#define ONE_LAUNCH 1
#endif

#ifdef HOST_EMU
#define LAS
#define GAS
#define DYN_LDS(name) unsigned char* name = emu::B->lds
#define WAVE_SYNC() emu::wave_barrier()
#define MFMA32(a, b, c) emu_mfma32(a, b, c)
#define FAST_EXP2(x) exp2f(x)
#define FAST_LOG2(x) log2f(x)
#define FAST_RCP(x) (1.0f / (x))
#define FAST_RSQ(x) (1.0f / sqrtf(x))
#define MFMA16(a, b, c) emu_mfma16(a, b, c)
#else
#define LAS __attribute__((address_space(3)))
#define GAS __attribute__((address_space(1)))
#define DYN_LDS(name) extern __shared__ __attribute__((aligned(16))) unsigned char name[]
#define WAVE_SYNC() do { asm volatile("s_waitcnt lgkmcnt(0)" ::: "memory"); __builtin_amdgcn_wave_barrier(); } while (0)
#define MFMA32(a, b, c) __builtin_amdgcn_mfma_f32_32x32x16_bf16(a, b, c, 0, 0, 0)
#define FAST_EXP2(x) __builtin_amdgcn_exp2f(x)
#define FAST_LOG2(x) __builtin_amdgcn_logf(x)
#define FAST_RCP(x) __builtin_amdgcn_rcpf(x)
#define FAST_RSQ(x) __builtin_amdgcn_rsqf(x)
#define MFMA16(a, b, c) __builtin_amdgcn_mfma_f32_16x16x32_bf16(a, b, c, 0, 0, 0)
#endif
namespace pg8 {
#define PG8_LAS __attribute__((address_space(3)))
typedef unsigned short bf16_t;
typedef short bf16x8 __attribute__((ext_vector_type(8)));
typedef float f32x4 __attribute__((ext_vector_type(4)));
typedef unsigned u32x4 __attribute__((ext_vector_type(4)));
constexpr int BM = 256, BK = 64, HALF = 128, HTB = HALF * BK * 2  , STAGE_BYTES = 8 * HTB, NXCD = 8, WGM = 8;

__host__ __device__ __forceinline__ int lds_byte(int r, int c) { const int st = (r >> 4) * 2 + (c >> 5), rr = r & 15, cc = c & 31, ob = rr * 64 + cc * 2; return st * 1024 + (ob ^ (((ob >> 9) & 1) << 5)); }
__host__ __device__ __forceinline__ void stage_rc(int b, int& R, int& C) { const int st = b / 1024, sb = b % 1024, swz = sb ^ (((sb >> 9) & 1) << 5); R = (st >> 1) * 16 + swz / 64; C = (st & 1) * 32 + (swz % 64) / 2; }
__host__ __device__ __forceinline__ int perm32(int rho) { const int n = rho >> 4, i = rho & 15; return 8 * (i >> 2) + 4 * n + (i & 3); }

struct Unit { int pm, pn, kofs; };
struct Gemm { const bf16_t* A; const bf16_t* Bt; int M, N, K, Klen; };

struct StaticOrder {
    int nM, nN, nwg, G, c;
    __host__ __device__ void init(int M, int N, int G_, int c_) { nM = M / BM; nN = N / BM; nwg = nM * nN; G = G_; c = c_; }
    __host__ __device__ bool next(int i, Unit& u) const {
        const long L = (long)i * G + c; if (L >= nwg) return false;
        int wgid = (int)L; { const int q = nwg / NXCD, r = nwg % NXCD, xcd = wgid % NXCD, off = wgid / NXCD; wgid = (xcd < r ? xcd * (q + 1) : r * (q + 1) + (xcd - r) * q) + off; }
        const int nig = WGM * nN, gid = wgid / nig, fm = gid * WGM, gsz = (nM - fm) < WGM ? (nM - fm) : WGM;
        u.pm = fm + ((wgid % nig) % gsz); u.pn = (wgid % nig) / gsz; u.kofs = 0; return true;
    }
    __device__ __forceinline__ void a_ready(const Unit&) const {}
    __device__ __forceinline__ void done(const Unit&) const {}
};

struct TailOrder {
    int pm0, nN, ntile, nsl, klen_bytes, G, c;
    __host__ __device__ void init(int pm0_, int nM_, int N, int nsl_, int Klen, int G_, int c_) { pm0 = pm0_; nN = N / BM; ntile = nM_ * nN; nsl = nsl_; klen_bytes = Klen * 2; G = G_; c = c_; }
    __host__ __device__ bool next(int i, Unit& u) const {
        const long L = (long)i * G + c; if (L >= (long)ntile * nsl) return false;
        const int tile = (int)(L / nsl), sl = (int)(L % nsl); u.pm = pm0 + tile / nN; u.pn = tile % nN; u.kofs = sl * klen_bytes; return true;
    }
    __device__ __forceinline__ void a_ready(const Unit&) const {}
    __device__ __forceinline__ void done(const Unit&) const {}
};

#ifdef HOST_EMU
__device__ __forceinline__ unsigned cvt_pk_bf16(float lo, float hi) {
    auto f2b = [](float f) { unsigned u = __builtin_bit_cast(unsigned, f); return (u + 0x7fffu + ((u >> 16) & 1u)) >> 16; };
    return f2b(lo) | (f2b(hi) << 16);
}
#else
__device__ __forceinline__ unsigned cvt_pk_bf16(float lo, float hi) { unsigned r; asm volatile("v_cvt_pk_bf16_f32 %0, %1, %2" : "=v"(r) : "v"(lo), "v"(hi)); return r; }
#endif
typedef unsigned u32x4 __attribute__((ext_vector_type(4)));
#ifndef HOST_EMU
template <class Epi, class Sched, bool ALIGN_EPI = false, bool SP2 = false>
__device__ __forceinline__ void gemm_phase(PG8_LAS unsigned char* lds, const Gemm g, const Sched& S, const Epi& E) {
    int tid_l = threadIdx.x; asm volatile("" : "+v"(tid_l));
    const int tid = tid_l, wid = __builtin_amdgcn_readfirstlane(tid >> 6), lane = tid & 63, wr = wid >> 2, wc = wid & 3, fr = lane & 15, fq = lane >> 4;
    const int K = g.K, nt = g.Klen / BK;
    unsigned voffA[2], voffB[2];
#pragma unroll
    for (int i = 0; i < 2; ++i) { int R, C; stage_rc(tid * 16 + i * 8192, R, C); const int Rb = Epi::PERM ? ((R & ~31) + perm32(R & 31)) : R;
        voffA[i] = (unsigned)(R * K + C) * 2u; voffB[i] = (unsigned)(Rb * K + C) * 2u; }
    const size_t kstep = (size_t)(BK * 2);
    const size_t hstep = (size_t)HALF * K * 2;
    const size_t tstep = 2 * hstep;
    const unsigned ldsw = (unsigned)wid * 1024u;
    const int aoff = lds_byte(wr * 64 + fr, fq * 8), boff = lds_byte(wc * 32 + fr, fq * 8);
#define PG8_SA(b, h) (((b) * 2 + (h)) * HTB)
#define PG8_SB(b, h) ((4 + (b) * 2 + (h)) * HTB)
#define PG8_STAGE(bufoff, gbase, voff) do { _Pragma("unroll") for (int _i = 0; _i < 2; ++_i) \
        __builtin_amdgcn_global_load_lds((const unsigned*)((const char*)(gbase) + (voff)[_i]), (PG8_LAS unsigned*)(lds + (bufoff) + ldsw + _i * 8192), 16, 0, 0); } while (0)
#define PG8_LDA(dst, b, h) do { _Pragma("unroll") for (int m = 0; m < 4; ++m) _Pragma("unroll") for (int k = 0; k < 2; ++k) dst[m][k] = *(const PG8_LAS bf16x8*)(lds + PG8_SA(b, h) + aoff + m * 2048 + k * 1024); } while (0)
#define PG8_LDB(dst, b, h) do { _Pragma("unroll") for (int n = 0; n < 2; ++n) _Pragma("unroll") for (int k = 0; k < 2; ++k) dst[n][k] = *(const PG8_LAS bf16x8*)(lds + PG8_SB(b, h) + boff + n * 2048 + k * 1024); } while (0)
#define PG8_MMA(ai, bj, At, Bt) do { __builtin_amdgcn_s_setprio(1); _Pragma("unroll") for (int m = 0; m < 4; ++m) _Pragma("unroll") for (int n = 0; n < 2; ++n) _Pragma("unroll") for (int k = 0; k < 2; ++k) \
        acc[ai][bj][m][n] = __builtin_amdgcn_mfma_f32_16x16x32_bf16(Bt[n][k], At[m][k], acc[ai][bj][m][n], 0, 0, 0); __builtin_amdgcn_s_setprio(0); } while (0)
#define PG8_WAIT_V(n) asm volatile("s_waitcnt vmcnt(" #n ")" ::: "memory")
#define PG8_WAIT_L(n) asm volatile("s_waitcnt lgkmcnt(" #n ")" ::: "memory")
#define PG8_BAR __builtin_amdgcn_s_barrier()
#define PG8_SCHED __builtin_amdgcn_sched_barrier(0)
    Unit cur, nxt; int ui = 0;
    if (!S.next(0, cur)) return;
    f32x4 acc[2][2][4][2];
#pragma unroll
    for (int a = 0; a < 2; ++a)
#pragma unroll
        for (int b = 0; b < 2; ++b)
#pragma unroll
            for (int m = 0; m < 4; ++m)
#pragma unroll
                for (int n = 0; n < 2; ++n) acc[a][b][m][n] = (f32x4){0.f, 0.f, 0.f, 0.f};
    bf16x8 At[4][2], B0[2][2], B1[2][2];
    const char* cA = (const char*)g.A + (size_t)cur.pm * tstep + cur.kofs; const char* cB = (const char*)g.Bt + (size_t)cur.pn * tstep + cur.kofs;
    S.a_ready(cur);
    if constexpr (SP2) {
        PG8_STAGE(PG8_SB(0, 0), cB, voffB); PG8_STAGE(PG8_SB(0, 1), cB + hstep, voffB); PG8_STAGE(PG8_SA(0, 0), cA, voffA); PG8_STAGE(PG8_SA(0, 1), cA + hstep, voffA);
        if (wr == 1) PG8_BAR;
        PG8_WAIT_V(2); PG8_BAR;
        PG8_STAGE(PG8_SB(1, 0), cB + kstep, voffB); PG8_STAGE(PG8_SA(1, 0), cA + kstep, voffA); PG8_STAGE(PG8_SB(1, 1), cB + hstep + kstep, voffB);
        PG8_WAIT_V(6); PG8_BAR;
    } else {
        PG8_STAGE(PG8_SB(0, 0), cB, voffB); PG8_STAGE(PG8_SA(0, 0), cA, voffA); PG8_STAGE(PG8_SB(0, 1), cB + hstep, voffB); PG8_STAGE(PG8_SA(0, 1), cA + hstep, voffA);
        if (wr == 1) PG8_BAR;
        PG8_WAIT_V(4); PG8_BAR;
        PG8_STAGE(PG8_SB(1, 0), cB + kstep, voffB); PG8_STAGE(PG8_SA(1, 0), cA + kstep, voffA); PG8_STAGE(PG8_SB(1, 1), cB + hstep + kstep, voffB);
        PG8_WAIT_V(6); PG8_BAR;
    }
    for (;;) {
        const bool has_next = S.next(ui + 1, nxt);
        const char* nA = has_next ? (const char*)g.A + (size_t)nxt.pm * tstep + nxt.kofs : cA; const char* nB = has_next ? (const char*)g.Bt + (size_t)nxt.pn * tstep + nxt.kofs : cB;
        for (int t = 0; t < nt; t += 2) {
            const bool last = (t == nt - 2);
            const char* a1 = cA + (size_t)(t + 1) * kstep;
            const char* a2 = last ? nA : cA + (size_t)(t + 2) * kstep; const char* b2 = last ? nB : cB + (size_t)(t + 2) * kstep;
            const char* a3 = a2 + kstep; const char* b3 = b2 + kstep;
            if (last && has_next) S.a_ready(nxt);
            if constexpr (SP2) {
            PG8_LDB(B0, 0, 0); PG8_LDB(B1, 0, 1); PG8_SCHED; PG8_LDA(At, 0, 0); PG8_STAGE(PG8_SA(1, 1), a1 + hstep, voffA);
            PG8_WAIT_V(8); PG8_WAIT_L(0); PG8_BAR; PG8_MMA(0, 0, At, B0); PG8_MMA(0, 1, At, B1); PG8_BAR; PG8_SCHED;
            PG8_LDA(At, 0, 1); PG8_STAGE(PG8_SB(0, 0), b2, voffB); PG8_STAGE(PG8_SB(0, 1), b2 + hstep, voffB); PG8_STAGE(PG8_SA(0, 0), a2, voffA);
            PG8_WAIT_V(8); PG8_WAIT_L(0); PG8_BAR; PG8_MMA(1, 0, At, B0); PG8_MMA(1, 1, At, B1); PG8_BAR; PG8_SCHED;
            PG8_LDB(B0, 1, 0); PG8_LDB(B1, 1, 1); PG8_SCHED; PG8_LDA(At, 1, 0); PG8_STAGE(PG8_SA(0, 1), a2 + hstep, voffA);
            PG8_WAIT_V(8); PG8_WAIT_L(0); PG8_BAR; PG8_MMA(0, 0, At, B0); PG8_MMA(0, 1, At, B1); PG8_BAR; PG8_SCHED;
            PG8_LDA(At, 1, 1); PG8_STAGE(PG8_SB(1, 0), b3, voffB); PG8_STAGE(PG8_SB(1, 1), b3 + hstep, voffB); PG8_STAGE(PG8_SA(1, 0), a3, voffA);
            PG8_WAIT_V(8); PG8_WAIT_L(0); PG8_BAR; PG8_MMA(1, 0, At, B0); PG8_MMA(1, 1, At, B1); PG8_BAR; PG8_SCHED;
            } else {
            PG8_LDB(B0, 0, 0); PG8_SCHED; PG8_LDA(At, 0, 0); PG8_STAGE(PG8_SA(1, 1), a1 + hstep, voffA);
            PG8_WAIT_L(8); PG8_BAR; PG8_WAIT_L(0); PG8_MMA(0, 0, At, B0); PG8_BAR; PG8_SCHED;
            PG8_LDB(B1, 0, 1); PG8_STAGE(PG8_SB(0, 0), b2, voffB);
            PG8_BAR; PG8_WAIT_L(0); PG8_MMA(0, 1, At, B1); PG8_BAR;
            PG8_LDA(At, 0, 1); PG8_STAGE(PG8_SA(0, 0), a2, voffA);
            PG8_BAR; PG8_WAIT_L(0); PG8_MMA(1, 0, At, B0); PG8_BAR; PG8_SCHED;
            PG8_STAGE(PG8_SB(0, 1), b2 + hstep, voffB);
            PG8_WAIT_V(6); PG8_BAR; PG8_MMA(1, 1, At, B1); PG8_BAR;
            PG8_LDB(B0, 1, 0); PG8_SCHED; PG8_LDA(At, 1, 0); PG8_STAGE(PG8_SA(0, 1), a2 + hstep, voffA);
            PG8_WAIT_L(8); PG8_BAR; PG8_WAIT_L(0); PG8_MMA(0, 0, At, B0); PG8_BAR; PG8_SCHED;
            PG8_LDB(B1, 1, 1); PG8_STAGE(PG8_SB(1, 0), b3, voffB);
            PG8_BAR; PG8_WAIT_L(0); PG8_MMA(0, 1, At, B1); PG8_BAR;
            PG8_LDA(At, 1, 1); PG8_STAGE(PG8_SA(1, 0), a3, voffA);
            PG8_BAR; PG8_WAIT_L(0); PG8_MMA(1, 0, At, B0); PG8_BAR; PG8_SCHED;
            PG8_STAGE(PG8_SB(1, 1), b3 + hstep, voffB);
            PG8_WAIT_V(6); PG8_BAR; PG8_MMA(1, 1, At, B1); PG8_BAR;
            }
        }
        if constexpr (ALIGN_EPI) { if (wr == 0) PG8_BAR; }
        if constexpr (!Epi::AFTER_DRAIN) { int fr_e = fr, fq_e = fq; asm volatile("" : "+v"(fr_e), "+v"(fq_e));
            E(acc, cur, wr, wc, fr_e, fq_e); S.done(cur); }
        if (!has_next) break;
#pragma unroll
        for (int a = 0; a < 2; ++a)
#pragma unroll
            for (int b = 0; b < 2; ++b)
#pragma unroll
                for (int m = 0; m < 4; ++m)
#pragma unroll
                    for (int n = 0; n < 2; ++n) acc[a][b][m][n] = (f32x4){0.f, 0.f, 0.f, 0.f};
        cur = nxt; cA = nA; cB = nB; ++ui;
        if constexpr (ALIGN_EPI) { if (wr == 1) PG8_BAR; }
    }
    PG8_WAIT_V(0);
    if constexpr (!ALIGN_EPI) { if (wr == 0) PG8_BAR; }
    PG8_BAR;
    if constexpr (Epi::AFTER_DRAIN) { E.fused(acc, cur, wr, wc, fr, fq, lds, wid, lane); S.done(cur); }
#undef PG8_SA
#undef PG8_SB
#undef PG8_STAGE
#undef PG8_LDA
#undef PG8_LDB
#undef PG8_MMA
#undef PG8_WAIT_V
#undef PG8_WAIT_L
#undef PG8_BAR
#undef PG8_SCHED
}
#else
template <class Epi, class Sched, bool ALIGN_EPI = false, bool SP2 = false>
inline void gemm_phase(unsigned char* lds, const Gemm g, const Sched& S, const Epi& E) {
    (void)lds;
    static thread_local float* pa = nullptr; static thread_local float* pb = nullptr;
    const int tid = threadIdx.x, wid = tid >> 6, lane = tid & 63, wr = wid >> 2, wc = wid & 3, fr = lane & 15, fq = lane >> 4;
    const int K = g.K, KL = g.Klen;
    if (tid == 0 && !pa) { pa = (float*)malloc(256 * 8192 * 4); pb = (float*)malloc(256 * 8192 * 4); }
    __syncthreads();
    Unit cur;
    for (int ui = 0; S.next(ui, cur); ++ui) {
        { const int r = tid >> 1, h = tid & 1; const bf16_t* ar = g.A + (size_t)(cur.pm * 256 + r) * K + h * (K / 2); const bf16_t* br = g.Bt + (size_t)(cur.pn * 256 + r) * K + h * (K / 2);
          for (int k = 0; k < K / 2; ++k) { unsigned ua = (unsigned)ar[k] << 16, ub = (unsigned)br[k] << 16; pa[(size_t)r * K + h * (K / 2) + k] = __builtin_bit_cast(float, ua); pb[(size_t)r * K + h * (K / 2) + k] = __builtin_bit_cast(float, ub); } }
        __syncthreads();
        f32x4 acc[2][2][4][2];
        for (int ai = 0; ai < 2; ++ai) for (int bj = 0; bj < 2; ++bj) for (int m = 0; m < 4; ++m) for (int n = 0; n < 2; ++n) for (int e = 0; e < 4; ++e) {
            const int r = ai * 128 + wr * 64 + m * 16 + fr; const int c = bj * 128 + wc * 32 + (Epi::PERM ? 8 * fq + 4 * n + e : 16 * n + 4 * fq + e);
            const float* x = pa + (size_t)r * K + cur.kofs / 2; const float* y = pb + (size_t)c * K + cur.kofs / 2; float s = 0.f; for (int k = 0; k < KL; ++k) s += x[k] * y[k]; acc[ai][bj][m][n][e] = s; }
        E(acc, cur, wr, wc, fr, fq);
        __syncthreads();
    }
}
#endif
}
constexpr int D = 2048, NB = CFG_BATCH, T = CFG_SEQ, NL = 2, SB = CFG_DEC_BATCH, ST = 32, PAST = CFG_PAST, DFF = CFG_DFF;
constexpr int MP = NB * T, MS = SB * ST, M = MP + MS, LS = PAST + ST;
constexpr int NIN = 6656, NGU = 2 * DFF, WIN_COLS = 6496;
constexpr int KTOP_P = (T / 4 < 256) ? T / 4 : 256, KTOP_S = (LS / 4 < 256) ? LS / 4 : 256;
constexpr int LMAXV = (T > LS) ? T : LS, LPAD = (LMAXV + 63) / 64 * 64;
constexpr float EPSN = 1e-6f;
static_assert(M % 256 == 0 && T % 64 == 0 && DFF % 128 == 0 && PAST % 64 == 0, "tile divisibility");
constexpr size_t O_Y = 0;
constexpr size_t O_PAK = (size_t)M * D, O_PAV = O_PAK + (size_t)NL * MP * 128, O_PIK = O_PAV + (size_t)NL * MP * 128, O_PBK = O_PIK + (size_t)NL * MP * 64,
                 O_PBV = O_PBK + (size_t)NL * MP * 512, O_PSSM = O_PBV + (size_t)NL * MP * 512, O_PCONV = O_PSSM + (size_t)NL * NB * 131072,
                 O_SAK = O_PCONV + (size_t)NL * NB * 6144, O_SAV = O_SAK + (size_t)NL * MS * 128, O_SIK = O_SAV + (size_t)NL * MS * 128, O_SBK = O_SIK + (size_t)NL * MS * 64,
                 O_SBV = O_SBK + (size_t)NL * MS * 512, O_SSSM = O_SBV + (size_t)NL * MS * 512, O_SCONV = O_SSSM + (size_t)NL * SB * 131072, O_END = O_SCONV + (size_t)NL * SB * 6144;
constexpr size_t al256(size_t x) { return (x + 255) & ~(size_t)255; }
constexpr size_t WS_CTL = 0, CTL_ZERO_BYTES = 1u << 20;
constexpr int CW_BAR = 4096;
constexpr size_t CTL_QUEUE = 8192;
constexpr size_t CTL_QUEUE2 = 12288;
static_assert(NB + 1 <= 8 && CTL_QUEUE2 + (size_t)NL * 8 * 256 <= (size_t)CW_BAR * 4, "attention queues fit below the barrier words");
constexpr size_t CTL_RSS = 65536;
static_assert(CTL_RSS + (size_t)4 * M * 4 <= CTL_ZERO_BYTES, "RSS inside the memset region");
constexpr size_t WS_WIN = CTL_ZERO_BYTES;
constexpr size_t WS_WOUT = WS_WIN + al256((size_t)NL * NIN * D * 2);
constexpr size_t WS_WGU = WS_WOUT + al256((size_t)NL * D * D * 2);
constexpr size_t WS_WDN = WS_WGU + al256((size_t)NL * NGU * D * 2);
constexpr size_t WS_XB = WS_WDN + al256((size_t)NL * D * DFF * 2);
constexpr size_t WS_ROPE = WS_XB + al256((size_t)M * D * 2);
constexpr size_t WS_AQ = WS_ROPE + al256((size_t)LS * 16 * 4);
constexpr size_t WS_IQ = WS_AQ + al256((size_t)M * 512 * 2);
constexpr size_t WS_IW = WS_IQ + al256((size_t)M * 1024 * 2);
constexpr size_t WS_BQ = WS_IW + al256((size_t)M * 16 * 4);
constexpr size_t WS_CZ = WS_BQ + al256((size_t)M * 512 * 2);
constexpr size_t WS_CX = WS_CZ + al256((size_t)M * 1024 * 2);
constexpr size_t WS_DT = WS_CX + al256((size_t)M * 2048 * 2);
constexpr int NC = T / 64, NCU = NB * NC + SB, MPADT = M + 64;
constexpr size_t WS_XC = WS_DT + al256((size_t)M * 16 * 4);
constexpr size_t WS_XCT = WS_XC + al256((size_t)M * 2048 * 2);
constexpr size_t WS_CS = WS_XCT + al256((size_t)2048 * MPADT * 2);
constexpr size_t WS_CD = WS_CS + al256((size_t)NCU * 16 * 8192 * 4);
constexpr size_t WS_ENT = WS_CD + al256((size_t)NCU * 16 * 4);
constexpr size_t WS_YC = WS_ENT + al256((size_t)NCU * 16 * 8192 * 2);
constexpr int LSP = LPAD;
constexpr size_t WS_IKBP = WS_YC + al256((size_t)M * 1024 * 4);
constexpr size_t WS_IKBS = WS_IKBP + al256((size_t)MP * 64 * 2);
constexpr size_t WS_AKBP = WS_IKBS + al256((size_t)NL * SB * LSP * 64 * 2);
constexpr size_t WS_AKBS = WS_AKBP + al256((size_t)MP * 128 * 2);
constexpr size_t WS_AVTP = WS_AKBS + al256((size_t)NL * SB * LSP * 128 * 2);
constexpr size_t WS_AVTS = WS_AVTP + al256((size_t)NB * 128 * T * 2);
constexpr size_t WS_NSEL = WS_AVTS + al256((size_t)NL * SB * 128 * LSP * 2);
constexpr int MASK_W = LPAD / 32;
constexpr size_t WS_MASK = WS_NSEL + al256((size_t)M * 4);
constexpr size_t WS_MIX = WS_MASK + al256((size_t)M * MASK_W * 4);
constexpr size_t WS_HMID = WS_MIX + al256((size_t)M * 2048 * 2);
constexpr size_t WS_PART = WS_HMID + al256((size_t)M * DFF * 2);
constexpr size_t WS_GT = WS_PART + al256((size_t)4 * MS * D * 4);
constexpr size_t WS_PT = WS_GT + 4096;
constexpr size_t WS_END = WS_PT + 4096;
constexpr int A1_NEED = LPAD * 4;
constexpr int A1_WAVE_BYTES = (A1_NEED > 9216) ? A1_NEED : 9216;
constexpr int A1_TILE_OFF = 8 * A1_WAVE_BYTES, A1_TILE_B = 64 * 144;
constexpr int LDS_PHASE_BYTES = (A1_TILE_OFF + 2 * A1_TILE_B > 139264) ? A1_TILE_OFF + 2 * A1_TILE_B : 139264;
constexpr int MISC_OFF = (LDS_PHASE_BYTES + 255) / 256 * 256, LDS_BYTES = MISC_OFF + 256;
static_assert(LDS_BYTES <= 163840 && A1_WAVE_BYTES >= 6144, "LDS budget");
constexpr int PH_PER_LAYER = 14, NPH = 1 + NL * PH_PER_LAYER;
enum { PH_G1 = 0, PH_A1, PH_CONV, PH_A2, PH_B, PH_C1, PH_C2, PH_C3, PH_GN, PH_G2, PH_F2, PH_G3, PH_G4, PH_F4 };
constexpr int NSL2 = 4, NSL4 = ((DFF / 4) % 128 == 0) ? 4 : (((DFF / 2) % 128 == 0) ? 2 : 1);

typedef unsigned short bf16_t;
typedef float f32x4 __attribute__((ext_vector_type(4)));
typedef unsigned u32x4 __attribute__((ext_vector_type(4)));
typedef unsigned u32x2 __attribute__((ext_vector_type(2)));
typedef short bf16x8 __attribute__((ext_vector_type(8)));
typedef float f32x16 __attribute__((ext_vector_type(16)));

__device__ __forceinline__ unsigned f2bf(float f) { unsigned u = __builtin_bit_cast(unsigned, f); return (u + 0x7fffu + ((u >> 16) & 1u)) >> 16; }
__device__ __forceinline__ float bf2f(unsigned h) { return __builtin_bit_cast(float, h << 16); }
__device__ __forceinline__ float bflo(unsigned w) { return __builtin_bit_cast(float, w << 16); }
__device__ __forceinline__ float bfhi(unsigned w) { return __builtin_bit_cast(float, w & 0xffff0000u); }
#ifdef HOST_EMU
__device__ __forceinline__ unsigned pk2(float lo, float hi) { return f2bf(lo) | (f2bf(hi) << 16); }
#else
__device__ __forceinline__ unsigned pk2(float lo, float hi) { unsigned r; asm("v_cvt_pk_bf16_f32 %0, %1, %2" : "=v"(r) : "v"(lo), "v"(hi)); return r; }
#endif
__device__ __forceinline__ float exp_f(float x) { return FAST_EXP2(x * 1.4426950408889634f); }
__device__ __forceinline__ float silu_f(float x) { return x * FAST_RCP(1.f + FAST_EXP2(-1.4426950408889634f * x)); }
__device__ __forceinline__ float softplus_f(float x) { return fmaxf(x, 0.f) + 0.6931471805599453f * FAST_LOG2(1.f + FAST_EXP2(-1.4426950408889634f * fabsf(x))); }
__device__ __forceinline__ float wave_sum(float v) {
#pragma unroll
    for (int o = 1; o < 64; o <<= 1) v += __shfl_xor(v, o);
    return v;
}
__device__ __forceinline__ float wave_max(float v) {
#pragma unroll
    for (int o = 1; o < 64; o <<= 1) v = fmaxf(v, __shfl_xor(v, o));
    return v;
}
__device__ __forceinline__ float wave_incl_scan(float v, int lane) {
#pragma unroll
    for (int off = 1; off < 64; off <<= 1) { const float tt = __shfl_up(v, off); if (lane >= off) v += tt; }
    return v;
}
__device__ __forceinline__ bf16x8 pack_bf16x8(const float (&v)[8]) { u32x4 w; w.x = pk2(v[0], v[1]); w.y = pk2(v[2], v[3]); w.z = pk2(v[4], v[5]); w.w = pk2(v[6], v[7]); return __builtin_bit_cast(bf16x8, w); }
__device__ __forceinline__ unsigned sortable_key(float s) { const unsigned u = __builtin_bit_cast(unsigned, s); return (u & 0x80000000u) ? ~u : (u | 0x80000000u); }

#ifndef HOST_EMU
#define XB_TMO      128
#define XB_XCNT(j)  (256  + 64 * (j))
#define XB_XSUB(j)  (1280 + 64 * (j))
#define XB_XGEN(j)  (2304 + 64 * (j))
#define XB_TOP      3328
#define XB_TOPGEN   3392
#define XCD_BAR_WORDS 3456
#define XB_SPIN_CAP (1u << 18)

__device__ __forceinline__ unsigned xb_ld(unsigned* p)              { return __hip_atomic_load(p, __ATOMIC_RELAXED, __HIP_MEMORY_SCOPE_AGENT); }
__device__ __forceinline__ unsigned xb_add(unsigned* p, unsigned v) { return __hip_atomic_fetch_add(p, v, __ATOMIC_RELAXED, __HIP_MEMORY_SCOPE_AGENT); }
__device__ __forceinline__ unsigned xb_xcc_id() { return (unsigned)__builtin_amdgcn_s_getreg((3 << 11) | 20) & 0xFu; }
#define XB_SPIN(cond, bar) do { unsigned _sp = 0; while (cond) { __builtin_amdgcn_s_sleep(1); \
    if ((++_sp & 255u) == 0u) { if (xb_ld(&(bar)[XB_TMO])) break; if (_sp > XB_SPIN_CAP) { atomicAdd(&(bar)[XB_TMO], 1u); break; } } } } while (0)

struct XcdBarrier {
    unsigned* bar; unsigned x;
    volatile LAS unsigned* st;
};

__device__ __forceinline__ XcdBarrier xcd_barrier_post(unsigned* bar, volatile LAS unsigned* st) {
    XcdBarrier b; b.bar = bar; b.x = xb_xcc_id(); b.st = st;
    if (threadIdx.x == 0) (void)xb_add(&bar[XB_XCNT(b.x)], 1u);
    return b;
}
__device__ __forceinline__ void xcd_barrier_complete(unsigned* bar, unsigned x, unsigned& nloc, unsigned& nx) {
    const unsigned G = gridDim.x * gridDim.y * gridDim.z;
    unsigned sum, cnt, mine, sp = 0u;
    for (;;) {
        sum = 0u; cnt = 0u; mine = 0u;
#pragma unroll
        for (unsigned j = 0; j < 16; ++j) { const unsigned c = xb_ld(&bar[XB_XCNT(j)]); sum += c; cnt += (c > 0u) ? 1u : 0u; mine = (j == x) ? c : mine; }
        if (sum == G) break;
        __builtin_amdgcn_s_sleep(1);
        if ((++sp & 255u) == 0u) { if (xb_ld(&bar[XB_TMO])) break; if (sp > XB_SPIN_CAP) { atomicAdd(&bar[XB_TMO], 1u); break; } }
    }
    nloc = mine > 0u ? mine : 1u; nx = cnt > 0u ? cnt : 1u;
}

__device__ __forceinline__ void xcd_barrier(const XcdBarrier& b) {
    asm volatile("s_waitcnt vmcnt(0)" ::: "memory");
    __syncthreads();
    if (threadIdx.x == 0) {
        unsigned* bar = b.bar;
        __builtin_amdgcn_s_waitcnt(0);
        unsigned nloc = b.st[0], nx = b.st[1];
        if (nloc == 0u) { xcd_barrier_complete(bar, b.x, nloc, nx); b.st[0] = nloc; b.st[1] = nx; }
        const unsigned old = xb_add(&bar[XB_XSUB(b.x)], 1u);
        const unsigned gen = old / nloc;
        if (old + 1u == (gen + 1u) * nloc) {
            __builtin_amdgcn_fence(__ATOMIC_RELEASE, "agent");
            asm volatile("s_waitcnt vmcnt(0)" ::: "memory");
            const unsigned og = xb_add(&bar[XB_TOP], 1u);
            const unsigned tg = og / nx;
            if (og + 1u == (tg + 1u) * nx) xb_add(&bar[XB_TOPGEN], 1u);
            else XB_SPIN(xb_ld(&bar[XB_TOPGEN]) == tg, bar);
            __builtin_amdgcn_fence(__ATOMIC_ACQUIRE, "agent");
            xb_add(&bar[XB_XGEN(b.x)], 1u);
            asm volatile("s_waitcnt vmcnt(0)" ::: "memory");
        } else {
            XB_SPIN(xb_ld(&bar[XB_XGEN(b.x)]) == gen, bar);
            __builtin_amdgcn_fence(__ATOMIC_ACQUIRE, "agent");
            asm volatile("s_waitcnt vmcnt(0)" ::: "memory");
        }
    }
    __syncthreads();
}
#endif

struct Args { const float* in[27]; float* out; unsigned char* ws; int ph_lo, ph_hi; };
struct Frame {
    LAS unsigned char* lds;
    int tid, lane, wave, G, gw, NGW;
    float* out; unsigned char* ws;
};
#define WSP(Tp, off) ((Tp*)(ws + (off)))
#ifdef HOST_EMU
#define EPI_FENCE() do { } while (0)
#define LAUNDER(p) do { } while (0)
#define LAUNDER_V(p) do { } while (0)
#else
#define EPI_FENCE() asm volatile("" ::: "memory")
#define LAUNDER(p) asm volatile("" : "+s"(p))
#define LAUNDER_V(p) asm volatile("" : "+v"(p))
#endif
#ifdef HOST_EMU
#define GPT(k) (PT[k])
#define PHASE_BASES() unsigned char* ws = F.ws; float* outp = F.out; const float* const* PT = (const float* const*)(ws + WS_PT); (void)PT; (void)outp; int tidl = threadIdx.x; LAUNDER_V(tidl); const int lane = tidl & 63; (void)lane
#else
#define GPT(k) ((const float*)(GAS const float*)PT[k])
#define PHASE_BASES() unsigned long long ws_u_ = (unsigned long long)F.ws, out_u_ = (unsigned long long)F.out; LAUNDER(ws_u_); LAUNDER(out_u_); unsigned char* ws = (unsigned char*)(GAS unsigned char*)ws_u_; float* outp = (float*)(GAS float*)out_u_; const unsigned long long* PT = (const unsigned long long*)(ws + WS_PT); (void)PT; (void)outp; int tidl = threadIdx.x; LAUNDER_V(tidl); const int lane = tidl & 63; (void)lane
#endif
enum { IN_XP = 0, IN_XS, IN_CAK, IN_CAV, IN_CAIK, IN_CBK, IN_CBV, IN_SSM, IN_SCONV, IN_N1G, IN_WIN, IN_GAQ, IN_GAK, IN_GIK, IN_GBQ, IN_GBK, IN_CONVW, IN_CONVB, IN_DTB, IN_ALOG, IN_CD, IN_CNG, IN_WOUT, IN_N2G, IN_WGATE, IN_WUP, IN_WDOWN };
constexpr int GT_STRIDE = 384;

struct RowInfo { bool prompt; int b, t, pos, rg; };
__device__ __forceinline__ RowInfo row_info(int row) {
    RowInfo r; r.prompt = row < MP;
    if (r.prompt) { r.rg = row; r.b = row / T; r.t = row - r.b * T; r.pos = r.t; }
    else { r.rg = row - MP; r.b = r.rg / ST; r.t = r.rg - r.b * ST; r.pos = PAST + r.t; }
    return r;
}
template <int W> __device__ __forceinline__ const float* kv_row(const float* outp, const float* outs, const float* cache, int l, bool prompt, int b, int s) {
    if (prompt) return outp + ((size_t)l * MP + (size_t)b * T + s) * W;
    if (s < PAST) return cache + (((size_t)l * SB + b) * PAST + s) * W;
    return outs + ((size_t)l * MS + (size_t)b * ST + (s - PAST)) * W;
}

__device__ __forceinline__ int inproj_src_col(int p) {
    const int pl = p & 255, L = (p & ~255) + 64 * ((pl >> 5) & 3) + 32 * ((pl >> 7) & 1) + (pl & 31);
    if (L < 1856) return L;
    if (L < 6464) return L + 16;
    if (L < 6480) return 1856 + (L - 6464);
    if (L < 6496) return L;
    return -1;
}
template <class ColFn>
__device__ __forceinline__ void transpose_load(f32x4 (&v)[2][8], const float* W, int ldw, ColFn colfn, const float* gain, int k0, int n0, int lane) {
    const int nq = lane & 15, kq = lane >> 4;
#pragma unroll
    for (int h = 0; h < 2; ++h) { const int col = colfn(n0 + 64 * h + 4 * nq);
#pragma unroll
        for (int j = 0; j < 8; ++j) v[h][j] = (col >= 0) ? *(const f32x4*)(W + (size_t)(k0 + 4 * j + kq) * ldw + col) : (f32x4){0.f, 0.f, 0.f, 0.f}; }
    if (gain) {
#pragma unroll
        for (int j = 0; j < 8; ++j) { const float g = gain[k0 + 4 * j + kq]; v[0][j] = v[0][j] * g; v[1][j] = v[1][j] * g; } }
}
__device__ __forceinline__ void transpose_store(const f32x4 (&v)[2][8], int K, bf16_t* WT, LAS float* scr, int k0, int n0, int lane) {
    const int nq = lane & 15, kq = lane >> 4;
#pragma unroll
    for (int h = 0; h < 2; ++h) {
#pragma unroll
        for (int j = 0; j < 8; ++j) *(LAS f32x4*)(scr + (4 * j + kq) * 68 + 4 * nq) = v[h][j];
        WAVE_SYNC();
        bf16_t* orow = WT + (size_t)(n0 + 64 * h + lane) * K + k0;
#pragma unroll
        for (int q = 0; q < 4; ++q) { u32x4 o;
            o.x = pk2(scr[(8 * q + 0) * 68 + lane], scr[(8 * q + 1) * 68 + lane]); o.y = pk2(scr[(8 * q + 2) * 68 + lane], scr[(8 * q + 3) * 68 + lane]);
            o.z = pk2(scr[(8 * q + 4) * 68 + lane], scr[(8 * q + 5) * 68 + lane]); o.w = pk2(scr[(8 * q + 6) * 68 + lane], scr[(8 * q + 7) * 68 + lane]);
            *(u32x4*)(orow + 8 * q) = o; }
        WAVE_SYNC();
    }
}
#define TRANSPOSE_MATRIX(NIT_, NBLK_, KB_, W_OF_NB, LDW_, COLFN_, GAIN_, KDIM_, WT_) do { const int nit_ = (NIT_); f32x4 va_[2][8], vb_[2][8]; \
        { const int c_ = (F.gw < nit_) ? F.gw : nit_ - 1; const int kb_ = c_ / (NBLK_), nb_ = c_ % (NBLK_); transpose_load(va_, W_OF_NB(nb_), (LDW_), COLFN_, (GAIN_), (KB_) * kb_, 128 * nb_, lane); } \
        for (int it_ = F.gw; it_ < nit_; it_ += 2 * F.NGW) { \
            { const int n_ = it_ + F.NGW, c_ = (n_ < nit_) ? n_ : nit_ - 1; const int kb_ = c_ / (NBLK_), nb_ = c_ % (NBLK_); transpose_load(vb_, W_OF_NB(nb_), (LDW_), COLFN_, (GAIN_), (KB_) * kb_, 128 * nb_, lane); } \
            { const int kb_ = it_ / (NBLK_), nb_ = it_ % (NBLK_); transpose_store(va_, (KDIM_), (WT_), scr, (KB_) * kb_, 128 * nb_, lane); } \
            { const int n_ = it_ + 2 * F.NGW, c_ = (n_ < nit_) ? n_ : nit_ - 1; const int kb_ = c_ / (NBLK_), nb_ = c_ % (NBLK_); transpose_load(va_, W_OF_NB(nb_), (LDW_), COLFN_, (GAIN_), (KB_) * kb_, 128 * nb_, lane); } \
            if (it_ + F.NGW < nit_) { const int n_ = it_ + F.NGW; const int kb_ = n_ / (NBLK_), nb_ = n_ % (NBLK_); transpose_store(vb_, (KDIM_), (WT_), scr, (KB_) * kb_, 128 * nb_, lane); } \
        } } while (0)
__device__ __forceinline__ void sincos_d(double x, double& s, double& c) {
    const double k = rint(x * 0.63661977236758134308); const double r = (x - k * 1.57079632679489655800) - k * 6.123233995736766036e-17; const double r2 = r * r;
    const double sp = r * (1.0 + r2 * (-1.0 / 6 + r2 * (1.0 / 120 + r2 * (-1.0 / 5040 + r2 * (1.0 / 362880 + r2 * (-1.0 / 39916800 + r2 * (1.0 / 6227020800.0)))))));
    const double cp = 1.0 + r2 * (-0.5 + r2 * (1.0 / 24 + r2 * (-1.0 / 720 + r2 * (1.0 / 40320 + r2 * (-1.0 / 3628800 + r2 * (1.0 / 479001600 + r2 * (-1.0 / 87178291200.0)))))));
    const int q = ((int)k) & 3;
    s = (q == 0) ? sp : (q == 1) ? cp : (q == 2) ? -sp : -cp; c = (q == 0) ? cp : (q == 1) ? -sp : (q == 2) ? -cp : sp;
}
__device__ __forceinline__ void phase_prologue(const Frame& F, const Args& A) {
    unsigned char* ws = F.ws;
    if (blockIdx.x == 0 && F.tid == 0) { const float** pt = (const float**)(ws + WS_PT);
#pragma unroll
        for (int i = 0; i < 27; ++i) pt[i] = A.in[i]; }
    LAS float* scr = (LAS float*)(F.lds + F.wave * 16384);
    const int lane = F.lane;
    for (int l = 0; l < NL; ++l) {
        { const float* W = A.in[IN_WIN] + (size_t)l * D * WIN_COLS; const float* gain = A.in[IN_N1G] + l * D; bf16_t* WT = WSP(bf16_t, WS_WIN) + (size_t)l * NIN * D;
#define W_SAME(nb_) W
          TRANSPOSE_MATRIX((D / 32) * (NIN / 128), (NIN / 128), 32, W_SAME, WIN_COLS, [](int p) { return inproj_src_col(p); }, gain, D, WT); }
        { const float* Wg = A.in[IN_WGATE] + (size_t)l * D * DFF; const float* Wu = A.in[IN_WUP] + (size_t)l * D * DFF; const float* gain = A.in[IN_N2G] + l * D; bf16_t* WT = WSP(bf16_t, WS_WGU) + (size_t)l * NGU * D;
#define W_GU(nb_) (((nb_) & 1) ? Wu : Wg)
          TRANSPOSE_MATRIX((D / 32) * (NGU / 128), (NGU / 128), 32, W_GU, DFF, [](int p) { const int pl = p & 255; return 128 * (p >> 8) + 32 * ((pl >> 5) & 3) + (pl & 31); }, gain, D, WT); }
        { const float* W = A.in[IN_WOUT] + (size_t)l * D * D; bf16_t* WT = WSP(bf16_t, WS_WOUT) + (size_t)l * D * D;
          TRANSPOSE_MATRIX((D / 32) * (D / 128), (D / 128), 32, W_SAME, D, [](int p) { return p; }, (const float*)nullptr, D, WT); }
        { const float* W = A.in[IN_WDOWN] + (size_t)l * DFF * D; bf16_t* WT = WSP(bf16_t, WS_WDN) + (size_t)l * D * DFF;
          TRANSPOSE_MATRIX((DFF / 32) * (D / 128), (D / 128), 32, W_SAME, D, [](int p) { return p; }, (const float*)nullptr, DFF, WT); }
    }
    { const float* cik = A.in[IN_CAIK];
      bf16_t* IKBS = WSP(bf16_t, WS_IKBS);
      const size_t gt_ = (size_t)blockIdx.x * 512 + F.tid, gs_ = (size_t)F.G * 512;
      for (size_t i = gt_; i < (size_t)NL * SB * PAST * 8; i += gs_) { const size_t rowi = i >> 3; const int c8 = (int)(i & 7) * 8; const size_t lb = rowi / PAST; const int sidx = (int)(rowi - lb * PAST);
          const f32x4 a = *(const f32x4*)(cik + rowi * 64 + c8), b4 = *(const f32x4*)(cik + rowi * 64 + c8 + 4);
          u32x4 w; w.x = pk2(a.x, a.y); w.y = pk2(a.z, a.w); w.z = pk2(b4.x, b4.y); w.w = pk2(b4.z, b4.w); *(u32x4*)(IKBS + (lb * LSP + sidx) * 64 + c8) = w; }
      for (size_t i = gt_; i < (size_t)NL * SB * (LSP - LS) * 8; i += gs_) { const size_t pr = i >> 3; const int c8 = (int)(i & 7) * 8; const size_t lb = pr / (LSP - LS); const int sidx = LS + (int)(pr - lb * (LSP - LS));
          *(u32x4*)(IKBS + (lb * LSP + sidx) * 64 + c8) = (u32x4){0u, 0u, 0u, 0u}; }
    }
    { const float* cak = A.in[IN_CAK]; bf16_t* AKBS = WSP(bf16_t, WS_AKBS); const size_t gt_ = (size_t)blockIdx.x * 512 + F.tid, gs_ = (size_t)F.G * 512;
      for (size_t i = gt_; i < (size_t)NL * SB * PAST * 16; i += gs_) { const size_t rowi = i >> 4; const int c8 = (int)(i & 15) * 8; const size_t lb = rowi / PAST; const int sidx = (int)(rowi - lb * PAST);
          const f32x4 a = *(const f32x4*)(cak + rowi * 128 + c8), b4 = *(const f32x4*)(cak + rowi * 128 + c8 + 4);
          u32x4 w; w.x = pk2(a.x, a.y); w.y = pk2(a.z, a.w); w.z = pk2(b4.x, b4.y); w.w = pk2(b4.z, b4.w); *(u32x4*)(AKBS + (lb * LSP + sidx) * 128 + c8) = w; }
      for (size_t i = gt_; i < (size_t)NL * SB * (LSP - LS) * 16; i += gs_) { const size_t pr = i >> 4; const int c8 = (int)(i & 15) * 8; const size_t lb = pr / (LSP - LS); const int sidx = LS + (int)(pr - lb * (LSP - LS));
          *(u32x4*)(AKBS + (lb * LSP + sidx) * 128 + c8) = (u32x4){0u, 0u, 0u, 0u}; }
    }
    { const float* cav = A.in[IN_CAV]; bf16_t* AVTS = WSP(bf16_t, WS_AVTS); const size_t gt_ = (size_t)blockIdx.x * 512 + F.tid, gs_ = (size_t)F.G * 512;
      LAS bf16_t* tile = (LAS bf16_t*)(F.lds + F.wave * 16384);
      constexpr int NTV = NL * SB * (PAST / 64) * 2;
      for (int it = F.gw; it < NTV; it += F.NGW) {
          const int tc = it & 1, tr = (it >> 1) % (PAST / 64), lb = (it >> 1) / (PAST / 64); const int g8 = lane & 7;
#pragma unroll 2
          for (int ps = 0; ps < 8; ++ps) { const int rl = ps * 8 + (lane >> 3); const float* sp = cav + ((size_t)lb * PAST + tr * 64 + rl) * 128 + tc * 64 + 8 * g8;
              const f32x4 a = *(const f32x4*)sp, b4 = *(const f32x4*)(sp + 4); u32x4 w; w.x = pk2(a.x, a.y); w.y = pk2(a.z, a.w); w.z = pk2(b4.x, b4.y); w.w = pk2(b4.z, b4.w);
              *(LAS u32x4*)(tile + rl * 72 + 8 * g8) = w; }
          WAVE_SYNC();
#pragma unroll 2
          for (int rg = 0; rg < 8; ++rg) { unsigned short h[8];
#pragma unroll
              for (int k = 0; k < 8; ++k) h[k] = tile[(8 * rg + k) * 72 + lane];
              u32x4 w; w.x = h[0] | ((unsigned)h[1] << 16); w.y = h[2] | ((unsigned)h[3] << 16); w.z = h[4] | ((unsigned)h[5] << 16); w.w = h[6] | ((unsigned)h[7] << 16);
              *(u32x4*)(AVTS + ((size_t)lb * 128 + tc * 64 + lane) * LSP + tr * 64 + 8 * rg) = w; }
          WAVE_SYNC();
      }
      for (size_t i = gt_; i < (size_t)NL * SB * 128 * ((LSP - LS) / 8); i += gs_) { const size_t rw = i / ((LSP - LS) / 8); const int c8 = (int)(i % ((LSP - LS) / 8)) * 8; *(u32x4*)(AVTS + rw * LSP + LS + c8) = (u32x4){0u, 0u, 0u, 0u}; }
    }
    if (blockIdx.x == 0) {
        float* gt = WSP(float, WS_GT);
        for (int i = F.tid; i < NL * GT_STRIDE; i += 512) { const int l = i / GT_STRIDE, j = i % GT_STRIDE; float v = 0.f;
            if (j < 64) v = A.in[IN_GAQ][l * 64 + j]; else if (j < 128) v = A.in[IN_GAK][l * 64 + j - 64]; else if (j < 192) v = A.in[IN_GIK][l * 64 + j - 128];
            else if (j < 256) v = A.in[IN_GBQ][l * 64 + j - 192]; else if (j < 320) v = A.in[IN_GBK][l * 64 + j - 256]; else if (j < 336) v = A.in[IN_DTB][l * 16 + j - 320];
            gt[i] = v; }
    }
    { const float* xs = A.in[IN_XS]; float* X = F.out + O_Y + (size_t)MP * D;
      for (size_t i = (size_t)blockIdx.x * 512 + F.tid; i < (size_t)MS * D / 4; i += (size_t)F.G * 512) *(f32x4*)(X + 4 * i) = *(const f32x4*)(xs + 4 * i); }
    { const float* xp = A.in[IN_XP]; const float* xs = A.in[IN_XS]; bf16_t* XB = WSP(bf16_t, WS_XB); float* RSS = WSP(float, CTL_RSS);
      for (int row0 = F.gw; row0 < M; row0 += 2 * F.NGW) {
        const int rowb = row0 + F.NGW; const bool hasb = rowb < M; const int rb2 = hasb ? rowb : row0;
        const float* xa = (row0 < MP) ? xp + (size_t)row0 * D : xs + (size_t)(row0 - MP) * D; const float* xb = (rb2 < MP) ? xp + (size_t)rb2 * D : xs + (size_t)(rb2 - MP) * D;
        f32x4 va[8], vb[8];
#pragma unroll
        for (int j = 0; j < 8; ++j) va[j] = *(const f32x4*)(xa + 4 * lane + 256 * j);
#pragma unroll
        for (int j = 0; j < 8; ++j) vb[j] = *(const f32x4*)(xb + 4 * lane + 256 * j);
        float sa = 0.f, sb = 0.f;
#pragma unroll
        for (int j = 0; j < 8; ++j) { sa += (va[j].x * va[j].x + va[j].y * va[j].y) + (va[j].z * va[j].z + va[j].w * va[j].w); u32x2 o; o.x = pk2(va[j].x, va[j].y); o.y = pk2(va[j].z, va[j].w); *(u32x2*)(XB + (size_t)row0 * D + 4 * lane + 256 * j) = o; }
        if (hasb) {
#pragma unroll
            for (int j = 0; j < 8; ++j) { sb += (vb[j].x * vb[j].x + vb[j].y * vb[j].y) + (vb[j].z * vb[j].z + vb[j].w * vb[j].w); u32x2 o; o.x = pk2(vb[j].x, vb[j].y); o.y = pk2(vb[j].z, vb[j].w); *(u32x2*)(XB + (size_t)rowb * D + 4 * lane + 256 * j) = o; } }
        sa = wave_sum(sa); sb = wave_sum(sb);
        if (lane == 0) { RSS[row0] = sa; if (hasb) RSS[rowb] = sb; }
      } }
    { float* ROPE = WSP(float, WS_ROPE);
      for (int i = blockIdx.x * 512 + F.tid; i < LS * 8; i += F.G * 512) {
        const int pos = i >> 3, j = i & 7;
        const float invf = (j == 0) ? 1.0f : (j == 1) ? 0.193922758102417f : (j == 2) ? 0.03760603070259094f : (j == 3) ? 0.00729266507551074f : (j == 4) ? 0.001414213445968926f
                         : (j == 5) ? 0.00027424818836152554f : (j == 6) ? 5.318296462064609e-05f : 1.0313385246263351e-05f;
        const float ang = (float)pos * invf; double sn, cs; sincos_d((double)ang, sn, cs);
        ROPE[pos * 16 + j] = (float)cs; ROPE[pos * 16 + 8 + j] = (float)sn;
      } }
}

__device__ __forceinline__ void st_bf16x8(bf16_t* p, const float (&v)[8]) { u32x4 w; w.x = pk2(v[0], v[1]); w.y = pk2(v[2], v[3]); w.z = pk2(v[4], v[5]); w.w = pk2(v[6], v[7]); *(u32x4*)p = w; }
__device__ __forceinline__ void st_f32x8(float* p, const float (&v)[8]) { *(f32x4*)p = (f32x4){v[0], v[1], v[2], v[3]}; *(f32x4*)(p + 4) = (f32x4){v[4], v[5], v[6], v[7]}; }

struct EpiIn {
    static constexpr bool PERM = true, AFTER_DRAIN = false;
    int l; unsigned char* ws; float* out;
    __device__ __forceinline__ void operator()(const f32x4 (&acc)[2][2][4][2], const pg8::Unit& u, int wr, int wc, int fr, int fq) const {
        const int grp = u.pn * 4 + wc;
        if (grp >= 102) return;
        const float* rss = (const float*)(ws + CTL_RSS) + (size_t)(2 * l) * M; const float* rope = (const float*)(ws + WS_ROPE); const float* gt = (const float*)(ws + WS_GT) + l * GT_STRIDE;
        int kind = 0, coff = 0, bstride = 0, fstride = 0; bool do_norm = false, do_rope = false, conv_tail = false; const float* gain = gt;
        bf16_t* bb = nullptr; float* fP = nullptr; float* fS = nullptr;
        int side = 0, sstride = 0; bf16_t* sP = nullptr; bf16_t* sS = nullptr;
        bool qscale = false;
        if (grp < 8) { kind = 0; bb = (bf16_t*)(ws + WS_AQ); bstride = 512; coff = grp * 64; do_norm = true; do_rope = true; gain = gt; qscale = true; }
        else if (grp < 10) { kind = 1; fP = out + O_PAK + (size_t)l * MP * 128; fS = out + O_SAK + (size_t)l * MS * 128; fstride = 128; coff = (grp - 8) * 64; do_norm = true; do_rope = true; gain = gt + 64;
            side = 1; sstride = 128; sP = (bf16_t*)(ws + WS_AKBP); sS = (bf16_t*)(ws + WS_AKBS) + (size_t)l * SB * LSP * 128; }
        else if (grp < 12) { kind = 1; fP = out + O_PAV + (size_t)l * MP * 128; fS = out + O_SAV + (size_t)l * MS * 128; fstride = 128; coff = (grp - 10) * 64; }
        else if (grp < 28) { kind = 0; bb = (bf16_t*)(ws + WS_IQ); bstride = 1024; coff = (grp - 12) * 64; do_rope = true; }
        else if (grp < 29) { kind = 1; fP = out + O_PIK + (size_t)l * MP * 64; fS = out + O_SIK + (size_t)l * MS * 64; fstride = 64; coff = 0; do_norm = true; do_rope = true; gain = gt + 128;
            side = 1; sstride = 64; sP = (bf16_t*)(ws + WS_IKBP); sS = (bf16_t*)(ws + WS_IKBS) + (size_t)l * SB * LSP * 64; }
        else if (grp < 37) { kind = 0; bb = (bf16_t*)(ws + WS_BQ); bstride = 512; coff = (grp - 29) * 64; do_norm = true; gain = gt + 192; }
        else if (grp < 45) { kind = 1; fP = out + O_PBK + (size_t)l * MP * 512; fS = out + O_SBK + (size_t)l * MS * 512; fstride = 512; coff = (grp - 37) * 64; do_norm = true; gain = gt + 256; }
        else if (grp < 53) { kind = 1; fP = out + O_PBV + (size_t)l * MP * 512; fS = out + O_SBV + (size_t)l * MS * 512; fstride = 512; coff = (grp - 45) * 64; }
        else if (grp < 69) { kind = 0; bb = (bf16_t*)(ws + WS_CZ); bstride = 1024; coff = (grp - 53) * 64; }
        else if (grp < 101) { kind = 0; bb = (bf16_t*)(ws + WS_CX); bstride = 2048; coff = (grp - 69) * 64; conv_tail = true; }
        else { kind = 2; }
        const int d0 = 8 * fq;
        float rsv[8];
#pragma unroll
        for (int q = 0; q < 8; ++q) rsv[q] = rss[u.pm * 256 + (q >> 2) * 128 + wr * 64 + (q & 3) * 16 + fr];
#pragma unroll
        for (int ai = 0; ai < 2; ++ai)
#pragma unroll
            for (int m = 0; m < 4; ++m) {
                const int r = u.pm * 256 + ai * 128 + wr * 64 + m * 16 + fr;
                const RowInfo ri = row_info(r);
                const float rs = FAST_RSQ(rsv[ai * 4 + m] * (1.0f / D) + EPSN);
                float v[2][8];
#pragma unroll
                for (int bj = 0; bj < 2; ++bj)
#pragma unroll
                    for (int n = 0; n < 2; ++n)
#pragma unroll
                        for (int e = 0; e < 4; ++e) v[bj][4 * n + e] = acc[ai][bj][m][n][e] * rs;
                if (do_norm) {
                    float ss = 0.f;
#pragma unroll
                    for (int bj = 0; bj < 2; ++bj)
#pragma unroll
                        for (int i = 0; i < 8; ++i) ss += v[bj][i] * v[bj][i];
                    ss += __shfl_xor(ss, 16); ss += __shfl_xor(ss, 32);
                    const float rn = FAST_RSQ(ss * (1.0f / 64.0f) + EPSN);
#pragma unroll
                    for (int bj = 0; bj < 2; ++bj) { const f32x4 g0 = *(const f32x4*)(gain + 32 * bj + d0), g1 = *(const f32x4*)(gain + 32 * bj + d0 + 4);
#pragma unroll
                        for (int e = 0; e < 4; ++e) { v[bj][e] = v[bj][e] * rn * g0[e]; v[bj][4 + e] = v[bj][4 + e] * rn * g1[e]; } }
                }
                if (do_rope) {
                    const float* rp = rope + (size_t)ri.pos * 16;
                    const f32x4 c0 = *(const f32x4*)rp, c1 = *(const f32x4*)(rp + 4), s0 = *(const f32x4*)(rp + 8), s1 = *(const f32x4*)(rp + 12);
                    const float sgn = (fq == 0) ? -1.f : 1.f;
#pragma unroll
                    for (int i = 0; i < 8; ++i) {
                        const float pv = __shfl_xor(v[0][i], 16);
                        const float c = (i < 4) ? c0[i & 3] : c1[i & 3], sn = (i < 4) ? s0[i & 3] : s1[i & 3];
                        if (fq < 2) v[0][i] = v[0][i] * c + sgn * pv * sn;
                    }
                }
                if (kind == 0) {
                    if (qscale) {
#pragma unroll
                        for (int bj = 0; bj < 2; ++bj)
#pragma unroll
                            for (int i = 0; i < 8; ++i) v[bj][i] *= 0.18033688011112042f; }
                    bf16_t* o = bb + (size_t)r * bstride + coff + d0; st_bf16x8(o, v[0]); st_bf16x8(o + 32, v[1]);
                    if (conv_tail) { const int Tg = ri.prompt ? T : ST;
                        if (ri.t >= Tg - 3) { float* of = (ri.prompt ? out + O_PCONV + ((size_t)(l * NB + ri.b) * 3 + (ri.t - (Tg - 3))) * 2048 : out + O_SCONV + ((size_t)(l * SB + ri.b) * 3 + (ri.t - (Tg - 3))) * 2048) + coff + d0;
                            st_f32x8(of, v[0]); st_f32x8(of + 32, v[1]); } }
                } else if (kind == 1) {
                    float* o = (ri.prompt ? fP : fS) + (size_t)ri.rg * fstride + coff + d0; st_f32x8(o, v[0]); st_f32x8(o + 32, v[1]);
                    if (side == 1) { bf16_t* o2 = (ri.prompt ? sP + (size_t)r * sstride : sS + ((size_t)ri.b * LSP + PAST + ri.t) * sstride) + coff + d0; st_bf16x8(o2, v[0]); st_bf16x8(o2 + 32, v[1]); }
                } else {
                    float w[8];
                    if (fq < 2) {
#pragma unroll
                        for (int i = 0; i < 8; ++i) w[i] = v[0][i] * 0.25f;
                        st_f32x8((float*)(ws + WS_IW) + (size_t)r * 16 + d0, w); }
                    else {
#pragma unroll
                        for (int i = 0; i < 8; ++i) w[i] = softplus_f(v[0][i] + gt[320 + (d0 - 16) + i]);
                        st_f32x8((float*)(ws + WS_DT) + (size_t)r * 16 + (d0 - 16), w); }
                }
                if (m & 1) EPI_FENCE();
            }
    }
};
struct EpiOut {
    static constexpr bool PERM = true, AFTER_DRAIN = false;
    float* X; unsigned char* ws; int l;
    __device__ __forceinline__ void operator()(const f32x4 (&acc)[2][2][4][2], const pg8::Unit& u, int wr, int wc, int fr, int fq) const {
        bf16_t* XB = (bf16_t*)(ws + WS_XB); float* rss = (float*)(ws + CTL_RSS) + (size_t)(2 * l + 1) * M;
        const float* const* PT = (const float* const*)(ws + WS_PT); const float* xp = GPT(IN_XP);
#pragma unroll
        for (int ai = 0; ai < 2; ++ai)
#pragma unroll
            for (int m = 0; m < 4; ++m) {
                const int r = u.pm * 256 + ai * 128 + wr * 64 + m * 16 + fr;
                const float* xr = (l == 0) ? xp + (size_t)r * D : X + (size_t)r * D;
                float ss = 0.f;
#pragma unroll
                for (int bj = 0; bj < 2; ++bj) {
                    const int c = u.pn * 256 + bj * 128 + wc * 32 + 8 * fq; float v[8];
                    const f32x4 a0 = *(const f32x4*)(xr + c), a1 = *(const f32x4*)(xr + c + 4);
#pragma unroll
                    for (int e = 0; e < 4; ++e) { v[e] = a0[e] + acc[ai][bj][m][0][e]; v[4 + e] = a1[e] + acc[ai][bj][m][1][e]; }
#pragma unroll
                    for (int i = 0; i < 8; ++i) ss += v[i] * v[i];
                    st_f32x8(X + (size_t)r * D + c, v); st_bf16x8(XB + (size_t)r * D + c, v);
                }
                ss += __shfl_xor(ss, 16); ss += __shfl_xor(ss, 32);
                if (fq == 0) atomicAdd(rss + r, ss);
                if (m & 1) EPI_FENCE();
            }
    }
};
struct EpiGU {
    static constexpr bool PERM = true, AFTER_DRAIN = false;
    unsigned char* ws; int l;
    __device__ __forceinline__ void operator()(const f32x4 (&acc)[2][2][4][2], const pg8::Unit& u, int wr, int wc, int fr, int fq) const {
        const float* rss = (const float*)(ws + CTL_RSS) + (size_t)(2 * l + 1) * M; bf16_t* H = (bf16_t*)(ws + WS_HMID);
        float rsv[8];
#pragma unroll
        for (int q = 0; q < 8; ++q) rsv[q] = rss[u.pm * 256 + (q >> 2) * 128 + wr * 64 + (q & 3) * 16 + fr];
#pragma unroll
        for (int ai = 0; ai < 2; ++ai)
#pragma unroll
            for (int m = 0; m < 4; ++m) {
                const int r = u.pm * 256 + ai * 128 + wr * 64 + m * 16 + fr;
                const float rs = FAST_RSQ(rsv[ai * 4 + m] * (1.0f / D) + EPSN);
                float v[8];
#pragma unroll
                for (int n = 0; n < 2; ++n)
#pragma unroll
                    for (int e = 0; e < 4; ++e) { const float g = acc[ai][0][m][n][e] * rs, up = acc[ai][1][m][n][e] * rs; v[4 * n + e] = silu_f(g) * up; }
                st_bf16x8(H + (size_t)r * DFF + u.pn * 128 + wc * 32 + 8 * fq, v);
                EPI_FENCE();
            }
    }
};
struct EpiDown {
    static constexpr bool PERM = true, AFTER_DRAIN = false;
    float* X; unsigned char* ws; int l;
    __device__ __forceinline__ void operator()(const f32x4 (&acc)[2][2][4][2], const pg8::Unit& u, int wr, int wc, int fr, int fq) const {
        bf16_t* XB = (bf16_t*)(ws + WS_XB); float* rss = (float*)(ws + CTL_RSS) + (size_t)(2 * l + 2) * M; const bool next = l + 1 < NL;
#pragma unroll
        for (int ai = 0; ai < 2; ++ai)
#pragma unroll
            for (int m = 0; m < 4; ++m) {
                const int r = u.pm * 256 + ai * 128 + wr * 64 + m * 16 + fr;
                float ss = 0.f;
#pragma unroll
                for (int bj = 0; bj < 2; ++bj) {
                    const int c = u.pn * 256 + bj * 128 + wc * 32 + 8 * fq; float v[8];
                    const f32x4 a0 = *(const f32x4*)(X + (size_t)r * D + c), a1 = *(const f32x4*)(X + (size_t)r * D + c + 4);
#pragma unroll
                    for (int e = 0; e < 4; ++e) { v[e] = a0[e] + acc[ai][bj][m][0][e]; v[4 + e] = a1[e] + acc[ai][bj][m][1][e]; }
#pragma unroll
                    for (int i = 0; i < 8; ++i) ss += v[i] * v[i];
                    st_f32x8(X + (size_t)r * D + c, v);
                    if (next) st_bf16x8(XB + (size_t)r * D + c, v);
                }
                if (next) { ss += __shfl_xor(ss, 16); ss += __shfl_xor(ss, 32); if (fq == 0) atomicAdd(rss + r, ss); }
                if (m & 1) EPI_FENCE();
            }
    }
};

struct EpiTail {
    static constexpr bool PERM = true, AFTER_DRAIN = false;
    float* P; int klen_bytes;
    __device__ __forceinline__ void operator()(const f32x4 (&acc)[2][2][4][2], const pg8::Unit& u, int wr, int wc, int fr, int fq) const {
        float* slab = P + (size_t)(u.kofs / klen_bytes) * MS * D;
#pragma unroll
        for (int ai = 0; ai < 2; ++ai)
#pragma unroll
            for (int m = 0; m < 4; ++m) {
                const int r = u.pm * 256 + ai * 128 + wr * 64 + m * 16 + fr - MP;
#pragma unroll
                for (int bj = 0; bj < 2; ++bj) { float* xo = slab + (size_t)r * D + u.pn * 256 + bj * 128 + wc * 32 + 8 * fq; *(f32x4*)xo = acc[ai][bj][m][0]; *(f32x4*)(xo + 4) = acc[ai][bj][m][1]; }
                EPI_FENCE();
            }
    }
};
__device__ __forceinline__ void phase_fin(const Frame& F, int idx, int nsl, bool next) {
    PHASE_BASES();
    float* X = outp + O_Y; bf16_t* XB = WSP(bf16_t, WS_XB); float* RSS = WSP(float, CTL_RSS) + (size_t)idx * M; const float* P = WSP(float, WS_PART);
    for (int row = MP + F.gw; row < M; row += F.NGW) {
        float ss = 0.f;
#pragma unroll
        for (int j = 0; j < 8; ++j) { const size_t o = (size_t)row * D + 4 * lane + 256 * j; f32x4 v = *(const f32x4*)(X + o);
            for (int sl = 0; sl < nsl; ++sl) v += *(const f32x4*)(P + ((size_t)sl * MS + (row - MP)) * D + 4 * lane + 256 * j);
            *(f32x4*)(X + o) = v; ss += (v.x * v.x + v.y * v.y) + (v.z * v.z + v.w * v.w);
            if (next) { u32x2 w; w.x = pk2(v.x, v.y); w.y = pk2(v.z, v.w); *(u32x2*)(XB + o) = w; } }
        ss = wave_sum(ss);
        if (next && lane == 0) RSS[row] = ss;
    }
}

__device__ __forceinline__ void phase_a1(const Frame& F, int l, int qs = 0) {
    PHASE_BASES();
    const bf16_t* IQ = WSP(bf16_t, WS_IQ); const float* IW = WSP(float, WS_IW); unsigned* MASK = WSP(unsigned, WS_MASK);
    unsigned* qhead = (unsigned*)(ws + CTL_QUEUE) + (l * 8 + 0 + qs) * 64;
    volatile LAS int* qslot = (volatile LAS int*)(F.lds + MISC_OFF + 64);
    LAS float* iwt = (LAS float*)(F.lds + A1_TILE_OFF);
    LAS unsigned* cand_list = (LAS unsigned*)(F.lds + A1_TILE_OFF + 1024) + F.wave * 64;
    const int r32 = lane & 31, hh = lane >> 5, wave = F.wave;
    constexpr int NUS = MS / 8, NUP = MP / 8, NUNITS = NUS + NUP;
    for (;;) {
        __syncthreads();
        if (tidl == 0) qslot[0] = (int)atomicAdd(qhead, 1u);
        __syncthreads();
        const int u = qslot[0];
        if (u >= NUNITS) break;
        bool prompt; int b, row0, L, Ktop;
        if (u < NUS) { prompt = false; b = (u * 8) / ST; row0 = MP + u * 8; L = LS; Ktop = KTOP_S; }
        else { const int k = u - NUS, c = NC - 1 - k / (NB * 8), j = k % (NB * 8); prompt = true; b = j >> 3; row0 = b * T + 64 * c + 8 * (j & 7); L = 64 * (c + 1); Ktop = KTOP_P; }
        const int nb32 = (L + 31) / 32;
        if (tidl < 128) iwt[tidl] = IW[(size_t)row0 * 16 + tidl] * 0.125f;
        bf16x8 af[4][4];
#pragma unroll
        for (int rb = 0; rb < 4; ++rb) { const bf16_t* ap = IQ + (size_t)(row0 + 2 * rb + ((r32 >> 2) & 1)) * 1024 + ((r32 & 3) + 4 * (r32 >> 3)) * 64 + 8 * hh;
#pragma unroll
            for (int ks = 0; ks < 4; ++ks) af[rb][ks] = *(const bf16x8*)(ap + 16 * ks); }
        __syncthreads();
        const bf16_t* ikb = (prompt ? WSP(bf16_t, WS_IKBP) + (size_t)b * T * 64 : WSP(bf16_t, WS_IKBS) + ((size_t)l * SB + b) * LSP * 64) + (size_t)r32 * 64 + 8 * hh;
        bf16x8 ring[4][4];
#define A1_LOAD_B(dst, kb_) do { const bf16_t* kp_ = ikb + (size_t)(kb_) * 32 * 64; _Pragma("unroll") for (int ks_ = 0; ks_ < 4; ++ks_) dst[ks_] = *(const bf16x8*)(kp_ + 16 * ks_); } while (0)
#pragma unroll
        for (int j = 0; j < 4; ++j) { const int kl = wave + 8 * j; A1_LOAD_B(ring[j], kl < nb32 ? kl : nb32 - 1); }
#pragma unroll 1
        for (int kb0 = wave; kb0 < nb32; kb0 += 32) {
#pragma unroll
            for (int j = 0; j < 4; ++j) {
                const int kb = kb0 + 8 * j;
                if (kb < nb32) {
                    const int s = 32 * kb + r32; const bool kvalid = s < L;
#pragma unroll
                    for (int rb = 0; rb < 4; ++rb) {
                        f32x16 acc;
#pragma unroll
                        for (int i = 0; i < 16; ++i) acc[i] = 0.f;
#pragma unroll
                        for (int ks = 0; ks < 4; ++ks) acc = MFMA32(af[rb][ks], ring[j][ks], acc);
                        float score = 0.f;
#pragma unroll
                        for (int q = 0; q < 4; ++q) { const f32x4 w4 = *(const LAS f32x4*)(iwt + (2 * rb + hh) * 16 + 4 * q);
                            score += w4.x * fmaxf(acc[4 * q], 0.f) + w4.y * fmaxf(acc[4 * q + 1], 0.f) + w4.z * fmaxf(acc[4 * q + 2], 0.f) + w4.w * fmaxf(acc[4 * q + 3], 0.f); }
                        *(LAS unsigned*)(F.lds + (2 * rb + hh) * A1_WAVE_BYTES + (size_t)s * 4) = kvalid ? sortable_key(score) : 0u;
                    }
                }
                { const int kl = kb + 32; A1_LOAD_B(ring[j], kl < nb32 ? kl : nb32 - 1); }
            }
        }
        __syncthreads();
        const LAS unsigned* sc = (const LAS unsigned*)(F.lds + wave * A1_WAVE_BYTES);
        const int nt = (nb32 + 1) / 2, row = row0 + wave;
        if (2 * nt > nb32 && lane >= 32) ((LAS unsigned*)sc)[32 * nb32 + (lane - 32)] = 0u;
        WAVE_SYNC();
        const int n4 = nt / 4, nrem = nt - 4 * n4;
        constexpr int G4MAX = LPAD / 256;
        u32x4 kq[G4MAX]; unsigned kr_[3];
#pragma unroll
        for (int g = 0; g < G4MAX; ++g) kq[g] = (g < n4) ? *(const LAS u32x4*)(sc + 256 * g + 4 * lane) : (u32x4){0u, 0u, 0u, 0u};
#pragma unroll
        for (int r = 0; r < 3; ++r) kr_[r] = (r < nrem) ? sc[256 * n4 + 64 * r + lane] : 0u;
        unsigned tau = 1u;
        if (L > Ktop) {
            tau = 0u; int c_lo = 64 * nt, c_hi = 0, bit = 31; bool found = false;
            while (bit >= 0 && c_lo - c_hi > 64) {
                const unsigned cand = tau | (1u << bit); int cnt = 0;
#pragma unroll
                for (int g = 0; g < G4MAX; ++g) if (g < n4) cnt += __popcll(__ballot(kq[g].x >= cand)) + __popcll(__ballot(kq[g].y >= cand)) + __popcll(__ballot(kq[g].z >= cand)) + __popcll(__ballot(kq[g].w >= cand));
#pragma unroll
                for (int r = 0; r < 3; ++r) if (r < nrem) cnt += __popcll(__ballot(kr_[r] >= cand));
                if (cnt >= Ktop) { tau = cand; c_lo = cnt; } else c_hi = cnt;
                --bit;
                if (cnt == Ktop) { found = true; break; }
            }
            if (!found && bit >= 0) {
                const bool whole = (bit == 31); const unsigned hi_excl = whole ? 0u : tau + (2u << bit);
                int nb = 0;
#define A1_COMPACT(kval) do { const unsigned k_ = (kval); const bool in_ = (k_ >= tau) && (whole || k_ < hi_excl); const unsigned long long bal_ = __ballot(in_); \
                    if (in_) cand_list[nb + __popcll(bal_ & ((1ull << lane) - 1ull))] = k_; nb += __popcll(bal_); } while (0)
#pragma unroll
                for (int g = 0; g < G4MAX; ++g) if (g < n4) { A1_COMPACT(kq[g].x); A1_COMPACT(kq[g].y); A1_COMPACT(kq[g].z); A1_COMPACT(kq[g].w); }
#pragma unroll
                for (int r = 0; r < 3; ++r) if (r < nrem) A1_COMPACT(kr_[r]);
                WAVE_SYNC();
                const unsigned mine = (lane < nb) ? cand_list[lane] : 0u;
                for (; bit >= 0; --bit) {
                    const unsigned cand = tau | (1u << bit);
                    const int cnt = c_hi + __popcll(__ballot((lane < nb) && mine >= cand));
                    if (cnt >= Ktop) tau = cand;
                    if (cnt == Ktop) break;
                }
            }
            if (tau == 0u) tau = 1u;
        }
        unsigned* mrow = MASK + (size_t)row * MASK_W;
#pragma unroll
        for (int g = 0; g < G4MAX; ++g) if (g < n4) {
            unsigned nib = ((kq[g].x >= tau && kq[g].x != 0u) ? 1u : 0u) | ((kq[g].y >= tau && kq[g].y != 0u) ? 2u : 0u) | ((kq[g].z >= tau && kq[g].z != 0u) ? 4u : 0u) | ((kq[g].w >= tau && kq[g].w != 0u) ? 8u : 0u);
            unsigned wv = nib << (4 * (lane & 7));
            wv |= __shfl_xor(wv, 1); wv |= __shfl_xor(wv, 2); wv |= __shfl_xor(wv, 4);
            if ((lane & 7) == 0) mrow[8 * g + (lane >> 3)] = wv;
        }
#pragma unroll
        for (int r = 0; r < 3; ++r) if (r < nrem) {
            const unsigned long long bal = __ballot(kr_[r] >= tau && kr_[r] != 0u);
            if (lane == 0) { mrow[8 * n4 + 2 * r] = (unsigned)bal; mrow[8 * n4 + 2 * r + 1] = (unsigned)(bal >> 32); }
        }
    }
}
constexpr int A2_KP = 272, A2_VP = 136, A2_KT = 64 * A2_KP, A2_VT = 128 * A2_VP, A2_BUF = A2_KT + A2_VT;
static_assert(2 * A2_BUF <= LDS_PHASE_BYTES, "A2 LDS");
__device__ __forceinline__ void phase_a2(const Frame& F, int l, int qs = 0) {
    PHASE_BASES();
    const bf16_t* AQ = WSP(bf16_t, WS_AQ); const unsigned* MASK = WSP(unsigned, WS_MASK); bf16_t* MIX = WSP(bf16_t, WS_MIX);
    const float* kp_p = outp + O_PAK; const float* kp_s = outp + O_SAK; const float* kp_c = GPT(IN_CAK);
    const float* vp_p = outp + O_PAV; const float* vp_s = outp + O_SAV; const float* vp_c = GPT(IN_CAV);
    unsigned* qbase = (unsigned*)(ws + CTL_QUEUE2) + (size_t)(l * 8) * 64; (void)qs;
    volatile LAS int* qslot = (volatile LAS int*)(F.lds + MISC_OFF + 96);
    const int r32 = lane & 31, hh = lane >> 5, wave = F.wave, kvh = wave >> 2, qsub = wave & 3, qq = r32 & 15;
    constexpr int NUS = SB, NUP = NB * NC, NUNITS = NUS + NUP; (void)NUNITS; (void)NUP;
#ifdef HOST_EMU
    const int home = (int)(blockIdx.x % NB);
#else
    const int home = (int)(xb_xcc_id() % (unsigned)NB);
#endif
    int qstage = 0;
    const int kkey = tidl >> 3, kd = 16 * (tidl & 7), vkp = 2 * (tidl & 31), vd = 8 * (tidl >> 5);
    for (;;) {
        __syncthreads();
        if (tidl == 0) {
            int uu = -1;
            while (qstage <= NB) {
                const int qi = qstage == 0 ? NB : (home + qstage - 1) % NB;
                const int v = (int)atomicAdd(qbase + qi * 64, 1u);
                if (v < (qstage == 0 ? NUS : NC)) { uu = qstage == 0 ? v : NUS + v * NB + qi; break; }
                ++qstage;
            }
            qslot[0] = uu;
        }
        __syncthreads();
        const int u = qslot[0];
        if (u < 0) break;
        bool prompt; int b, row0, L, nq;
        if (u < NUS) { prompt = false; b = u; row0 = MP + u * ST; L = LS; nq = ST; }
        else { const int k = u - NUS, c = NC - 1 - k / NB; prompt = true; b = k % NB; row0 = b * T + 64 * c; L = 64 * (c + 1); nq = 64; }
        const int nt = (L + 63) / 64; const bool active = 16 * qsub < nq;
        const int qrow = row0 + (active ? 16 * qsub + qq : 0);
        bf16x8 qf[2][4];
#pragma unroll
        for (int cb = 0; cb < 2; ++cb)
#pragma unroll
            for (int ks = 0; ks < 4; ++ks) qf[cb][ks] = *(const bf16x8*)(AQ + (size_t)qrow * 512 + (kvh * 4 + 2 * cb + (r32 >> 4)) * 64 + 16 * ks + 8 * hh);
        f32x16 o[2][2]; float mrun[2] = {-1.0e30f, -1.0e30f}, lrun[2] = {0.f, 0.f};
#pragma unroll
        for (int db = 0; db < 2; ++db)
#pragma unroll
            for (int cb = 0; cb < 2; ++cb)
#pragma unroll
                for (int i = 0; i < 16; ++i) o[db][cb][i] = 0.f;
        const bf16_t* akb_base = prompt ? WSP(bf16_t, WS_AKBP) + (size_t)b * T * 128 : WSP(bf16_t, WS_AKBS) + ((size_t)l * SB + b) * LSP * 128;
        const bf16_t* avt_base = prompt ? WSP(bf16_t, WS_AVTP) + (size_t)b * 128 * T : WSP(bf16_t, WS_AVTS) + ((size_t)l * SB + b) * 128 * LSP; const size_t avt_pitch = prompt ? (size_t)T : (size_t)LSP;
        u32x4 kA[2], vA[2], kB[2], vB[2];
#define A2_LOAD_TT(K_, V_, t_) do { const bf16_t* kp_ = akb_base + (size_t)(64 * (t_) + kkey) * 128 + kd; K_[0] = *(const u32x4*)kp_; K_[1] = *(const u32x4*)(kp_ + 8); \
            const bf16_t* vp_ = avt_base + (size_t)(tidl >> 2) * avt_pitch + 64 * (t_) + 16 * (tidl & 3); V_[0] = *(const u32x4*)vp_; V_[1] = *(const u32x4*)(vp_ + 8); } while (0)
#define A2_STORE_TT(K_, V_, buf_) do { LAS unsigned char* kb_ = F.lds + (buf_) * A2_BUF + kkey * A2_KP + kd * 2; *(LAS u32x4*)kb_ = K_[0]; *(LAS u32x4*)(kb_ + 16) = K_[1]; \
            LAS unsigned char* vb_ = F.lds + (buf_) * A2_BUF + A2_KT + (tidl >> 2) * A2_VP + 32 * (tidl & 3); \
            *(LAS u32x2*)(vb_) = (u32x2){V_[0].x, V_[0].y}; *(LAS u32x2*)(vb_ + 8) = (u32x2){V_[0].z, V_[0].w}; *(LAS u32x2*)(vb_ + 16) = (u32x2){V_[1].x, V_[1].y}; *(LAS u32x2*)(vb_ + 24) = (u32x2){V_[1].z, V_[1].w}; } while (0)
#define A2_COMPUTE(BUF_) do { \
            if (active) { \
                const LAS unsigned char* kt = F.lds + (BUF_) * A2_BUF; const LAS unsigned char* vt = kt + A2_KT; \
                _Pragma("unroll") \
                for (int kblk = 0; kblk < 2; ++kblk) { \
                    f32x16 sacc[2]; \
                _Pragma("unroll") \
                    for (int cb = 0; cb < 2; ++cb) \
                _Pragma("unroll") \
                        for (int i = 0; i < 16; ++i) sacc[cb][i] = 0.f; \
                _Pragma("unroll") \
                    for (int ks = 0; ks < 4; ++ks) { const bf16x8 kf = *(const LAS bf16x8*)(kt + (32 * kblk + r32) * A2_KP + (kvh * 64 + 16 * ks + 8 * hh) * 2); \
                        sacc[0] = MFMA32(kf, qf[0][ks], sacc[0]); sacc[1] = MFMA32(kf, qf[1][ks], sacc[1]); } \
                    const unsigned mw = kblk ? mcur1 : mcur0; \
                    bf16x8 pf[2][2]; \
                _Pragma("unroll") \
                    for (int cb = 0; cb < 2; ++cb) { \
                        float sv[16]; float bm = -1.0e30f; const unsigned mwh = mw >> (4 * hh); \
                _Pragma("unroll") \
                        for (int i = 0; i < 16; ++i) { const bool on = (mwh & (1u << ((i & 3) + 8 * (i >> 2)))) != 0u; sv[i] = on ? sacc[cb][i] : -1.0e30f; bm = fmaxf(bm, sv[i]); } \
                        bm = fmaxf(bm, __shfl_xor(bm, 32)); \
                        const float mnew = fmaxf(mrun[cb], bm); \
                        float ps = 0.f; float pv[16]; \
                _Pragma("unroll") \
                        for (int i = 0; i < 16; ++i) { pv[i] = FAST_EXP2(sv[i] - mnew); ps += pv[i]; } \
                        if (mnew < -1.0e29f) { \
                _Pragma("unroll") \
                            for (int i = 0; i < 16; ++i) pv[i] = 0.f; \
                            ps = 0.f; } \
                        ps += __shfl_xor(ps, 32); \
                        if (!__all(mnew == mrun[cb])) { \
                            const float alpha = FAST_EXP2(mrun[cb] - mnew); \
                            lrun[cb] *= alpha; \
                _Pragma("unroll") \
                            for (int db = 0; db < 2; ++db) \
                _Pragma("unroll") \
                                for (int i = 0; i < 16; ++i) o[db][cb][i] *= alpha; \
                        } \
                        lrun[cb] += ps; mrun[cb] = mnew; \
                _Pragma("unroll") \
                        for (int ks2 = 0; ks2 < 2; ++ks2) { float t8[8]; \
                _Pragma("unroll") \
                            for (int j = 0; j < 8; ++j) t8[j] = pv[8 * ks2 + j]; \
                            pf[cb][ks2] = pack_bf16x8(t8); } \
                    } \
                _Pragma("unroll") \
                    for (int db = 0; db < 2; ++db) \
                _Pragma("unroll") \
                        for (int ks2 = 0; ks2 < 2; ++ks2) { \
                            const LAS unsigned char* vp = vt + (kvh * 64 + 32 * db + r32) * A2_VP + (32 * kblk + 16 * ks2 + 4 * hh) * 2; \
                            const u32x2 v0 = *(const LAS u32x2*)vp, v1 = *(const LAS u32x2*)(vp + 16); \
                            const bf16x8 vf = __builtin_bit_cast(bf16x8, ((u32x4){v0.x, v0.y, v1.x, v1.y})); \
                            o[db][0] = MFMA32(vf, pf[0][ks2], o[db][0]); o[db][1] = MFMA32(vf, pf[1][ks2], o[db][1]); \
                        } \
                } \
            } \
            } while (0)
        A2_LOAD_TT(kA, vA, 0); A2_STORE_TT(kA, vA, 0);
        A2_LOAD_TT(kB, vB, (nt > 1 ? 1 : 0));
        const unsigned* mrow = MASK + (size_t)qrow * MASK_W;
        unsigned mcur0 = mrow[0], mcur1 = mrow[1], mnx0 = 0u, mnx1 = 0u;
        __syncthreads();
#pragma unroll 1
        for (int t = 0; t < nt; t += 2) {
            A2_LOAD_TT(kA, vA, (t + 2 < nt ? t + 2 : nt - 1));
            { const int tm = (t + 1 < nt) ? t + 1 : nt - 1; mnx0 = mrow[2 * tm]; mnx1 = mrow[2 * tm + 1]; }
            A2_COMPUTE(0);
            if (t + 1 < nt) A2_STORE_TT(kB, vB, 1);
            mcur0 = mnx0; mcur1 = mnx1;
            __syncthreads();
            if (t + 1 >= nt) break;
            A2_LOAD_TT(kB, vB, (t + 3 < nt ? t + 3 : nt - 1));
            { const int tm = (t + 2 < nt) ? t + 2 : nt - 1; mnx0 = mrow[2 * tm]; mnx1 = mrow[2 * tm + 1]; }
            A2_COMPUTE(1);
            if (t + 2 < nt) A2_STORE_TT(kA, vA, 0);
            mcur0 = mnx0; mcur1 = mnx1;
            __syncthreads();
        }
        if (active) {
#pragma unroll
            for (int cb = 0; cb < 2; ++cb) { const float inv = 1.0f / lrun[cb];
#pragma unroll
                for (int db = 0; db < 2; ++db)
#pragma unroll
                    for (int g = 0; g < 4; ++g) { u32x2 w; w.x = pk2(o[db][cb][4 * g] * inv, o[db][cb][4 * g + 1] * inv); w.y = pk2(o[db][cb][4 * g + 2] * inv, o[db][cb][4 * g + 3] * inv);
                        *(u32x2*)(MIX + (size_t)qrow * 2048 + (kvh * 4 + 2 * cb + (r32 >> 4)) * 64 + 32 * db + 8 * g + 4 * hh) = w; } }
        }
    }
}
__device__ __forceinline__ void phase_b(const Frame& F, int l) {
    PHASE_BASES();
    const bf16_t* BQ = WSP(bf16_t, WS_BQ); bf16_t* MIX = WSP(bf16_t, WS_MIX);
    const float* kp_p = outp + O_PBK; const float* kp_s = outp + O_SBK; const float* kp_c = GPT(IN_CBK);
    const float* vp_p = outp + O_PBV; const float* vp_s = outp + O_SBV; const float* vp_c = GPT(IN_CBV);
    const int r32 = lane & 31, hh = lane >> 5;
    constexpr int NUP = NB * (T / 32) * 8, NUS = SB * 8;
    for (int unit = F.gw; unit < NUP + NUS; unit += F.NGW) {
        const bool prompt = unit < NUP; const int uu = prompt ? unit : unit - NUP; const int h = uu & 7; int b, row0, qbase;
        if (prompt) { const int qb = (uu >> 3) % (T / 32); b = (uu >> 3) / (T / 32); row0 = b * T + 32 * qb; qbase = 32 * qb; } else { b = uu >> 3; row0 = MP + b * ST; qbase = PAST; }
        const int nk = prompt ? T : LS;
        bf16x8 qf[4];
#pragma unroll
        for (int ks = 0; ks < 4; ++ks) qf[ks] = *(const bf16x8*)(BQ + (size_t)(row0 + r32) * 512 + h * 64 + 16 * ks + 8 * hh);
        f32x16 o[2];
#pragma unroll
        for (int db = 0; db < 2; ++db)
#pragma unroll
            for (int i = 0; i < 16; ++i) o[db][i] = 0.f;
        float R = 0.f; const int qpos = qbase + r32;
        f32x4 kraw[8];
#define B_LOAD_K(kb_) do { const int s_ = 32 * (kb_) + r32; const float* kp_ = kv_row<512>(kp_p, kp_s, kp_c, l, prompt, b, (s_ < nk) ? s_ : 0) + h * 64 + 8 * hh; \
            _Pragma("unroll") for (int ks_ = 0; ks_ < 4; ++ks_) { kraw[2 * ks_] = *(const f32x4*)(kp_ + 16 * ks_); kraw[2 * ks_ + 1] = *(const f32x4*)(kp_ + 16 * ks_ + 4); } } while (0)
        B_LOAD_K((qbase + 31) / 32);
        for (int kb = (qbase + 31) / 32; kb >= 0; --kb) {
            f32x16 sacc;
#pragma unroll
            for (int i = 0; i < 16; ++i) sacc[i] = 0.f;
            { const bool kvalid = 32 * kb + r32 < nk;
#pragma unroll
              for (int ks = 0; ks < 4; ++ks) { f32x4 k0 = kraw[2 * ks], k1 = kraw[2 * ks + 1];
                  if (!kvalid) { k0 = (f32x4){0.f, 0.f, 0.f, 0.f}; k1 = k0; }
                  float kv[8] = {k0.x, k0.y, k0.z, k0.w, k1.x, k1.y, k1.z, k1.w};
                  sacc = MFMA32(pack_bf16x8(kv), qf[ks], sacc); } }
            B_LOAD_K(kb > 0 ? kb - 1 : 0);
            float vv[2][2][8];
#pragma unroll
            for (int ks2 = 0; ks2 < 2; ++ks2)
#pragma unroll
                for (int db = 0; db < 2; ++db)
#pragma unroll
                    for (int j = 0; j < 8; ++j) { const int s = 32 * kb + 16 * ks2 + 8 * (j >> 2) + 4 * hh + (j & 3); vv[ks2][db][j] = (s < nk) ? kv_row<512>(vp_p, vp_s, vp_c, l, prompt, b, s)[h * 64 + 32 * db + r32] : 0.f; }
            float lk[16], zz[16];
#pragma unroll
            for (int i = 0; i < 16; ++i) { const int kpos = 32 * kb + (i & 3) + 8 * (i >> 2) + 4 * hh; const float z = sacc[i] * 0.125f; zz[i] = z; lk[i] = (kpos < qpos) ? -softplus_f(z) : 0.f; }
            float G[4], Go[4];
#pragma unroll
            for (int g = 0; g < 4; ++g) { G[g] = (lk[4 * g] + lk[4 * g + 1]) + (lk[4 * g + 2] + lk[4 * g + 3]); Go[g] = __shfl_xor(G[g], 32); }
            float a[16]; float tail = 0.f;
#pragma unroll
            for (int g = 3; g >= 0; --g) {
                const float tg = tail + (hh == 0 ? Go[g] : 0.f);
                const float s3 = 0.f, s2 = lk[4 * g + 3], s1 = s2 + lk[4 * g + 2], s0 = s1 + lk[4 * g + 1];
                const float sf[4] = {s0, s1, s2, s3};
#pragma unroll
                for (int e = 0; e < 4; ++e) { const int i = 4 * g + e; const int kpos = 32 * kb + e + 8 * g + 4 * hh; a[i] = (kpos < qpos) ? exp_f(zz[i] + lk[i] + R + tg + sf[e]) : 0.f; }
                tail += G[g] + Go[g];
            }
            R += tail;
#pragma unroll
            for (int ks2 = 0; ks2 < 2; ++ks2) {
                float pv[8];
#pragma unroll
                for (int j = 0; j < 8; ++j) pv[j] = a[8 * ks2 + j];
                const bf16x8 pf = pack_bf16x8(pv);
#pragma unroll
                for (int db = 0; db < 2; ++db) o[db] = MFMA32(pack_bf16x8(vv[ks2][db]), pf, o[db]);
            }
            if (__all(R < -40.f)) break;
        }
#pragma unroll
        for (int db = 0; db < 2; ++db)
#pragma unroll
            for (int g = 0; g < 4; ++g) { u32x2 w; w.x = pk2(o[db][4 * g], o[db][4 * g + 1]); w.y = pk2(o[db][4 * g + 2], o[db][4 * g + 3]);
                *(u32x2*)(MIX + (size_t)(row0 + r32) * 2048 + 512 + h * 64 + 32 * db + 8 * g + 4 * hh) = w; }
    }
}
__device__ __forceinline__ void phase_conv(const Frame& F, int l) {
    PHASE_BASES();
    const float* cw = GPT(IN_CONVW) + (size_t)l * 4 * 2048; const float* cb = GPT(IN_CONVB) + (size_t)l * 2048; const float* sconv = GPT(IN_SCONV);
    const bf16_t* CX = WSP(bf16_t, WS_CX); bf16_t* XC = WSP(bf16_t, WS_XC); bf16_t* XCT = WSP(bf16_t, WS_XCT);
    LAS bf16_t* tile = (LAS bf16_t*)(F.lds + F.wave * A1_WAVE_BYTES);
    constexpr int NTILE = (M / 64) * 32, NVT = (M / 64) * 2;
    { bf16_t* AVTP = WSP(bf16_t, WS_AVTP); bf16_t* AVTS = WSP(bf16_t, WS_AVTS) + (size_t)l * SB * 128 * LSP; const float* avp = outp + O_PAV + (size_t)l * MP * 128; const float* avs = outp + O_SAV + (size_t)l * MS * 128;
      for (int it = F.gw; it < NVT; it += F.NGW) {
          const int tc = it & 1, tr = it >> 1, rbase = tr * 64, g8 = lane & 7; const bool pr = rbase < MP;
#pragma unroll 2
          for (int ps = 0; ps < 8; ++ps) { const int rl = ps * 8 + (lane >> 3), row = rbase + rl; const float* sp = (pr ? avp + (size_t)row * 128 : avs + (size_t)(row - MP) * 128) + tc * 64 + 8 * g8;
              const f32x4 a = *(const f32x4*)sp, b4 = *(const f32x4*)(sp + 4); u32x4 w; w.x = pk2(a.x, a.y); w.y = pk2(a.z, a.w); w.z = pk2(b4.x, b4.y); w.w = pk2(b4.z, b4.w);
              *(LAS u32x4*)(tile + rl * 72 + 8 * g8) = w; }
          WAVE_SYNC();
#pragma unroll 2
          for (int rg = 0; rg < 8; ++rg) { unsigned short h[8];
#pragma unroll
              for (int k = 0; k < 8; ++k) h[k] = tile[(8 * rg + k) * 72 + lane];
              u32x4 w; w.x = h[0] | ((unsigned)h[1] << 16); w.y = h[2] | ((unsigned)h[3] << 16); w.z = h[4] | ((unsigned)h[5] << 16); w.w = h[6] | ((unsigned)h[7] << 16);
              const int row = rbase + 8 * rg;
              bf16_t* dst = pr ? AVTP + ((size_t)(row / T) * 128 + tc * 64 + lane) * T + (row % T) : AVTS + ((size_t)((row - MP) / ST) * 128 + tc * 64 + lane) * LSP + PAST + ((row - MP) % ST);
              *(u32x4*)dst = w; }
          WAVE_SYNC();
      } }
    for (int it = F.gw; it < NTILE; it += F.NGW) {
        const int tr = it >> 5, tc = it & 31, rbase = tr * 64, cbase = tc * 64;
        const int g8 = lane & 7, c0 = cbase + 8 * g8;
        float wj[4][8], bs[8];
#pragma unroll
        for (int e = 0; e < 8; ++e) bs[e] = cb[c0 + e];
#pragma unroll
        for (int j = 0; j < 4; ++j)
#pragma unroll
            for (int e = 0; e < 8; ++e) wj[j][e] = cw[j * 2048 + c0 + e];
#pragma unroll 4
        for (int ps = 0; ps < 8; ++ps) {
            const int rl = ps * 8 + (lane >> 3), row = rbase + rl; const RowInfo ri = row_info(row);
            float a[8];
#pragma unroll
            for (int e = 0; e < 8; ++e) a[e] = bs[e];
#pragma unroll
            for (int j = 0; j < 4; ++j) {
                const int tau = ri.t - 3 + j; float x[8];
                if (tau >= 0) { const u32x4 w = *(const u32x4*)(CX + (size_t)(row - ri.t + tau) * 2048 + c0);
                    x[0] = bflo(w.x); x[1] = bfhi(w.x); x[2] = bflo(w.y); x[3] = bfhi(w.y); x[4] = bflo(w.z); x[5] = bfhi(w.z); x[6] = bflo(w.w); x[7] = bfhi(w.w); }
                else if (!ri.prompt) { const float* sp = sconv + ((size_t)(l * SB + ri.b) * 3 + (3 + tau)) * 2048 + c0;
#pragma unroll
                    for (int e = 0; e < 8; ++e) x[e] = sp[e]; }
                else {
#pragma unroll
                    for (int e = 0; e < 8; ++e) x[e] = 0.f; }
#pragma unroll
                for (int e = 0; e < 8; ++e) a[e] += wj[j][e] * x[e];
            }
            float o[8];
#pragma unroll
            for (int e = 0; e < 8; ++e) o[e] = silu_f(a[e]);
            u32x4 w; w.x = pk2(o[0], o[1]); w.y = pk2(o[2], o[3]); w.z = pk2(o[4], o[5]); w.w = pk2(o[6], o[7]);
            if (tc >= 16) *(u32x4*)(XC + (size_t)row * 2048 + c0) = w;
            *(LAS u32x4*)(tile + rl * 72 + 8 * g8) = w;
        }
        WAVE_SYNC();
        if (tc < 24) {
#pragma unroll 2
        for (int rg = 0; rg < 8; ++rg) {
            unsigned short h[8];
#pragma unroll
            for (int k = 0; k < 8; ++k) h[k] = tile[(8 * rg + k) * 72 + lane];
            u32x4 w; w.x = h[0] | ((unsigned)h[1] << 16); w.y = h[2] | ((unsigned)h[3] << 16); w.z = h[4] | ((unsigned)h[5] << 16); w.w = h[6] | ((unsigned)h[7] << 16);
            *(u32x4*)(XCT + (size_t)(cbase + lane) * MPADT + rbase + 8 * rg) = w;
        }
        }
        if (tc < 24 && tr == M / 64 - 1) {
#pragma unroll 2
            for (int rg = 0; rg < 8; ++rg) *(u32x4*)(XCT + (size_t)(cbase + lane) * MPADT + M + 8 * rg) = (u32x4){0u, 0u, 0u, 0u};
        }
        WAVE_SYNC();
    }
}
struct CuInfo { int row0, Tv; bool prompt; int b; };
__device__ __forceinline__ CuInfo cu_info(int cu) { CuInfo c; c.prompt = cu < NB * NC; if (c.prompt) { c.b = cu / NC; c.row0 = c.b * T + (cu - c.b * NC) * 64; c.Tv = 64; } else { c.b = cu - NB * NC; c.row0 = MP + c.b * ST; c.Tv = ST; } return c; }
__device__ __forceinline__ void phase_c1(const Frame& F, int l) {
    PHASE_BASES();
    const float* DT = WSP(float, WS_DT); const bf16_t* XCT = WSP(bf16_t, WS_XCT); bf16_t* CS = WSP(bf16_t, WS_CS); float* CD = WSP(float, WS_CD);
    LAS float* wbuf = (LAS float*)(F.lds + F.wave * A1_WAVE_BYTES);
    const int r32 = lane & 31, hh = lane >> 5;
    for (int it = F.gw; it < NCU * 32; it += F.NGW) {
        const int pb = it & 1, h = (it >> 1) & 15, cu = it >> 5, g = h >> 2; const CuInfo ci = cu_info(cu);
        const float Aneg = -expf(GPT(IN_ALOG)[l * 16 + h]);
        const float dt = (lane < ci.Tv) ? DT[(size_t)(ci.row0 + lane) * 16 + h] : 0.f;
        u32x4 araw[4]; bf16x8 bfr[4][4];
#pragma unroll
        for (int ks = 0; ks < 4; ++ks) araw[ks] = *(const u32x4*)(XCT + (size_t)(h * 64 + 32 * pb + r32) * MPADT + ci.row0 + 16 * ks + 8 * hh);
#pragma unroll
        for (int nb = 0; nb < 4; ++nb)
#pragma unroll
            for (int ks = 0; ks < 4; ++ks) bfr[nb][ks] = *(const bf16x8*)(XCT + (size_t)(1024 + g * 128 + 32 * nb + r32) * MPADT + ci.row0 + 16 * ks + 8 * hh);
        const float acum = wave_incl_scan(dt * Aneg, lane), tot = __shfl(acum, 63);
        wbuf[lane] = dt * exp_f(tot - acum);
        if (pb == 0 && lane == 0) CD[cu * 16 + h] = exp_f(tot);
        WAVE_SYNC();
        bf16x8 af[4];
#pragma unroll
        for (int ks = 0; ks < 4; ++ks) {
            const u32x4 raw = araw[ks];
            const f32x4 w0 = *(const LAS f32x4*)(wbuf + 16 * ks + 8 * hh), w1 = *(const LAS f32x4*)(wbuf + 16 * ks + 8 * hh + 4);
            float v[8] = {bflo(raw.x) * w0[0], bfhi(raw.x) * w0[1], bflo(raw.y) * w0[2], bfhi(raw.y) * w0[3], bflo(raw.z) * w1[0], bfhi(raw.z) * w1[1], bflo(raw.w) * w1[2], bfhi(raw.w) * w1[3]};
            af[ks] = pack_bf16x8(v);
        }
        f32x16 acc[4];
#pragma unroll
        for (int nb = 0; nb < 4; ++nb) {
#pragma unroll
            for (int i = 0; i < 16; ++i) acc[nb][i] = 0.f;
#pragma unroll
            for (int ks = 0; ks < 4; ++ks) acc[nb] = MFMA32(af[ks], bfr[nb][ks], acc[nb]);
        }
        bf16_t* cs = CS + (size_t)(cu * 16 + h) * 8192;
#pragma unroll
        for (int nb = 0; nb < 4; ++nb)
#pragma unroll
            for (int i = 0; i < 16; ++i) cs[(32 * pb + (i & 3) + 8 * (i >> 2) + 4 * hh) * 128 + 32 * nb + r32] = (bf16_t)f2bf(acc[nb][i]);
        WAVE_SYNC();
    }
}
__device__ __forceinline__ void phase_c2(const Frame& F, int l) {
    PHASE_BASES();
    const bf16_t* CS = WSP(bf16_t, WS_CS); const float* CD = WSP(float, WS_CD); bf16_t* ENT = WSP(bf16_t, WS_ENT);
    constexpr int NEP = NB * 16 * 2048, NES = SB * 16 * 2048;
    for (int it = blockIdx.x * 512 + tidl; it < NEP + NES; it += F.G * 512) {
        const bool prompt = it < NEP; const int e = prompt ? it : it - NEP; const int q = e & 2047, h = (e >> 11) & 15, b = e >> 15;
        if (prompt) {
            f32x4 st = (f32x4){0.f, 0.f, 0.f, 0.f};
            constexpr int CB = (NC % 8 == 0) ? 8 : ((NC % 4 == 0) ? 4 : 1);
#pragma unroll 1
            for (int c0 = 0; c0 < NC; c0 += CB) {
                u32x2 cw[CB]; float cdv[CB];
#pragma unroll
                for (int k = 0; k < CB; ++k) { const size_t u = (size_t)((b * NC + c0 + k) * 16 + h); cw[k] = *(const u32x2*)(CS + u * 8192 + q * 4); cdv[k] = CD[u]; }
#pragma unroll
                for (int k = 0; k < CB; ++k) { const size_t u = (size_t)((b * NC + c0 + k) * 16 + h); const f32x4 cs = (f32x4){bflo(cw[k].x), bfhi(cw[k].x), bflo(cw[k].y), bfhi(cw[k].y)};
                    u32x2 w; w.x = pk2(st.x, st.y); w.y = pk2(st.z, st.w); *(u32x2*)(ENT + u * 8192 + q * 4) = w;
                    st = st * cdv[k] + cs; }
            }
            *(f32x4*)(outp + O_PSSM + (((size_t)l * NB + b) * 16 + h) * 8192 + q * 4) = st;
        } else {
            const size_t u = (size_t)((NB * NC + b) * 16 + h);
            f32x4 st = *(const f32x4*)(GPT(IN_SSM) + (((size_t)l * SB + b) * 16 + h) * 8192 + q * 4);
            u32x2 w; w.x = pk2(st.x, st.y); w.y = pk2(st.z, st.w); *(u32x2*)(ENT + u * 8192 + q * 4) = w;
            const u32x2 cw = *(const u32x2*)(CS + u * 8192 + q * 4); const f32x4 cs = (f32x4){bflo(cw.x), bfhi(cw.x), bflo(cw.y), bfhi(cw.y)};
            st = st * CD[u] + cs;
            *(f32x4*)(outp + O_SSSM + (((size_t)l * SB + b) * 16 + h) * 8192 + q * 4) = st;
        }
    }
}
__device__ __forceinline__ void phase_c3(const Frame& F, int l) {
    PHASE_BASES();
    const float* DT = WSP(float, WS_DT); const bf16_t* XC = WSP(bf16_t, WS_XC); const bf16_t* XCT = WSP(bf16_t, WS_XCT); const bf16_t* ENT = WSP(bf16_t, WS_ENT); bf16_t* YC = WSP(bf16_t, WS_YC);
    LAS float* abuf = (LAS float*)(F.lds + F.wave * A1_WAVE_BYTES);
    LAS float* dbuf = abuf + 64;
    const int r32 = lane & 31, hh = lane >> 5;
    for (int it = F.gw; it < NCU * 32; it += F.NGW) {
        const int tb = it & 1, h = (it >> 1) & 15, cu = it >> 5, g = h >> 2; const CuInfo ci = cu_info(cu);
        if (32 * tb >= ci.Tv) continue;
        const float Aneg = -expf(GPT(IN_ALOG)[l * 16 + h]), Dk = GPT(IN_CD)[l * 16 + h];
        const float dt = (lane < ci.Tv) ? DT[(size_t)(ci.row0 + lane) * 16 + h] : 0.f;
        bf16x8 cmf[8], entf[2][8];
#pragma unroll
        for (int ks = 0; ks < 8; ++ks) cmf[ks] = *(const bf16x8*)(XC + (size_t)(ci.row0 + 32 * tb + r32) * 2048 + 1536 + g * 128 + 16 * ks + 8 * hh);
#pragma unroll
        for (int pb = 0; pb < 2; ++pb)
#pragma unroll
            for (int ks = 0; ks < 8; ++ks) entf[pb][ks] = *(const bf16x8*)(ENT + ((size_t)(cu * 16 + h) * 64 + 32 * pb + r32) * 128 + 16 * ks + 8 * hh);
        const float acum = wave_incl_scan(dt * Aneg, lane);
        abuf[lane] = acum; dbuf[lane] = dt;
        const float acum_t = __shfl(acum, 32 * tb + r32);
        WAVE_SYNC();
        f32x16 y[2];
#pragma unroll
        for (int pb = 0; pb < 2; ++pb)
#pragma unroll
            for (int i = 0; i < 16; ++i) y[pb][i] = 0.f;
        for (int sb = 0; sb <= tb; ++sb) {
            f32x16 ga;
#pragma unroll
            for (int i = 0; i < 16; ++i) ga[i] = 0.f;
#pragma unroll
            for (int ks = 0; ks < 8; ++ks) { const bf16x8 bmf = *(const bf16x8*)(XC + (size_t)(ci.row0 + 32 * sb + r32) * 2048 + 1024 + g * 128 + 16 * ks + 8 * hh); ga = MFMA32(bmf, cmf[ks], ga); }
            const int tt = 32 * tb + r32;
#pragma unroll
            for (int q = 0; q < 4; ++q) {
                const f32x4 as = *(const LAS f32x4*)(abuf + 32 * sb + 8 * q + 4 * hh), ds = *(const LAS f32x4*)(dbuf + 32 * sb + 8 * q + 4 * hh);
#pragma unroll
                for (int e = 0; e < 4; ++e) { const int ss = 32 * sb + 8 * q + 4 * hh + e; ga[4 * q + e] = (ss <= tt) ? ga[4 * q + e] * exp_f(acum_t - as[e]) * ds[e] : 0.f; }
            }
#pragma unroll
            for (int ks2 = 0; ks2 < 2; ++ks2) {
                float pv[8];
#pragma unroll
                for (int j = 0; j < 8; ++j) pv[j] = ga[8 * ks2 + j];
                const bf16x8 pa = pack_bf16x8(pv);
#pragma unroll
                for (int pb = 0; pb < 2; ++pb) {
                    const bf16_t* xp = XCT + (size_t)(h * 64 + 32 * pb + r32) * MPADT + ci.row0 + 32 * sb + 16 * ks2 + 4 * hh;
                    const u32x2 x0 = *(const u32x2*)xp, x1 = *(const u32x2*)(xp + 8);
                    const u32x4 xw = (u32x4){x0.x, x0.y, x1.x, x1.y};
                    y[pb] = MFMA32(pa, __builtin_bit_cast(bf16x8, xw), y[pb]);
                }
            }
        }
        float ea[16];
#pragma unroll
        for (int q = 0; q < 4; ++q) { const f32x4 at = *(const LAS f32x4*)(abuf + 32 * tb + 8 * q + 4 * hh);
#pragma unroll
            for (int e = 0; e < 4; ++e) ea[4 * q + e] = exp_f(at[e]); }
#pragma unroll
        for (int pb = 0; pb < 2; ++pb) {
            f32x16 yo;
#pragma unroll
            for (int i = 0; i < 16; ++i) yo[i] = 0.f;
#pragma unroll
            for (int ks = 0; ks < 8; ++ks) yo = MFMA32(cmf[ks], entf[pb][ks], yo);
            const bf16_t* xp = XCT + (size_t)(h * 64 + 32 * pb + r32) * MPADT + ci.row0 + 32 * tb + 4 * hh;
#pragma unroll
            for (int q = 0; q < 4; ++q) { const u32x2 xw = *(const u32x2*)(xp + 8 * q); const float xs[4] = {bflo(xw.x), bfhi(xw.x), bflo(xw.y), bfhi(xw.y)};
#pragma unroll
                for (int e = 0; e < 4; ++e) { const int i = 4 * q + e; const float val = y[pb][i] + ea[i] * yo[i] + Dk * xs[e]; const int tl = 32 * tb + 8 * q + 4 * hh + e;
                    if (tl < ci.Tv) YC[(size_t)(ci.row0 + tl) * 1024 + h * 64 + 32 * pb + r32] = (bf16_t)f2bf(val); } }
        }
        WAVE_SYNC();
    }
}
__device__ __forceinline__ void phase_gn(const Frame& F, int l) {
    PHASE_BASES();
    const bf16_t* YC = WSP(bf16_t, WS_YC); const bf16_t* CZ = WSP(bf16_t, WS_CZ); bf16_t* MIX = WSP(bf16_t, WS_MIX); const float* cng = GPT(IN_CNG) + l * 1024;
    f32x4 ng[4];
#pragma unroll
    for (int g = 0; g < 4; ++g) ng[g] = *(const f32x4*)(cng + g * 256 + 4 * lane);
    u32x2 yw[4], zw[4], ywn[4], zwn[4];
#define GN_LOAD(Y_, Z_, row_) do { _Pragma("unroll") for (int g = 0; g < 4; ++g) { Y_[g] = *(const u32x2*)(YC + (size_t)(row_) * 1024 + g * 256 + 4 * lane); Z_[g] = *(const u32x2*)(CZ + (size_t)(row_) * 1024 + g * 256 + 4 * lane); } } while (0)
    if (F.gw < M) GN_LOAD(yw, zw, F.gw);
    for (int row = F.gw; row < M; row += F.NGW) {
        { const int rn = (row + F.NGW < M) ? row + F.NGW : row; GN_LOAD(ywn, zwn, rn); }
        float v[4][4], ss[4];
#pragma unroll
        for (int g = 0; g < 4; ++g) { v[g][0] = bflo(yw[g].x) * silu_f(bflo(zw[g].x)); v[g][1] = bfhi(yw[g].x) * silu_f(bfhi(zw[g].x)); v[g][2] = bflo(yw[g].y) * silu_f(bflo(zw[g].y)); v[g][3] = bfhi(yw[g].y) * silu_f(bfhi(zw[g].y));
            ss[g] = (v[g][0] * v[g][0] + v[g][1] * v[g][1]) + (v[g][2] * v[g][2] + v[g][3] * v[g][3]); }
#pragma unroll
        for (int o = 1; o < 64; o <<= 1) {
#pragma unroll
            for (int g = 0; g < 4; ++g) ss[g] += __shfl_xor(ss[g], o); }
#pragma unroll
        for (int g = 0; g < 4; ++g) { const float rn = FAST_RSQ(ss[g] * (1.0f / 256.0f) + EPSN);
            u32x2 o; o.x = pk2(v[g][0] * rn * ng[g].x, v[g][1] * rn * ng[g].y); o.y = pk2(v[g][2] * rn * ng[g].z, v[g][3] * rn * ng[g].w);
            *(u32x2*)(MIX + (size_t)row * 2048 + 1024 + g * 256 + 4 * lane) = o; }
#pragma unroll
        for (int g = 0; g < 4; ++g) { yw[g] = ywn[g]; zw[g] = zwn[g]; }
    }
}

#ifndef PHMASK
#define PHMASK 0xFFFFFFFFu
#endif
#ifndef PROBE_DUP
#define PROBE_DUP 0u
#endif
#define DUP(j) ((PROBE_DUP >> (j)) & 1u)
__global__ void __launch_bounds__(512, 2) mega(Args args) {
    DYN_LDS(lds);
    Frame F;
    F.lds = (LAS unsigned char*)lds;
    F.tid = threadIdx.x; F.lane = F.tid & 63;
#ifdef HOST_EMU
    F.wave = F.tid >> 6;
#else
    F.wave = __builtin_amdgcn_readfirstlane(F.tid >> 6);
#endif
    F.G = gridDim.x; F.gw = blockIdx.x * 8 + F.wave; F.NGW = F.G * 8;
    F.out = args.out; F.ws = args.ws;
#ifndef HOST_EMU
    volatile LAS unsigned* MISC = (volatile LAS unsigned*)(F.lds + MISC_OFF);
    if (F.tid < 64) MISC[F.tid] = 0u;
    __syncthreads();
    XcdBarrier bar = xcd_barrier_post((unsigned*)(args.ws + WS_CTL) + CW_BAR, MISC + 8);
#define GRID_BAR() xcd_barrier(bar)
#else
#define GRID_BAR() do { } while (0)
#endif
    const int lo = args.ph_lo, hi = args.ph_hi;
#define IN(k) (lo <= (k) && (k) < hi)
#define SEAM(k) do { if (IN(k) && IN((k) + 1)) GRID_BAR(); } while (0)
#define PHON(j) ((PHMASK >> (j)) & 1u)
    if (IN(0) && PHON(31)) { phase_prologue(F, args); if (DUP(31)) { GRID_BAR(); phase_prologue(F, args); } }
    SEAM(0);
    for (int l = 0; l < NL; ++l) {
        const int pb = 1 + l * PH_PER_LAYER;
        if (IN(pb + PH_G1) && PHON(PH_G1)) {
            PHASE_BASES();
            pg8::Gemm g{WSP(bf16_t, WS_XB), WSP(bf16_t, WS_WIN) + (size_t)l * NIN * D, M, NIN, D, D}; pg8::StaticOrder S; S.init(M, NIN, F.G, (int)blockIdx.x);
            EpiIn E{l, ws, outp};
            pg8::gemm_phase<EpiIn, pg8::StaticOrder, true, true>(F.lds, g, S, E);
            if (DUP(PH_G1)) { GRID_BAR(); pg8::gemm_phase<EpiIn, pg8::StaticOrder, true, true>(F.lds, g, S, E); }
        }
        SEAM(pb + PH_G1);
        if (IN(pb + PH_CONV) && PHON(PH_CONV)) { phase_conv(F, l); if (DUP(PH_CONV)) { GRID_BAR(); phase_conv(F, l); } }
        if (IN(pb + PH_A1) && PHON(PH_A1)) { phase_a1(F, l); if (DUP(PH_A1)) { GRID_BAR(); phase_a1(F, l, 2); } }
        SEAM(pb + PH_CONV);
        if (IN(pb + PH_B) && PHON(PH_B)) { phase_b(F, l); if (DUP(PH_B)) { GRID_BAR(); phase_b(F, l); } }
        if (IN(pb + PH_C1) && PHON(PH_C1)) { phase_c1(F, l); if (DUP(PH_C1)) { GRID_BAR(); phase_c1(F, l); } }
        if (IN(pb + PH_A2) && PHON(PH_A2)) { phase_a2(F, l); if (DUP(PH_A2)) { GRID_BAR(); phase_a2(F, l, 2); } }
        SEAM(pb + PH_C1);
        if (IN(pb + PH_C2) && PHON(PH_C2)) { phase_c2(F, l); if (DUP(PH_C2)) { GRID_BAR(); phase_c2(F, l); } }
        SEAM(pb + PH_C2);
        if (IN(pb + PH_C3) && PHON(PH_C3)) { phase_c3(F, l); if (DUP(PH_C3)) { GRID_BAR(); phase_c3(F, l); } }
        SEAM(pb + PH_C3);
        if (IN(pb + PH_GN) && PHON(PH_GN)) { phase_gn(F, l); if (DUP(PH_GN)) { GRID_BAR(); phase_gn(F, l); } }
        SEAM(pb + PH_GN);
        if (IN(pb + PH_G2) && PHON(PH_G2)) {
            PHASE_BASES();
            { pg8::Gemm g{WSP(bf16_t, WS_MIX), WSP(bf16_t, WS_WOUT) + (size_t)l * D * D, MP, D, D, D}; pg8::StaticOrder S; S.init(MP, D, F.G, (int)blockIdx.x);
              EpiOut E{outp + O_Y, ws, l};
              pg8::gemm_phase<EpiOut, pg8::StaticOrder, true, true>(F.lds, g, S, E); }
            { pg8::Gemm g{WSP(bf16_t, WS_MIX), WSP(bf16_t, WS_WOUT) + (size_t)l * D * D, M, D, D, D / NSL2}; pg8::TailOrder S; S.init(MP / 256, MS / 256, D, NSL2, D / NSL2, F.G, (int)blockIdx.x);
              EpiTail E{WSP(float, WS_PART), (D / NSL2) * 2};
              pg8::gemm_phase<EpiTail, pg8::TailOrder, true, true>(F.lds, g, S, E); }
        }
        SEAM(pb + PH_G2);
        if (IN(pb + PH_F2) && PHON(PH_F2)) phase_fin(F, 2 * l + 1, NSL2, true);
        SEAM(pb + PH_F2);
        if (IN(pb + PH_G3) && PHON(PH_G3)) {
            PHASE_BASES();
            pg8::Gemm g{WSP(bf16_t, WS_XB), WSP(bf16_t, WS_WGU) + (size_t)l * NGU * D, M, NGU, D, D}; pg8::StaticOrder S; S.init(M, NGU, F.G, (int)blockIdx.x);
            EpiGU E{ws, l};
            pg8::gemm_phase<EpiGU, pg8::StaticOrder, true, true>(F.lds, g, S, E);
            if (DUP(PH_G3)) { GRID_BAR(); pg8::gemm_phase<EpiGU, pg8::StaticOrder, true, true>(F.lds, g, S, E); }
        }
        SEAM(pb + PH_G3);
        if (IN(pb + PH_G4) && PHON(PH_G4)) {
            PHASE_BASES();
            { pg8::Gemm g{WSP(bf16_t, WS_HMID), WSP(bf16_t, WS_WDN) + (size_t)l * D * DFF, MP, D, DFF, DFF}; pg8::StaticOrder S; S.init(MP, D, F.G, (int)blockIdx.x);
              EpiDown E{outp + O_Y, ws, l};
              pg8::gemm_phase<EpiDown, pg8::StaticOrder, true, true>(F.lds, g, S, E); }
            { pg8::Gemm g{WSP(bf16_t, WS_HMID), WSP(bf16_t, WS_WDN) + (size_t)l * D * DFF, M, D, DFF, DFF / NSL4}; pg8::TailOrder S; S.init(MP / 256, MS / 256, D, NSL4, DFF / NSL4, F.G, (int)blockIdx.x);
              EpiTail E{WSP(float, WS_PART), (DFF / NSL4) * 2};
              pg8::gemm_phase<EpiTail, pg8::TailOrder, true, true>(F.lds, g, S, E); }
        }
        SEAM(pb + PH_G4);
        if (IN(pb + PH_F4) && PHON(PH_F4)) phase_fin(F, 2 * l + 2, NSL4, l + 1 < NL);
        SEAM(pb + PH_F4);
    }
#undef IN
#undef SEAM
}

#ifndef HOST_EMU
extern "C" void kernel_launch(void* const* d_in, const int* in_sizes, int n_in, void* d_out, int out_size, void* d_ws, size_t ws_size, hipStream_t stream) {
    static int grid = 0;
    if (grid == 0) {
        if (n_in != 27 || (size_t)out_size != O_END || ws_size < WS_END) { fprintf(stderr, "kernel_launch: unexpected sizes (n_in %d, out %d, ws %zu; need %zu / %zu)\n", n_in, out_size, ws_size, (size_t)O_END, (size_t)WS_END); grid = -1; return; }
        int dev = 0, cus = 0, per_cu = 0;
        if (hipGetDevice(&dev) != hipSuccess || hipDeviceGetAttribute(&cus, hipDeviceAttributeMultiprocessorCount, dev) != hipSuccess) { grid = -1; return; }
        if (hipFuncSetAttribute((const void*)mega, hipFuncAttributeMaxDynamicSharedMemorySize, LDS_BYTES) != hipSuccess) { fprintf(stderr, "kernel_launch: hipFuncSetAttribute failed\n"); grid = -1; return; }
        if (hipOccupancyMaxActiveBlocksPerMultiprocessor(&per_cu, (const void*)mega, 512, LDS_BYTES) != hipSuccess || per_cu < 1) fprintf(stderr, "kernel_launch: occupancy query reports %d\n", per_cu);
        (void)hipGetLastError();
        grid = cus;
    }
    if (grid < 0) return;
    if (hipMemsetAsync((char*)d_ws + WS_CTL, 0, CTL_ZERO_BYTES, stream) != hipSuccess) return;
    Args a{};
    for (int i = 0; i < 27; ++i) a.in[i] = (const float*)d_in[i];
    a.out = (float*)d_out; a.ws = (unsigned char*)d_ws;
#if ONE_LAUNCH
    a.ph_lo = 0; a.ph_hi = NPH;
    hipLaunchKernelGGL(mega, dim3(grid), dim3(512), LDS_BYTES, stream, a);
#else
    for (int ph = 0; ph < NPH; ++ph) { a.ph_lo = ph; a.ph_hi = ph + 1; hipLaunchKernelGGL(mega, dim3(grid), dim3(512), LDS_BYTES, stream, a); }
#endif
}
#endif
```

```cpp
#ifndef HOST_EMU
#include <hip/hip_runtime.h>
#endif
#include <cstdio>
#include <cstdint>
#include <cmath>

#ifndef CFG_BATCH
#define CFG_BATCH 4
#endif
#ifndef CFG_SEQ
#define CFG_SEQ 4096
#endif
#ifndef CFG_DEC_BATCH
#define CFG_DEC_BATCH 32
#endif
#ifndef CFG_PAST
#define CFG_PAST 4096
#endif
#ifndef CFG_DFF
#define CFG_DFF 5632
#endif
#ifndef ONE_LAUNCH
#define ONE_LAUNCH 1
#endif

#ifdef HOST_EMU
#define LAS
#define GAS
#define DYN_LDS(name) unsigned char* name = emu::B->lds
#define WAVE_SYNC() emu::wave_barrier()
#define MFMA32(a, b, c) emu_mfma32(a, b, c)
#define FAST_EXP2(x) exp2f(x)
#define FAST_LOG2(x) log2f(x)
#define FAST_RCP(x) (1.0f / (x))
#define FAST_RSQ(x) (1.0f / sqrtf(x))
#define MFMA16(a, b, c) emu_mfma16(a, b, c)
#else
#define LAS __attribute__((address_space(3)))
#define GAS __attribute__((address_space(1)))
#define DYN_LDS(name) extern __shared__ __attribute__((aligned(16))) unsigned char name[]
#define WAVE_SYNC() do { asm volatile("s_waitcnt lgkmcnt(0)" ::: "memory"); __builtin_amdgcn_wave_barrier(); } while (0)
#define MFMA32(a, b, c) __builtin_amdgcn_mfma_f32_32x32x16_bf16(a, b, c, 0, 0, 0)
#define FAST_EXP2(x) __builtin_amdgcn_exp2f(x)
#define FAST_LOG2(x) __builtin_amdgcn_logf(x)
#define FAST_RCP(x) __builtin_amdgcn_rcpf(x)
#define FAST_RSQ(x) __builtin_amdgcn_rsqf(x)
#define MFMA16(a, b, c) __builtin_amdgcn_mfma_f32_16x16x32_bf16(a, b, c, 0, 0, 0)
#endif
namespace pg8 {
#define PG8_LAS __attribute__((address_space(3)))
typedef unsigned short bf16_t;
typedef short bf16x8 __attribute__((ext_vector_type(8)));
typedef float f32x4 __attribute__((ext_vector_type(4)));
typedef unsigned u32x4 __attribute__((ext_vector_type(4)));
constexpr int BM = 256, BK = 64, HALF = 128, HTB = HALF * BK * 2  , STAGE_BYTES = 8 * HTB, NXCD = 8, WGM = 8;

__host__ __device__ __forceinline__ int lds_byte(int r, int c) { const int st = (r >> 4) * 2 + (c >> 5), rr = r & 15, cc = c & 31, ob = rr * 64 + cc * 2; return st * 1024 + (ob ^ (((ob >> 9) & 1) << 5)); }
__host__ __device__ __forceinline__ void stage_rc(int b, int& R, int& C) { const int st = b / 1024, sb = b % 1024, swz = sb ^ (((sb >> 9) & 1) << 5); R = (st >> 1) * 16 + swz / 64; C = (st & 1) * 32 + (swz % 64) / 2; }
__host__ __device__ __forceinline__ int perm32(int rho) { const int n = rho >> 4, i = rho & 15; return 8 * (i >> 2) + 4 * n + (i & 3); }

struct Unit { int pm, pn, kofs; };
struct Gemm { const bf16_t* A; const bf16_t* Bt; int M, N, K, Klen; };

struct StaticOrder {
    int nM, nN, nwg, G, c;
    __host__ __device__ void init(int M, int N, int G_, int c_) { nM = M / BM; nN = N / BM; nwg = nM * nN; G = G_; c = c_; }
    __host__ __device__ bool next(int i, Unit& u) const {
        const long L = (long)i * G + c; if (L >= nwg) return false;
        int wgid = (int)L; { const int q = nwg / NXCD, r = nwg % NXCD, xcd = wgid % NXCD, off = wgid / NXCD; wgid = (xcd < r ? xcd * (q + 1) : r * (q + 1) + (xcd - r) * q) + off; }
        const int nig = WGM * nN, gid = wgid / nig, fm = gid * WGM, gsz = (nM - fm) < WGM ? (nM - fm) : WGM;
        u.pm = fm + ((wgid % nig) % gsz); u.pn = (wgid % nig) / gsz; u.kofs = 0; return true;
    }
    __device__ __forceinline__ void a_ready(const Unit&) const {}
    __device__ __forceinline__ void done(const Unit&) const {}
};

struct TailOrder {
    int pm0, nN, ntile, nsl, klen_bytes, G, c;
    __host__ __device__ void init(int pm0_, int nM_, int N, int nsl_, int Klen, int G_, int c_) { pm0 = pm0_; nN = N / BM; ntile = nM_ * nN; nsl = nsl_; klen_bytes = Klen * 2; G = G_; c = c_; }
    __host__ __device__ bool next(int i, Unit& u) const {
        const long L = (long)i * G + c; if (L >= (long)ntile * nsl) return false;
        const int tile = (int)(L / nsl), sl = (int)(L % nsl); u.pm = pm0 + tile / nN; u.pn = tile % nN; u.kofs = sl * klen_bytes; return true;
    }
    __device__ __forceinline__ void a_ready(const Unit&) const {}
    __device__ __forceinline__ void done(const Unit&) const {}
};

#ifdef HOST_EMU
__device__ __forceinline__ unsigned cvt_pk_bf16(float lo, float hi) {
    auto f2b = [](float f) { unsigned u = __builtin_bit_cast(unsigned, f); return (u + 0x7fffu + ((u >> 16) & 1u)) >> 16; };
    return f2b(lo) | (f2b(hi) << 16);
}
#else
__device__ __forceinline__ unsigned cvt_pk_bf16(float lo, float hi) { unsigned r; asm volatile("v_cvt_pk_bf16_f32 %0, %1, %2" : "=v"(r) : "v"(lo), "v"(hi)); return r; }
#endif
typedef unsigned u32x4 __attribute__((ext_vector_type(4)));
#ifndef HOST_EMU
template <class Epi, class Sched, bool ALIGN_EPI = false, bool SP2 = false>
__device__ __forceinline__ void gemm_phase(PG8_LAS unsigned char* lds, const Gemm g, const Sched& S, const Epi& E) {
    int tid_l = threadIdx.x; asm volatile("" : "+v"(tid_l));
    const int tid = tid_l, wid = __builtin_amdgcn_readfirstlane(tid >> 6), lane = tid & 63, wr = wid >> 2, wc = wid & 3, fr = lane & 15, fq = lane >> 4;
    const int K = g.K, nt = g.Klen / BK;
    unsigned voffA[2], voffB[2];
#pragma unroll
    for (int i = 0; i < 2; ++i) { int R, C; stage_rc(tid * 16 + i * 8192, R, C); const int Rb = Epi::PERM ? ((R & ~31) + perm32(R & 31)) : R;
        voffA[i] = (unsigned)(R * K + C) * 2u; voffB[i] = (unsigned)(Rb * K + C) * 2u; }
    const size_t kstep = (size_t)(BK * 2);
    const size_t hstep = (size_t)HALF * K * 2;
    const size_t tstep = 2 * hstep;
    const unsigned ldsw = (unsigned)wid * 1024u;
    const int aoff = lds_byte(wr * 64 + fr, fq * 8), boff = lds_byte(wc * 32 + fr, fq * 8);
#define PG8_SA(b, h) (((b) * 2 + (h)) * HTB)
#define PG8_SB(b, h) ((4 + (b) * 2 + (h)) * HTB)
#define PG8_STAGE(bufoff, gbase, voff) do { _Pragma("unroll") for (int _i = 0; _i < 2; ++_i) \
        __builtin_amdgcn_global_load_lds((const unsigned*)((const char*)(gbase) + (voff)[_i]), (PG8_LAS unsigned*)(lds + (bufoff) + ldsw + _i * 8192), 16, 0, 0); } while (0)
#define PG8_LDA(dst, b, h) do { _Pragma("unroll") for (int m = 0; m < 4; ++m) _Pragma("unroll") for (int k = 0; k < 2; ++k) dst[m][k] = *(const PG8_LAS bf16x8*)(lds + PG8_SA(b, h) + aoff + m * 2048 + k * 1024); } while (0)
#define PG8_LDB(dst, b, h) do { _Pragma("unroll") for (int n = 0; n < 2; ++n) _Pragma("unroll") for (int k = 0; k < 2; ++k) dst[n][k] = *(const PG8_LAS bf16x8*)(lds + PG8_SB(b, h) + boff + n * 2048 + k * 1024); } while (0)
#define PG8_MMA(ai, bj, At, Bt) do { __builtin_amdgcn_s_setprio(1); _Pragma("unroll") for (int m = 0; m < 4; ++m) _Pragma("unroll") for (int n = 0; n < 2; ++n) _Pragma("unroll") for (int k = 0; k < 2; ++k) \
        acc[ai][bj][m][n] = __builtin_amdgcn_mfma_f32_16x16x32_bf16(Bt[n][k], At[m][k], acc[ai][bj][m][n], 0, 0, 0); __builtin_amdgcn_s_setprio(0); } while (0)
#define PG8_WAIT_V(n) asm volatile("s_waitcnt vmcnt(" #n ")" ::: "memory")
#define PG8_WAIT_L(n) asm volatile("s_waitcnt lgkmcnt(" #n ")" ::: "memory")
#define PG8_BAR __builtin_amdgcn_s_barrier()
#define PG8_SCHED __builtin_amdgcn_sched_barrier(0)
    Unit cur, nxt; int ui = 0;
    if (!S.next(0, cur)) return;
    f32x4 acc[2][2][4][2];
#pragma unroll
    for (int a = 0; a < 2; ++a)
#pragma unroll
        for (int b = 0; b < 2; ++b)
#pragma unroll
            for (int m = 0; m < 4; ++m)
#pragma unroll
                for (int n = 0; n < 2; ++n) acc[a][b][m][n] = (f32x4){0.f, 0.f, 0.f, 0.f};
    bf16x8 At[4][2], B0[2][2], B1[2][2];
    const char* cA = (const char*)g.A + (size_t)cur.pm * tstep + cur.kofs; const char* cB = (const char*)g.Bt + (size_t)cur.pn * tstep + cur.kofs;
    S.a_ready(cur);
    if constexpr (SP2) {
        PG8_STAGE(PG8_SB(0, 0), cB, voffB); PG8_STAGE(PG8_SB(0, 1), cB + hstep, voffB); PG8_STAGE(PG8_SA(0, 0), cA, voffA); PG8_STAGE(PG8_SA(0, 1), cA + hstep, voffA);
        if (wr == 1) PG8_BAR;
        PG8_WAIT_V(2); PG8_BAR;
        PG8_STAGE(PG8_SB(1, 0), cB + kstep, voffB); PG8_STAGE(PG8_SA(1, 0), cA + kstep, voffA); PG8_STAGE(PG8_SB(1, 1), cB + hstep + kstep, voffB);
        PG8_WAIT_V(6); PG8_BAR;
    } else {
        PG8_STAGE(PG8_SB(0, 0), cB, voffB); PG8_STAGE(PG8_SA(0, 0), cA, voffA); PG8_STAGE(PG8_SB(0, 1), cB + hstep, voffB); PG8_STAGE(PG8_SA(0, 1), cA + hstep, voffA);
        if (wr == 1) PG8_BAR;
        PG8_WAIT_V(4); PG8_BAR;
        PG8_STAGE(PG8_SB(1, 0), cB + kstep, voffB); PG8_STAGE(PG8_SA(1, 0), cA + kstep, voffA); PG8_STAGE(PG8_SB(1, 1), cB + hstep + kstep, voffB);
        PG8_WAIT_V(6); PG8_BAR;
    }
    for (;;) {
        const bool has_next = S.next(ui + 1, nxt);
        const char* nA = has_next ? (const char*)g.A + (size_t)nxt.pm * tstep + nxt.kofs : cA; const char* nB = has_next ? (const char*)g.Bt + (size_t)nxt.pn * tstep + nxt.kofs : cB;
        for (int t = 0; t < nt; t += 2) {
            const bool last = (t == nt - 2);
            const char* a1 = cA + (size_t)(t + 1) * kstep;
            const char* a2 = last ? nA : cA + (size_t)(t + 2) * kstep; const char* b2 = last ? nB : cB + (size_t)(t + 2) * kstep;
            const char* a3 = a2 + kstep; const char* b3 = b2 + kstep;
            if (last && has_next) S.a_ready(nxt);
            if constexpr (SP2) {
            PG8_LDB(B0, 0, 0); PG8_LDB(B1, 0, 1); PG8_SCHED; PG8_LDA(At, 0, 0); PG8_STAGE(PG8_SA(1, 1), a1 + hstep, voffA);
            PG8_WAIT_V(8); PG8_WAIT_L(0); PG8_BAR; PG8_MMA(0, 0, At, B0); PG8_MMA(0, 1, At, B1); PG8_BAR; PG8_SCHED;
            PG8_LDA(At, 0, 1); PG8_STAGE(PG8_SB(0, 0), b2, voffB); PG8_STAGE(PG8_SB(0, 1), b2 + hstep, voffB); PG8_STAGE(PG8_SA(0, 0), a2, voffA);
            PG8_WAIT_V(8); PG8_WAIT_L(0); PG8_BAR; PG8_MMA(1, 0, At, B0); PG8_MMA(1, 1, At, B1); PG8_BAR; PG8_SCHED;
            PG8_LDB(B0, 1, 0); PG8_LDB(B1, 1, 1); PG8_SCHED; PG8_LDA(At, 1, 0); PG8_STAGE(PG8_SA(0, 1), a2 + hstep, voffA);
            PG8_WAIT_V(8); PG8_WAIT_L(0); PG8_BAR; PG8_MMA(0, 0, At, B0); PG8_MMA(0, 1, At, B1); PG8_BAR; PG8_SCHED;
            PG8_LDA(At, 1, 1); PG8_STAGE(PG8_SB(1, 0), b3, voffB); PG8_STAGE(PG8_SB(1, 1), b3 + hstep, voffB); PG8_STAGE(PG8_SA(1, 0), a3, voffA);
            PG8_WAIT_V(8); PG8_WAIT_L(0); PG8_BAR; PG8_MMA(1, 0, At, B0); PG8_MMA(1, 1, At, B1); PG8_BAR; PG8_SCHED;
            } else {
            PG8_LDB(B0, 0, 0); PG8_SCHED; PG8_LDA(At, 0, 0); PG8_STAGE(PG8_SA(1, 1), a1 + hstep, voffA);
            PG8_WAIT_L(8); PG8_BAR; PG8_WAIT_L(0); PG8_MMA(0, 0, At, B0); PG8_BAR; PG8_SCHED;
            PG8_LDB(B1, 0, 1); PG8_STAGE(PG8_SB(0, 0), b2, voffB);
            PG8_BAR; PG8_WAIT_L(0); PG8_MMA(0, 1, At, B1); PG8_BAR;
            PG8_LDA(At, 0, 1); PG8_STAGE(PG8_SA(0, 0), a2, voffA);
            PG8_BAR; PG8_WAIT_L(0); PG8_MMA(1, 0, At, B0); PG8_BAR; PG8_SCHED;
            PG8_STAGE(PG8_SB(0, 1), b2 + hstep, voffB);
            PG8_WAIT_V(6); PG8_BAR; PG8_MMA(1, 1, At, B1); PG8_BAR;
            PG8_LDB(B0, 1, 0); PG8_SCHED; PG8_LDA(At, 1, 0); PG8_STAGE(PG8_SA(0, 1), a2 + hstep, voffA);
            PG8_WAIT_L(8); PG8_BAR; PG8_WAIT_L(0); PG8_MMA(0, 0, At, B0); PG8_BAR; PG8_SCHED;
            PG8_LDB(B1, 1, 1); PG8_STAGE(PG8_SB(1, 0), b3, voffB);
            PG8_BAR; PG8_WAIT_L(0); PG8_MMA(0, 1, At, B1); PG8_BAR;
            PG8_LDA(At, 1, 1); PG8_STAGE(PG8_SA(1, 0), a3, voffA);
            PG8_BAR; PG8_WAIT_L(0); PG8_MMA(1, 0, At, B0); PG8_BAR; PG8_SCHED;
            PG8_STAGE(PG8_SB(1, 1), b3 + hstep, voffB);
            PG8_WAIT_V(6); PG8_BAR; PG8_MMA(1, 1, At, B1); PG8_BAR;
            }
        }
        if constexpr (ALIGN_EPI) { if (wr == 0) PG8_BAR; }
        if constexpr (!Epi::AFTER_DRAIN) { int fr_e = fr, fq_e = fq; asm volatile("" : "+v"(fr_e), "+v"(fq_e));
            E(acc, cur, wr, wc, fr_e, fq_e); S.done(cur); }
        if (!has_next) break;
#pragma unroll
        for (int a = 0; a < 2; ++a)
#pragma unroll
            for (int b = 0; b < 2; ++b)
#pragma unroll
                for (int m = 0; m < 4; ++m)
#pragma unroll
                    for (int n = 0; n < 2; ++n) acc[a][b][m][n] = (f32x4){0.f, 0.f, 0.f, 0.f};
        cur = nxt; cA = nA; cB = nB; ++ui;
        if constexpr (ALIGN_EPI) { if (wr == 1) PG8_BAR; }
    }
    PG8_WAIT_V(0);
    if constexpr (!ALIGN_EPI) { if (wr == 0) PG8_BAR; }
    PG8_BAR;
    if constexpr (Epi::AFTER_DRAIN) { E.fused(acc, cur, wr, wc, fr, fq, lds, wid, lane); S.done(cur); }
#undef PG8_SA
#undef PG8_SB
#undef PG8_STAGE
#undef PG8_LDA
#undef PG8_LDB
#undef PG8_MMA
#undef PG8_WAIT_V
#undef PG8_WAIT_L
#undef PG8_BAR
#undef PG8_SCHED
}
#else
template <class Epi, class Sched, bool ALIGN_EPI = false, bool SP2 = false>
inline void gemm_phase(unsigned char* lds, const Gemm g, const Sched& S, const Epi& E) {
    (void)lds;
    static thread_local float* pa = nullptr; static thread_local float* pb = nullptr;
    const int tid = threadIdx.x, wid = tid >> 6, lane = tid & 63, wr = wid >> 2, wc = wid & 3, fr = lane & 15, fq = lane >> 4;
    const int K = g.K, KL = g.Klen;
    if (tid == 0 && !pa) { pa = (float*)malloc(256 * 8192 * 4); pb = (float*)malloc(256 * 8192 * 4); }
    __syncthreads();
    Unit cur;
    for (int ui = 0; S.next(ui, cur); ++ui) {
        { const int r = tid >> 1, h = tid & 1; const bf16_t* ar = g.A + (size_t)(cur.pm * 256 + r) * K + h * (K / 2); const bf16_t* br = g.Bt + (size_t)(cur.pn * 256 + r) * K + h * (K / 2);
          for (int k = 0; k < K / 2; ++k) { unsigned ua = (unsigned)ar[k] << 16, ub = (unsigned)br[k] << 16; pa[(size_t)r * K + h * (K / 2) + k] = __builtin_bit_cast(float, ua); pb[(size_t)r * K + h * (K / 2) + k] = __builtin_bit_cast(float, ub); } }
        __syncthreads();
        f32x4 acc[2][2][4][2];
        for (int ai = 0; ai < 2; ++ai) for (int bj = 0; bj < 2; ++bj) for (int m = 0; m < 4; ++m) for (int n = 0; n < 2; ++n) for (int e = 0; e < 4; ++e) {
            const int r = ai * 128 + wr * 64 + m * 16 + fr; const int c = bj * 128 + wc * 32 + (Epi::PERM ? 8 * fq + 4 * n + e : 16 * n + 4 * fq + e);
            const float* x = pa + (size_t)r * K + cur.kofs / 2; const float* y = pb + (size_t)c * K + cur.kofs / 2; float s = 0.f; for (int k = 0; k < KL; ++k) s += x[k] * y[k]; acc[ai][bj][m][n][e] = s; }
        E(acc, cur, wr, wc, fr, fq);
        __syncthreads();
    }
}
#endif
}
constexpr int D = 2048, NB = CFG_BATCH, T = CFG_SEQ, NL = 2, SB = CFG_DEC_BATCH, ST = 32, PAST = CFG_PAST, DFF = CFG_DFF;
constexpr int MP = NB * T, MS = SB * ST, M = MP + MS, LS = PAST + ST;
constexpr int NIN = 6656, NGU = 2 * DFF, WIN_COLS = 6496;
constexpr int KTOP_P = (T / 4 < 256) ? T / 4 : 256, KTOP_S = (LS / 4 < 256) ? LS / 4 : 256;
constexpr int LMAXV = (T > LS) ? T : LS, LPAD = (LMAXV + 63) / 64 * 64;
constexpr float EPSN = 1e-6f;
static_assert(M % 256 == 0 && T % 64 == 0 && DFF % 128 == 0 && PAST % 64 == 0, "tile divisibility");
constexpr size_t O_Y = 0;
constexpr size_t O_PAK = (size_t)M * D, O_PAV = O_PAK + (size_t)NL * MP * 128, O_PIK = O_PAV + (size_t)NL * MP * 128, O_PBK = O_PIK + (size_t)NL * MP * 64,
                 O_PBV = O_PBK + (size_t)NL * MP * 512, O_PSSM = O_PBV + (size_t)NL * MP * 512, O_PCONV = O_PSSM + (size_t)NL * NB * 131072,
                 O_SAK = O_PCONV + (size_t)NL * NB * 6144, O_SAV = O_SAK + (size_t)NL * MS * 128, O_SIK = O_SAV + (size_t)NL * MS * 128, O_SBK = O_SIK + (size_t)NL * MS * 64,
                 O_SBV = O_SBK + (size_t)NL * MS * 512, O_SSSM = O_SBV + (size_t)NL * MS * 512, O_SCONV = O_SSSM + (size_t)NL * SB * 131072, O_END = O_SCONV + (size_t)NL * SB * 6144;
constexpr size_t al256(size_t x) { return (x + 255) & ~(size_t)255; }
constexpr size_t WS_CTL = 0, CTL_ZERO_BYTES = 1u << 20;
constexpr int CW_BAR = 4096;
constexpr size_t CTL_QUEUE = 8192;
constexpr size_t CTL_QUEUE2 = 12288;
static_assert(NB + 1 <= 8 && CTL_QUEUE2 + (size_t)NL * 8 * 256 <= (size_t)CW_BAR * 4, "attention queues fit below the barrier words");
constexpr size_t CTL_RSS = 65536;
static_assert(CTL_RSS + (size_t)4 * M * 4 <= CTL_ZERO_BYTES, "RSS inside the memset region");
constexpr size_t WS_WIN = CTL_ZERO_BYTES;
constexpr size_t WS_WOUT = WS_WIN + al256((size_t)NL * NIN * D * 2);
constexpr size_t WS_WGU = WS_WOUT + al256((size_t)NL * D * D * 2);
constexpr size_t WS_WDN = WS_WGU + al256((size_t)NL * NGU * D * 2);
constexpr size_t WS_XB = WS_WDN + al256((size_t)NL * D * DFF * 2);
constexpr size_t WS_ROPE = WS_XB + al256((size_t)M * D * 2);
constexpr size_t WS_AQ = WS_ROPE + al256((size_t)LS * 16 * 4);
constexpr size_t WS_IQ = WS_AQ + al256((size_t)M * 512 * 2);
constexpr size_t WS_IW = WS_IQ + al256((size_t)M * 1024 * 2);
constexpr size_t WS_BQ = WS_IW + al256((size_t)M * 16 * 4);
constexpr size_t WS_CZ = WS_BQ + al256((size_t)M * 512 * 2);
constexpr size_t WS_CX = WS_CZ + al256((size_t)M * 1024 * 2);
constexpr size_t WS_DT = WS_CX + al256((size_t)M * 2048 * 2);
constexpr int NC = T / 64, NCU = NB * NC + SB, MPADT = M + 64;
constexpr size_t WS_XC = WS_DT + al256((size_t)M * 16 * 4);
constexpr size_t WS_XCT = WS_XC + al256((size_t)M * 2048 * 2);
constexpr size_t WS_CS = WS_XCT + al256((size_t)2048 * MPADT * 2);
constexpr size_t WS_CD = WS_CS + al256((size_t)NCU * 16 * 8192 * 4);
constexpr size_t WS_ENT = WS_CD + al256((size_t)NCU * 16 * 4);
constexpr size_t WS_YC = WS_ENT + al256((size_t)NCU * 16 * 8192 * 2);
constexpr int LSP = LPAD;
constexpr size_t WS_IKBP = WS_YC + al256((size_t)M * 1024 * 4);
constexpr size_t WS_IKBS = WS_IKBP + al256((size_t)MP * 64 * 2);
constexpr size_t WS_AKBP = WS_IKBS + al256((size_t)NL * SB * LSP * 64 * 2);
constexpr size_t WS_AKBS = WS_AKBP + al256((size_t)MP * 128 * 2);
constexpr size_t WS_AVTP = WS_AKBS + al256((size_t)NL * SB * LSP * 128 * 2);
constexpr size_t WS_AVTS = WS_AVTP + al256((size_t)NB * 128 * T * 2);
constexpr size_t WS_NSEL = WS_AVTS + al256((size_t)NL * SB * 128 * LSP * 2);
constexpr int MASK_W = LPAD / 32;
constexpr size_t WS_MASK = WS_NSEL + al256((size_t)M * 4);
constexpr size_t WS_MIX = WS_MASK + al256((size_t)M * MASK_W * 4);
constexpr size_t WS_HMID = WS_MIX + al256((size_t)M * 2048 * 2);
constexpr size_t WS_PART = WS_HMID + al256((size_t)M * DFF * 2);
constexpr size_t WS_GT = WS_PART + al256((size_t)4 * MS * D * 4);
constexpr size_t WS_PT = WS_GT + 4096;
constexpr size_t WS_END = WS_PT + 4096;
constexpr int A1_NEED = LPAD * 4;
constexpr int A1_WAVE_BYTES = (A1_NEED > 9216) ? A1_NEED : 9216;
constexpr int A1_TILE_OFF = 8 * A1_WAVE_BYTES, A1_TILE_B = 64 * 144;
constexpr int LDS_PHASE_BYTES = (A1_TILE_OFF + 2 * A1_TILE_B > 139264) ? A1_TILE_OFF + 2 * A1_TILE_B : 139264;
constexpr int MISC_OFF = (LDS_PHASE_BYTES + 255) / 256 * 256, LDS_BYTES = MISC_OFF + 256;
static_assert(LDS_BYTES <= 163840 && A1_WAVE_BYTES >= 6144, "LDS budget");
constexpr int PH_PER_LAYER = 14, NPH = 1 + NL * PH_PER_LAYER;
enum { PH_G1 = 0, PH_A1, PH_CONV, PH_A2, PH_B, PH_C1, PH_C2, PH_C3, PH_GN, PH_G2, PH_F2, PH_G3, PH_G4, PH_F4 };
constexpr int NSL2 = 4, NSL4 = ((DFF / 4) % 128 == 0) ? 4 : (((DFF / 2) % 128 == 0) ? 2 : 1);

typedef unsigned short bf16_t;
typedef float f32x4 __attribute__((ext_vector_type(4)));
typedef unsigned u32x4 __attribute__((ext_vector_type(4)));
typedef unsigned u32x2 __attribute__((ext_vector_type(2)));
typedef short bf16x8 __attribute__((ext_vector_type(8)));
typedef float f32x16 __attribute__((ext_vector_type(16)));

__device__ __forceinline__ unsigned f2bf(float f) { unsigned u = __builtin_bit_cast(unsigned, f); return (u + 0x7fffu + ((u >> 16) & 1u)) >> 16; }
__device__ __forceinline__ float bf2f(unsigned h) { return __builtin_bit_cast(float, h << 16); }
__device__ __forceinline__ float bflo(unsigned w) { return __builtin_bit_cast(float, w << 16); }
__device__ __forceinline__ float bfhi(unsigned w) { return __builtin_bit_cast(float, w & 0xffff0000u); }
#ifdef HOST_EMU
__device__ __forceinline__ unsigned pk2(float lo, float hi) { return f2bf(lo) | (f2bf(hi) << 16); }
#else
__device__ __forceinline__ unsigned pk2(float lo, float hi) { unsigned r; asm("v_cvt_pk_bf16_f32 %0, %1, %2" : "=v"(r) : "v"(lo), "v"(hi)); return r; }
#endif
__device__ __forceinline__ float exp_f(float x) { return FAST_EXP2(x * 1.4426950408889634f); }
__device__ __forceinline__ float silu_f(float x) { return x * FAST_RCP(1.f + FAST_EXP2(-1.4426950408889634f * x)); }
__device__ __forceinline__ float softplus_f(float x) { return fmaxf(x, 0.f) + 0.6931471805599453f * FAST_LOG2(1.f + FAST_EXP2(-1.4426950408889634f * fabsf(x))); }
__device__ __forceinline__ float wave_sum(float v) {
#pragma unroll
    for (int o = 1; o < 64; o <<= 1) v += __shfl_xor(v, o);
    return v;
}
__device__ __forceinline__ float wave_max(float v) {
#pragma unroll
    for (int o = 1; o < 64; o <<= 1) v = fmaxf(v, __shfl_xor(v, o));
    return v;
}
__device__ __forceinline__ float wave_incl_scan(float v, int lane) {
#pragma unroll
    for (int off = 1; off < 64; off <<= 1) { const float tt = __shfl_up(v, off); if (lane >= off) v += tt; }
    return v;
}
__device__ __forceinline__ bf16x8 pack_bf16x8(const float (&v)[8]) { u32x4 w; w.x = pk2(v[0], v[1]); w.y = pk2(v[2], v[3]); w.z = pk2(v[4], v[5]); w.w = pk2(v[6], v[7]); return __builtin_bit_cast(bf16x8, w); }
__device__ __forceinline__ unsigned sortable_key(float s) { const unsigned u = __builtin_bit_cast(unsigned, s); return (u & 0x80000000u) ? ~u : (u | 0x80000000u); }

#ifndef HOST_EMU
#define XB_TMO      128
#define XB_XCNT(j)  (256  + 64 * (j))
#define XB_XSUB(j)  (1280 + 64 * (j))
#define XB_XGEN(j)  (2304 + 64 * (j))
#define XB_TOP      3328
#define XB_TOPGEN   3392
#define XCD_BAR_WORDS 3456
#define XB_SPIN_CAP (1u << 18)

__device__ __forceinline__ unsigned xb_ld(unsigned* p)              { return __hip_atomic_load(p, __ATOMIC_RELAXED, __HIP_MEMORY_SCOPE_AGENT); }
__device__ __forceinline__ unsigned xb_add(unsigned* p, unsigned v) { return __hip_atomic_fetch_add(p, v, __ATOMIC_RELAXED, __HIP_MEMORY_SCOPE_AGENT); }
__device__ __forceinline__ unsigned xb_xcc_id() { return (unsigned)__builtin_amdgcn_s_getreg((3 << 11) | 20) & 0xFu; }
#define XB_SPIN(cond, bar) do { unsigned _sp = 0; while (cond) { __builtin_amdgcn_s_sleep(1); \
    if ((++_sp & 255u) == 0u) { if (xb_ld(&(bar)[XB_TMO])) break; if (_sp > XB_SPIN_CAP) { atomicAdd(&(bar)[XB_TMO], 1u); break; } } } } while (0)

struct XcdBarrier {
    unsigned* bar; unsigned x;
    volatile LAS unsigned* st;
};

__device__ __forceinline__ XcdBarrier xcd_barrier_post(unsigned* bar, volatile LAS unsigned* st) {
    XcdBarrier b; b.bar = bar; b.x = xb_xcc_id(); b.st = st;
    if (threadIdx.x == 0) (void)xb_add(&bar[XB_XCNT(b.x)], 1u);
    return b;
}
__device__ __forceinline__ void xcd_barrier_complete(unsigned* bar, unsigned x, unsigned& nloc, unsigned& nx) {
    const unsigned G = gridDim.x * gridDim.y * gridDim.z;
    unsigned sum, cnt, mine, sp = 0u;
    for (;;) {
        sum = 0u; cnt = 0u; mine = 0u;
#pragma unroll
        for (unsigned j = 0; j < 16; ++j) { const unsigned c = xb_ld(&bar[XB_XCNT(j)]); sum += c; cnt += (c > 0u) ? 1u : 0u; mine = (j == x) ? c : mine; }
        if (sum == G) break;
        __builtin_amdgcn_s_sleep(1);
        if ((++sp & 255u) == 0u) { if (xb_ld(&bar[XB_TMO])) break; if (sp > XB_SPIN_CAP) { atomicAdd(&bar[XB_TMO], 1u); break; } }
    }
    nloc = mine > 0u ? mine : 1u; nx = cnt > 0u ? cnt : 1u;
}

__device__ __forceinline__ void xcd_barrier(const XcdBarrier& b) {
    asm volatile("s_waitcnt vmcnt(0)" ::: "memory");
    __syncthreads();
    if (threadIdx.x == 0) {
        unsigned* bar = b.bar;
        __builtin_amdgcn_s_waitcnt(0);
        unsigned nloc = b.st[0], nx = b.st[1];
        if (nloc == 0u) { xcd_barrier_complete(bar, b.x, nloc, nx); b.st[0] = nloc; b.st[1] = nx; }
        const unsigned old = xb_add(&bar[XB_XSUB(b.x)], 1u);
        const unsigned gen = old / nloc;
        if (old + 1u == (gen + 1u) * nloc) {
            __builtin_amdgcn_fence(__ATOMIC_RELEASE, "agent");
            asm volatile("s_waitcnt vmcnt(0)" ::: "memory");
            const unsigned og = xb_add(&bar[XB_TOP], 1u);
            const unsigned tg = og / nx;
            if (og + 1u == (tg + 1u) * nx) xb_add(&bar[XB_TOPGEN], 1u);
            else XB_SPIN(xb_ld(&bar[XB_TOPGEN]) == tg, bar);
            __builtin_amdgcn_fence(__ATOMIC_ACQUIRE, "agent");
            xb_add(&bar[XB_XGEN(b.x)], 1u);
            asm volatile("s_waitcnt vmcnt(0)" ::: "memory");
        } else {
            XB_SPIN(xb_ld(&bar[XB_XGEN(b.x)]) == gen, bar);
            __builtin_amdgcn_fence(__ATOMIC_ACQUIRE, "agent");
            asm volatile("s_waitcnt vmcnt(0)" ::: "memory");
        }
    }
    __syncthreads();
}
#endif

struct Args { const float* in[27]; float* out; unsigned char* ws; int ph_lo, ph_hi; };
struct Frame {
    LAS unsigned char* lds;
    int tid, lane, wave, G, gw, NGW;
    float* out; unsigned char* ws;
};
#define WSP(Tp, off) ((Tp*)(ws + (off)))
#ifdef HOST_EMU
#define EPI_FENCE() do { } while (0)
#define LAUNDER(p) do { } while (0)
#define LAUNDER_V(p) do { } while (0)
#else
#define EPI_FENCE() asm volatile("" ::: "memory")
#define LAUNDER(p) asm volatile("" : "+s"(p))
#define LAUNDER_V(p) asm volatile("" : "+v"(p))
#endif
#ifdef HOST_EMU
#define GPT(k) (PT[k])
#define PHASE_BASES() unsigned char* ws = F.ws; float* outp = F.out; const float* const* PT = (const float* const*)(ws + WS_PT); (void)PT; (void)outp; int tidl = threadIdx.x; LAUNDER_V(tidl); const int lane = tidl & 63; (void)lane
#else
#define GPT(k) ((const float*)(GAS const float*)PT[k])
#define PHASE_BASES() unsigned long long ws_u_ = (unsigned long long)F.ws, out_u_ = (unsigned long long)F.out; LAUNDER(ws_u_); LAUNDER(out_u_); unsigned char* ws = (unsigned char*)(GAS unsigned char*)ws_u_; float* outp = (float*)(GAS float*)out_u_; const unsigned long long* PT = (const unsigned long long*)(ws + WS_PT); (void)PT; (void)outp; int tidl = threadIdx.x; LAUNDER_V(tidl); const int lane = tidl & 63; (void)lane
#endif
enum { IN_XP = 0, IN_XS, IN_CAK, IN_CAV, IN_CAIK, IN_CBK, IN_CBV, IN_SSM, IN_SCONV, IN_N1G, IN_WIN, IN_GAQ, IN_GAK, IN_GIK, IN_GBQ, IN_GBK, IN_CONVW, IN_CONVB, IN_DTB, IN_ALOG, IN_CD, IN_CNG, IN_WOUT, IN_N2G, IN_WGATE, IN_WUP, IN_WDOWN };
constexpr int GT_STRIDE = 384;

struct RowInfo { bool prompt; int b, t, pos, rg; };
__device__ __forceinline__ RowInfo row_info(int row) {
    RowInfo r; r.prompt = row < MP;
    if (r.prompt) { r.rg = row; r.b = row / T; r.t = row - r.b * T; r.pos = r.t; }
    else { r.rg = row - MP; r.b = r.rg / ST; r.t = r.rg - r.b * ST; r.pos = PAST + r.t; }
    return r;
}
template <int W> __device__ __forceinline__ const float* kv_row(const float* outp, const float* outs, const float* cache, int l, bool prompt, int b, int s) {
    if (prompt) return outp + ((size_t)l * MP + (size_t)b * T + s) * W;
    if (s < PAST) return cache + (((size_t)l * SB + b) * PAST + s) * W;
    return outs + ((size_t)l * MS + (size_t)b * ST + (s - PAST)) * W;
}

__device__ __forceinline__ int inproj_src_col(int p) {
    const int pl = p & 255, L = (p & ~255) + 64 * ((pl >> 5) & 3) + 32 * ((pl >> 7) & 1) + (pl & 31);
    if (L < 1856) return L;
    if (L < 6464) return L + 16;
    if (L < 6480) return 1856 + (L - 6464);
    if (L < 6496) return L;
    return -1;
}
template <class ColFn>
__device__ __forceinline__ void transpose_load(f32x4 (&v)[2][8], const float* W, int ldw, ColFn colfn, const float* gain, int k0, int n0, int lane) {
    const int nq = lane & 15, kq = lane >> 4;
#pragma unroll
    for (int h = 0; h < 2; ++h) { const int col = colfn(n0 + 64 * h + 4 * nq);
#pragma unroll
        for (int j = 0; j < 8; ++j) v[h][j] = (col >= 0) ? *(const f32x4*)(W + (size_t)(k0 + 4 * j + kq) * ldw + col) : (f32x4){0.f, 0.f, 0.f, 0.f}; }
    if (gain) {
#pragma unroll
        for (int j = 0; j < 8; ++j) { const float g = gain[k0 + 4 * j + kq]; v[0][j] = v[0][j] * g; v[1][j] = v[1][j] * g; } }
}
__device__ __forceinline__ void transpose_store(const f32x4 (&v)[2][8], int K, bf16_t* WT, LAS float* scr, int k0, int n0, int lane) {
    const int nq = lane & 15, kq = lane >> 4;
#pragma unroll
    for (int h = 0; h < 2; ++h) {
#pragma unroll
        for (int j = 0; j < 8; ++j) *(LAS f32x4*)(scr + (4 * j + kq) * 68 + 4 * nq) = v[h][j];
        WAVE_SYNC();
        bf16_t* orow = WT + (size_t)(n0 + 64 * h + lane) * K + k0;
#pragma unroll
        for (int q = 0; q < 4; ++q) { u32x4 o;
            o.x = pk2(scr[(8 * q + 0) * 68 + lane], scr[(8 * q + 1) * 68 + lane]); o.y = pk2(scr[(8 * q + 2) * 68 + lane], scr[(8 * q + 3) * 68 + lane]);
            o.z = pk2(scr[(8 * q + 4) * 68 + lane], scr[(8 * q + 5) * 68 + lane]); o.w = pk2(scr[(8 * q + 6) * 68 + lane], scr[(8 * q + 7) * 68 + lane]);
            *(u32x4*)(orow + 8 * q) = o; }
        WAVE_SYNC();
    }
}
#define TRANSPOSE_MATRIX(NIT_, NBLK_, KB_, W_OF_NB, LDW_, COLFN_, GAIN_, KDIM_, WT_) do { const int nit_ = (NIT_); f32x4 va_[2][8], vb_[2][8]; \
        { const int c_ = (F.gw < nit_) ? F.gw : nit_ - 1; const int kb_ = c_ / (NBLK_), nb_ = c_ % (NBLK_); transpose_load(va_, W_OF_NB(nb_), (LDW_), COLFN_, (GAIN_), (KB_) * kb_, 128 * nb_, lane); } \
        for (int it_ = F.gw; it_ < nit_; it_ += 2 * F.NGW) { \
            { const int n_ = it_ + F.NGW, c_ = (n_ < nit_) ? n_ : nit_ - 1; const int kb_ = c_ / (NBLK_), nb_ = c_ % (NBLK_); transpose_load(vb_, W_OF_NB(nb_), (LDW_), COLFN_, (GAIN_), (KB_) * kb_, 128 * nb_, lane); } \
            { const int kb_ = it_ / (NBLK_), nb_ = it_ % (NBLK_); transpose_store(va_, (KDIM_), (WT_), scr, (KB_) * kb_, 128 * nb_, lane); } \
            { const int n_ = it_ + 2 * F.NGW, c_ = (n_ < nit_) ? n_ : nit_ - 1; const int kb_ = c_ / (NBLK_), nb_ = c_ % (NBLK_); transpose_load(va_, W_OF_NB(nb_), (LDW_), COLFN_, (GAIN_), (KB_) * kb_, 128 * nb_, lane); } \
            if (it_ + F.NGW < nit_) { const int n_ = it_ + F.NGW; const int kb_ = n_ / (NBLK_), nb_ = n_ % (NBLK_); transpose_store(vb_, (KDIM_), (WT_), scr, (KB_) * kb_, 128 * nb_, lane); } \
        } } while (0)
__device__ __forceinline__ void sincos_d(double x, double& s, double& c) {
    const double k = rint(x * 0.63661977236758134308); const double r = (x - k * 1.57079632679489655800) - k * 6.123233995736766036e-17; const double r2 = r * r;
    const double sp = r * (1.0 + r2 * (-1.0 / 6 + r2 * (1.0 / 120 + r2 * (-1.0 / 5040 + r2 * (1.0 / 362880 + r2 * (-1.0 / 39916800 + r2 * (1.0 / 6227020800.0)))))));
    const double cp = 1.0 + r2 * (-0.5 + r2 * (1.0 / 24 + r2 * (-1.0 / 720 + r2 * (1.0 / 40320 + r2 * (-1.0 / 3628800 + r2 * (1.0 / 479001600 + r2 * (-1.0 / 87178291200.0)))))));
    const int q = ((int)k) & 3;
    s = (q == 0) ? sp : (q == 1) ? cp : (q == 2) ? -sp : -cp; c = (q == 0) ? cp : (q == 1) ? -sp : (q == 2) ? -cp : sp;
}
__device__ __forceinline__ void phase_prologue(const Frame& F, const Args& A) {
    unsigned char* ws = F.ws;
    if (blockIdx.x == 0 && F.tid == 0) { const float** pt = (const float**)(ws + WS_PT);
#pragma unroll
        for (int i = 0; i < 27; ++i) pt[i] = A.in[i]; }
    LAS float* scr = (LAS float*)(F.lds + F.wave * 16384);
    const int lane = F.lane;
    for (int l = 0; l < NL; ++l) {
        { const float* W = A.in[IN_WIN] + (size_t)l * D * WIN_COLS; const float* gain = A.in[IN_N1G] + l * D; bf16_t* WT = WSP(bf16_t, WS_WIN) + (size_t)l * NIN * D;
#define W_SAME(nb_) W
          TRANSPOSE_MATRIX((D / 32) * (NIN / 128), (NIN / 128), 32, W_SAME, WIN_COLS, [](int p) { return inproj_src_col(p); }, gain, D, WT); }
        { const float* Wg = A.in[IN_WGATE] + (size_t)l * D * DFF; const float* Wu = A.in[IN_WUP] + (size_t)l * D * DFF; const float* gain = A.in[IN_N2G] + l * D; bf16_t* WT = WSP(bf16_t, WS_WGU) + (size_t)l * NGU * D;
#define W_GU(nb_) (((nb_) & 1) ? Wu : Wg)
          TRANSPOSE_MATRIX((D / 32) * (NGU / 128), (NGU / 128), 32, W_GU, DFF, [](int p) { const int pl = p & 255; return 128 * (p >> 8) + 32 * ((pl >> 5) & 3) + (pl & 31); }, gain, D, WT); }
        { const float* W = A.in[IN_WOUT] + (size_t)l * D * D; bf16_t* WT = WSP(bf16_t, WS_WOUT) + (size_t)l * D * D;
          TRANSPOSE_MATRIX((D / 32) * (D / 128), (D / 128), 32, W_SAME, D, [](int p) { return p; }, (const float*)nullptr, D, WT); }
        { const float* W = A.in[IN_WDOWN] + (size_t)l * DFF * D; bf16_t* WT = WSP(bf16_t, WS_WDN) + (size_t)l * D * DFF;
          TRANSPOSE_MATRIX((DFF / 32) * (D / 128), (D / 128), 32, W_SAME, D, [](int p) { return p; }, (const float*)nullptr, DFF, WT); }
    }
    { const float* cik = A.in[IN_CAIK];
      bf16_t* IKBS = WSP(bf16_t, WS_IKBS);
      const size_t gt_ = (size_t)blockIdx.x * 512 + F.tid, gs_ = (size_t)F.G * 512;
      for (size_t i = gt_; i < (size_t)NL * SB * PAST * 8; i += gs_) { const size_t rowi = i >> 3; const int c8 = (int)(i & 7) * 8; const size_t lb = rowi / PAST; const int sidx = (int)(rowi - lb * PAST);
          const f32x4 a = *(const f32x4*)(cik + rowi * 64 + c8), b4 = *(const f32x4*)(cik + rowi * 64 + c8 + 4);
          u32x4 w; w.x = pk2(a.x, a.y); w.y = pk2(a.z, a.w); w.z = pk2(b4.x, b4.y); w.w = pk2(b4.z, b4.w); *(u32x4*)(IKBS + (lb * LSP + sidx) * 64 + c8) = w; }
      for (size_t i = gt_; i < (size_t)NL * SB * (LSP - LS) * 8; i += gs_) { const size_t pr = i >> 3; const int c8 = (int)(i & 7) * 8; const size_t lb = pr / (LSP - LS); const int sidx = LS + (int)(pr - lb * (LSP - LS));
          *(u32x4*)(IKBS + (lb * LSP + sidx) * 64 + c8) = (u32x4){0u, 0u, 0u, 0u}; }
    }
    { const float* cak = A.in[IN_CAK]; bf16_t* AKBS = WSP(bf16_t, WS_AKBS); const size_t gt_ = (size_t)blockIdx.x * 512 + F.tid, gs_ = (size_t)F.G * 512;
      (void)cak;
      for (size_t i = gt_; i < (size_t)NL * SB * (LSP - LS) * 16; i += gs_) { const size_t pr = i >> 4; const int c8 = (int)(i & 15) * 8; const size_t lb = pr / (LSP - LS); const int sidx = LS + (int)(pr - lb * (LSP - LS));
          *(u32x4*)(AKBS + (lb * LSP + sidx) * 128 + c8) = (u32x4){0u, 0u, 0u, 0u}; }
    }
    { const float* cav = A.in[IN_CAV]; bf16_t* AVTS = WSP(bf16_t, WS_AVTS); const size_t gt_ = (size_t)blockIdx.x * 512 + F.tid, gs_ = (size_t)F.G * 512;
      (void)cav;
      for (size_t i = gt_; i < (size_t)NL * SB * 128 * ((LSP - LS) / 8); i += gs_) { const size_t rw = i / ((LSP - LS) / 8); const int c8 = (int)(i % ((LSP - LS) / 8)) * 8; *(u32x4*)(AVTS + rw * LSP + LS + c8) = (u32x4){0u, 0u, 0u, 0u}; }
    }
    if (blockIdx.x == 0) {
        float* gt = WSP(float, WS_GT);
        for (int i = F.tid; i < NL * GT_STRIDE; i += 512) { const int l = i / GT_STRIDE, j = i % GT_STRIDE; float v = 0.f;
            if (j < 64) v = A.in[IN_GAQ][l * 64 + j]; else if (j < 128) v = A.in[IN_GAK][l * 64 + j - 64]; else if (j < 192) v = A.in[IN_GIK][l * 64 + j - 128];
            else if (j < 256) v = A.in[IN_GBQ][l * 64 + j - 192]; else if (j < 320) v = A.in[IN_GBK][l * 64 + j - 256]; else if (j < 336) v = A.in[IN_DTB][l * 16 + j - 320];
            gt[i] = v; }
    }
    { const float* xs = A.in[IN_XS]; float* X = F.out + O_Y + (size_t)MP * D;
      for (size_t i = (size_t)blockIdx.x * 512 + F.tid; i < (size_t)MS * D / 4; i += (size_t)F.G * 512) *(f32x4*)(X + 4 * i) = *(const f32x4*)(xs + 4 * i); }
    { const float* xp = A.in[IN_XP]; const float* xs = A.in[IN_XS]; bf16_t* XB = WSP(bf16_t, WS_XB); float* RSS = WSP(float, CTL_RSS);
      for (int row0 = F.gw; row0 < M; row0 += 2 * F.NGW) {
        const int rowb = row0 + F.NGW; const bool hasb = rowb < M; const int rb2 = hasb ? rowb : row0;
        const float* xa = (row0 < MP) ? xp + (size_t)row0 * D : xs + (size_t)(row0 - MP) * D; const float* xb = (rb2 < MP) ? xp + (size_t)rb2 * D : xs + (size_t)(rb2 - MP) * D;
        f32x4 va[8], vb[8];
#pragma unroll
        for (int j = 0; j < 8; ++j) va[j] = *(const f32x4*)(xa + 4 * lane + 256 * j);
#pragma unroll
        for (int j = 0; j < 8; ++j) vb[j] = *(const f32x4*)(xb + 4 * lane + 256 * j);
        float sa = 0.f, sb = 0.f;
#pragma unroll
        for (int j = 0; j < 8; ++j) { sa += (va[j].x * va[j].x + va[j].y * va[j].y) + (va[j].z * va[j].z + va[j].w * va[j].w); u32x2 o; o.x = pk2(va[j].x, va[j].y); o.y = pk2(va[j].z, va[j].w); *(u32x2*)(XB + (size_t)row0 * D + 4 * lane + 256 * j) = o; }
        if (hasb) {
#pragma unroll
            for (int j = 0; j < 8; ++j) { sb += (vb[j].x * vb[j].x + vb[j].y * vb[j].y) + (vb[j].z * vb[j].z + vb[j].w * vb[j].w); u32x2 o; o.x = pk2(vb[j].x, vb[j].y); o.y = pk2(vb[j].z, vb[j].w); *(u32x2*)(XB + (size_t)rowb * D + 4 * lane + 256 * j) = o; } }
        sa = wave_sum(sa); sb = wave_sum(sb);
        if (lane == 0) { RSS[row0] = sa; if (hasb) RSS[rowb] = sb; }
      } }
    { float* ROPE = WSP(float, WS_ROPE);
      for (int i = blockIdx.x * 512 + F.tid; i < LS * 8; i += F.G * 512) {
        const int pos = i >> 3, j = i & 7;
        const float invf = (j == 0) ? 1.0f : (j == 1) ? 0.193922758102417f : (j == 2) ? 0.03760603070259094f : (j == 3) ? 0.00729266507551074f : (j == 4) ? 0.001414213445968926f
                         : (j == 5) ? 0.00027424818836152554f : (j == 6) ? 5.318296462064609e-05f : 1.0313385246263351e-05f;
        const float ang = (float)pos * invf; double sn, cs; sincos_d((double)ang, sn, cs);
        ROPE[pos * 16 + j] = (float)cs; ROPE[pos * 16 + 8 + j] = (float)sn;
      } }
}

__device__ __forceinline__ void st_bf16x8(bf16_t* p, const float (&v)[8]) { u32x4 w; w.x = pk2(v[0], v[1]); w.y = pk2(v[2], v[3]); w.z = pk2(v[4], v[5]); w.w = pk2(v[6], v[7]); *(u32x4*)p = w; }
__device__ __forceinline__ void st_f32x8(float* p, const float (&v)[8]) { *(f32x4*)p = (f32x4){v[0], v[1], v[2], v[3]}; *(f32x4*)(p + 4) = (f32x4){v[4], v[5], v[6], v[7]}; }

struct EpiIn {
    static constexpr bool PERM = true, AFTER_DRAIN = false;
    int l; unsigned char* ws; float* out;
    __device__ __forceinline__ void operator()(const f32x4 (&acc)[2][2][4][2], const pg8::Unit& u, int wr, int wc, int fr, int fq) const {
        const int grp = u.pn * 4 + wc;
        if (grp >= 102) return;
        const float* rss = (const float*)(ws + CTL_RSS) + (size_t)(2 * l) * M; const float* rope = (const float*)(ws + WS_ROPE); const float* gt = (const float*)(ws + WS_GT) + l * GT_STRIDE;
        int kind = 0, coff = 0, bstride = 0, fstride = 0; bool do_norm = false, do_rope = false, conv_tail = false; const float* gain = gt;
        bf16_t* bb = nullptr; float* fP = nullptr; float* fS = nullptr;
        int side = 0, sstride = 0; bf16_t* sP = nullptr; bf16_t* sS = nullptr;
        bool qscale = false;
        if (grp < 8) { kind = 0; bb = (bf16_t*)(ws + WS_AQ); bstride = 512; coff = grp * 64; do_norm = true; do_rope = true; gain = gt; qscale = true; }
        else if (grp < 10) { kind = 1; fP = out + O_PAK + (size_t)l * MP * 128; fS = out + O_SAK + (size_t)l * MS * 128; fstride = 128; coff = (grp - 8) * 64; do_norm = true; do_rope = true; gain = gt + 64;
            side = 1; sstride = 128; sP = (bf16_t*)(ws + WS_AKBP); sS = (bf16_t*)(ws + WS_AKBS) + (size_t)l * SB * LSP * 128; }
        else if (grp < 12) { kind = 1; fP = out + O_PAV + (size_t)l * MP * 128; fS = out + O_SAV + (size_t)l * MS * 128; fstride = 128; coff = (grp - 10) * 64; }
        else if (grp < 28) { kind = 0; bb = (bf16_t*)(ws + WS_IQ); bstride = 1024; coff = (grp - 12) * 64; do_rope = true; }
        else if (grp < 29) { kind = 1; fP = out + O_PIK + (size_t)l * MP * 64; fS = out + O_SIK + (size_t)l * MS * 64; fstride = 64; coff = 0; do_norm = true; do_rope = true; gain = gt + 128;
            side = 1; sstride = 64; sP = (bf16_t*)(ws + WS_IKBP); sS = (bf16_t*)(ws + WS_IKBS) + (size_t)l * SB * LSP * 64; }
        else if (grp < 37) { kind = 0; bb = (bf16_t*)(ws + WS_BQ); bstride = 512; coff = (grp - 29) * 64; do_norm = true; gain = gt + 192; }
        else if (grp < 45) { kind = 1; fP = out + O_PBK + (size_t)l * MP * 512; fS = out + O_SBK + (size_t)l * MS * 512; fstride = 512; coff = (grp - 37) * 64; do_norm = true; gain = gt + 256; }
        else if (grp < 53) { kind = 1; fP = out + O_PBV + (size_t)l * MP * 512; fS = out + O_SBV + (size_t)l * MS * 512; fstride = 512; coff = (grp - 45) * 64; }
        else if (grp < 69) { kind = 0; bb = (bf16_t*)(ws + WS_CZ); bstride = 1024; coff = (grp - 53) * 64; }
        else if (grp < 101) { kind = 0; bb = (bf16_t*)(ws + WS_CX); bstride = 2048; coff = (grp - 69) * 64; conv_tail = true; }
        else { kind = 2; }
        const int d0 = 8 * fq;
        float rsv[8];
#pragma unroll
        for (int q = 0; q < 8; ++q) rsv[q] = rss[u.pm * 256 + (q >> 2) * 128 + wr * 64 + (q & 3) * 16 + fr];
#pragma unroll
        for (int ai = 0; ai < 2; ++ai)
#pragma unroll
            for (int m = 0; m < 4; ++m) {
                const int r = u.pm * 256 + ai * 128 + wr * 64 + m * 16 + fr;
                const RowInfo ri = row_info(r);
                const float rs = FAST_RSQ(rsv[ai * 4 + m] * (1.0f / D) + EPSN);
                float v[2][8];
#pragma unroll
                for (int bj = 0; bj < 2; ++bj)
#pragma unroll
                    for (int n = 0; n < 2; ++n)
#pragma unroll
                        for (int e = 0; e < 4; ++e) v[bj][4 * n + e] = acc[ai][bj][m][n][e] * rs;
                if (do_norm) {
                    float ss = 0.f;
#pragma unroll
                    for (int bj = 0; bj < 2; ++bj)
#pragma unroll
                        for (int i = 0; i < 8; ++i) ss += v[bj][i] * v[bj][i];
                    ss += __shfl_xor(ss, 16); ss += __shfl_xor(ss, 32);
                    const float rn = FAST_RSQ(ss * (1.0f / 64.0f) + EPSN);
#pragma unroll
                    for (int bj = 0; bj < 2; ++bj) { const f32x4 g0 = *(const f32x4*)(gain + 32 * bj + d0), g1 = *(const f32x4*)(gain + 32 * bj + d0 + 4);
#pragma unroll
                        for (int e = 0; e < 4; ++e) { v[bj][e] = v[bj][e] * rn * g0[e]; v[bj][4 + e] = v[bj][4 + e] * rn * g1[e]; } }
                }
                if (do_rope) {
                    const float* rp = rope + (size_t)ri.pos * 16;
                    const f32x4 c0 = *(const f32x4*)rp, c1 = *(const f32x4*)(rp + 4), s0 = *(const f32x4*)(rp + 8), s1 = *(const f32x4*)(rp + 12);
                    const float sgn = (fq == 0) ? -1.f : 1.f;
#pragma unroll
                    for (int i = 0; i < 8; ++i) {
                        const float pv = __shfl_xor(v[0][i], 16);
                        const float c = (i < 4) ? c0[i & 3] : c1[i & 3], sn = (i < 4) ? s0[i & 3] : s1[i & 3];
                        if (fq < 2) v[0][i] = v[0][i] * c + sgn * pv * sn;
                    }
                }
                if (kind == 0) {
                    if (qscale) {
#pragma unroll
                        for (int bj = 0; bj < 2; ++bj)
#pragma unroll
                            for (int i = 0; i < 8; ++i) v[bj][i] *= 0.18033688011112042f; }
                    bf16_t* o = bb + (size_t)r * bstride + coff + d0; st_bf16x8(o, v[0]); st_bf16x8(o + 32, v[1]);
                    if (conv_tail) { const int Tg = ri.prompt ? T : ST;
                        if (ri.t >= Tg - 3) { float* of = (ri.prompt ? out + O_PCONV + ((size_t)(l * NB + ri.b) * 3 + (ri.t - (Tg - 3))) * 2048 : out + O_SCONV + ((size_t)(l * SB + ri.b) * 3 + (ri.t - (Tg - 3))) * 2048) + coff + d0;
                            st_f32x8(of, v[0]); st_f32x8(of + 32, v[1]); } }
                } else if (kind == 1) {
                    float* o = (ri.prompt ? fP : fS) + (size_t)ri.rg * fstride + coff + d0; st_f32x8(o, v[0]); st_f32x8(o + 32, v[1]);
                    if (side == 1) { bf16_t* o2 = (ri.prompt ? sP + (size_t)r * sstride : sS + ((size_t)ri.b * LSP + PAST + ri.t) * sstride) + coff + d0; st_bf16x8(o2, v[0]); st_bf16x8(o2 + 32, v[1]); }
                } else {
                    float w[8];
                    if (fq < 2) {
#pragma unroll
                        for (int i = 0; i < 8; ++i) w[i] = v[0][i] * 0.25f;
                        st_f32x8((float*)(ws + WS_IW) + (size_t)r * 16 + d0, w); }
                    else {
#pragma unroll
                        for (int i = 0; i < 8; ++i) w[i] = softplus_f(v[0][i] + gt[320 + (d0 - 16) + i]);
                        st_f32x8((float*)(ws + WS_DT) + (size_t)r * 16 + (d0 - 16), w); }
                }
                if (m & 1) EPI_FENCE();
            }
    }
};
struct EpiOut {
    static constexpr bool PERM = true, AFTER_DRAIN = false;
    float* X; unsigned char* ws; int l;
    __device__ __forceinline__ void operator()(const f32x4 (&acc)[2][2][4][2], const pg8::Unit& u, int wr, int wc, int fr, int fq) const {
        bf16_t* XB = (bf16_t*)(ws + WS_XB); float* rss = (float*)(ws + CTL_RSS) + (size_t)(2 * l + 1) * M;
        const float* const* PT = (const float* const*)(ws + WS_PT); const float* xp = GPT(IN_XP);
#pragma unroll
        for (int ai = 0; ai < 2; ++ai)
#pragma unroll
            for (int m = 0; m < 4; ++m) {
                const int r = u.pm * 256 + ai * 128 + wr * 64 + m * 16 + fr;
                const float* xr = (l == 0) ? xp + (size_t)r * D : X + (size_t)r * D;
                float ss = 0.f;
#pragma unroll
                for (int bj = 0; bj < 2; ++bj) {
                    const int c = u.pn * 256 + bj * 128 + wc * 32 + 8 * fq; float v[8];
                    const f32x4 a0 = *(const f32x4*)(xr + c), a1 = *(const f32x4*)(xr + c + 4);
#pragma unroll
                    for (int e = 0; e < 4; ++e) { v[e] = a0[e] + acc[ai][bj][m][0][e]; v[4 + e] = a1[e] + acc[ai][bj][m][1][e]; }
#pragma unroll
                    for (int i = 0; i < 8; ++i) ss += v[i] * v[i];
                    st_f32x8(X + (size_t)r * D + c, v); st_bf16x8(XB + (size_t)r * D + c, v);
                }
                ss += __shfl_xor(ss, 16); ss += __shfl_xor(ss, 32);
                if (fq == 0) atomicAdd(rss + r, ss);
                if (m & 1) EPI_FENCE();
            }
    }
};
struct EpiGU {
    static constexpr bool PERM = true, AFTER_DRAIN = false;
    unsigned char* ws; int l;
    __device__ __forceinline__ void operator()(const f32x4 (&acc)[2][2][4][2], const pg8::Unit& u, int wr, int wc, int fr, int fq) const {
        const float* rss = (const float*)(ws + CTL_RSS) + (size_t)(2 * l + 1) * M; bf16_t* H = (bf16_t*)(ws + WS_HMID);
        float rsv[8];
#pragma unroll
        for (int q = 0; q < 8; ++q) rsv[q] = rss[u.pm * 256 + (q >> 2) * 128 + wr * 64 + (q & 3) * 16 + fr];
#pragma unroll
        for (int ai = 0; ai < 2; ++ai)
#pragma unroll
            for (int m = 0; m < 4; ++m) {
                const int r = u.pm * 256 + ai * 128 + wr * 64 + m * 16 + fr;
                const float rs = FAST_RSQ(rsv[ai * 4 + m] * (1.0f / D) + EPSN);
                float v[8];
#pragma unroll
                for (int n = 0; n < 2; ++n)
#pragma unroll
                    for (int e = 0; e < 4; ++e) { const float g = acc[ai][0][m][n][e] * rs, up = acc[ai][1][m][n][e] * rs; v[4 * n + e] = silu_f(g) * up; }
                st_bf16x8(H + (size_t)r * DFF + u.pn * 128 + wc * 32 + 8 * fq, v);
                EPI_FENCE();
            }
    }
};
struct EpiDown {
    static constexpr bool PERM = true, AFTER_DRAIN = false;
    float* X; unsigned char* ws; int l;
    __device__ __forceinline__ void operator()(const f32x4 (&acc)[2][2][4][2], const pg8::Unit& u, int wr, int wc, int fr, int fq) const {
        bf16_t* XB = (bf16_t*)(ws + WS_XB); float* rss = (float*)(ws + CTL_RSS) + (size_t)(2 * l + 2) * M; const bool next = l + 1 < NL;
#pragma unroll
        for (int ai = 0; ai < 2; ++ai)
#pragma unroll
            for (int m = 0; m < 4; ++m) {
                const int r = u.pm * 256 + ai * 128 + wr * 64 + m * 16 + fr;
                float ss = 0.f;
#pragma unroll
                for (int bj = 0; bj < 2; ++bj) {
                    const int c = u.pn * 256 + bj * 128 + wc * 32 + 8 * fq; float v[8];
                    const f32x4 a0 = *(const f32x4*)(X + (size_t)r * D + c), a1 = *(const f32x4*)(X + (size_t)r * D + c + 4);
#pragma unroll
                    for (int e = 0; e < 4; ++e) { v[e] = a0[e] + acc[ai][bj][m][0][e]; v[4 + e] = a1[e] + acc[ai][bj][m][1][e]; }
#pragma unroll
                    for (int i = 0; i < 8; ++i) ss += v[i] * v[i];
                    st_f32x8(X + (size_t)r * D + c, v);
                    if (next) st_bf16x8(XB + (size_t)r * D + c, v);
                }
                if (next) { ss += __shfl_xor(ss, 16); ss += __shfl_xor(ss, 32); if (fq == 0) atomicAdd(rss + r, ss); }
                if (m & 1) EPI_FENCE();
            }
    }
};

struct EpiTail {
    static constexpr bool PERM = true, AFTER_DRAIN = false;
    float* P; int klen_bytes;
    __device__ __forceinline__ void operator()(const f32x4 (&acc)[2][2][4][2], const pg8::Unit& u, int wr, int wc, int fr, int fq) const {
        float* slab = P + (size_t)(u.kofs / klen_bytes) * MS * D;
#pragma unroll
        for (int ai = 0; ai < 2; ++ai)
#pragma unroll
            for (int m = 0; m < 4; ++m) {
                const int r = u.pm * 256 + ai * 128 + wr * 64 + m * 16 + fr - MP;
#pragma unroll
                for (int bj = 0; bj < 2; ++bj) { float* xo = slab + (size_t)r * D + u.pn * 256 + bj * 128 + wc * 32 + 8 * fq; *(f32x4*)xo = acc[ai][bj][m][0]; *(f32x4*)(xo + 4) = acc[ai][bj][m][1]; }
                EPI_FENCE();
            }
    }
};
__device__ __forceinline__ void phase_fin(const Frame& F, int idx, int nsl, bool next) {
    PHASE_BASES();
    float* X = outp + O_Y; bf16_t* XB = WSP(bf16_t, WS_XB); float* RSS = WSP(float, CTL_RSS) + (size_t)idx * M; const float* P = WSP(float, WS_PART);
    for (int row = MP + F.gw; row < M; row += F.NGW) {
        float ss = 0.f;
#pragma unroll
        for (int j = 0; j < 8; ++j) { const size_t o = (size_t)row * D + 4 * lane + 256 * j; f32x4 v = *(const f32x4*)(X + o);
            for (int sl = 0; sl < nsl; ++sl) v += *(const f32x4*)(P + ((size_t)sl * MS + (row - MP)) * D + 4 * lane + 256 * j);
            *(f32x4*)(X + o) = v; ss += (v.x * v.x + v.y * v.y) + (v.z * v.z + v.w * v.w);
            if (next) { u32x2 w; w.x = pk2(v.x, v.y); w.y = pk2(v.z, v.w); *(u32x2*)(XB + o) = w; } }
        ss = wave_sum(ss);
        if (next && lane == 0) RSS[row] = ss;
    }
}

constexpr int CC_NAV = SB * (PAST / 64) * 2 / 8, CC_NAK = SB * PAST * 16 / 4096, CC_N = CC_NAV + CC_NAK;
static_assert((SB * (PAST / 64) * 2) % 8 == 0 && (SB * PAST * 16) % 4096 == 0, "cache conversion items");
__device__ __forceinline__ void cache_conv_item(const Frame& F, int l, int ci, unsigned char* ws, const float* cak, const float* cav, int tidl, int lane) {
    if (ci < CC_NAV) {
        bf16_t* AVTS = WSP(bf16_t, WS_AVTS); LAS bf16_t* tile = (LAS bf16_t*)(F.lds + F.wave * 16384);
        const int it = l * (SB * (PAST / 64) * 2) + ci * 8 + F.wave;
        const int tc = it & 1, tr = (it >> 1) % (PAST / 64), lb = (it >> 1) / (PAST / 64); const int g8 = lane & 7;
#pragma unroll 2
        for (int ps = 0; ps < 8; ++ps) { const int rl = ps * 8 + (lane >> 3); const float* sp = cav + ((size_t)lb * PAST + tr * 64 + rl) * 128 + tc * 64 + 8 * g8;
            const f32x4 a = *(const f32x4*)sp, b4 = *(const f32x4*)(sp + 4); u32x4 w; w.x = pk2(a.x, a.y); w.y = pk2(a.z, a.w); w.z = pk2(b4.x, b4.y); w.w = pk2(b4.z, b4.w);
            *(LAS u32x4*)(tile + rl * 72 + 8 * g8) = w; }
        WAVE_SYNC();
#pragma unroll 2
        for (int rg = 0; rg < 8; ++rg) { unsigned short h[8];
#pragma unroll
            for (int k = 0; k < 8; ++k) h[k] = tile[(8 * rg + k) * 72 + lane];
            u32x4 w; w.x = h[0] | ((unsigned)h[1] << 16); w.y = h[2] | ((unsigned)h[3] << 16); w.z = h[4] | ((unsigned)h[5] << 16); w.w = h[6] | ((unsigned)h[7] << 16);
            *(u32x4*)(AVTS + ((size_t)lb * 128 + tc * 64 + lane) * LSP + tr * 64 + 8 * rg) = w; }
        WAVE_SYNC();
    } else {
        bf16_t* AKBS = WSP(bf16_t, WS_AKBS); const size_t base = (size_t)l * SB * PAST * 16 + (size_t)(ci - CC_NAV) * 4096 + tidl;
#pragma unroll 4
        for (int k = 0; k < 8; ++k) { const size_t i = base + (size_t)k * 512; const size_t rowi = i >> 4; const int c8 = (int)(i & 15) * 8; const size_t lb = rowi / PAST; const int sidx = (int)(rowi - lb * PAST);
            const f32x4 a = *(const f32x4*)(cak + rowi * 128 + c8), b4 = *(const f32x4*)(cak + rowi * 128 + c8 + 4);
            u32x4 w; w.x = pk2(a.x, a.y); w.y = pk2(a.z, a.w); w.z = pk2(b4.x, b4.y); w.w = pk2(b4.z, b4.w); *(u32x4*)(AKBS + (lb * LSP + sidx) * 128 + c8) = w; }
    }
}
__device__ __forceinline__ void phase_a1(const Frame& F, int l, int qs = 0) {
    PHASE_BASES();
    const bf16_t* IQ = WSP(bf16_t, WS_IQ); const float* IW = WSP(float, WS_IW); unsigned* MASK = WSP(unsigned, WS_MASK);
    unsigned* qhead = (unsigned*)(ws + CTL_QUEUE) + (l * 8 + 0 + qs) * 64;
    volatile LAS int* qslot = (volatile LAS int*)(F.lds + MISC_OFF + 64);
    LAS float* iwt = (LAS float*)(F.lds + A1_TILE_OFF);
    LAS unsigned* cand_list = (LAS unsigned*)(F.lds + A1_TILE_OFF + 1024) + F.wave * 64;
    const int r32 = lane & 31, hh = lane >> 5, wave = F.wave;
    constexpr int NUS = MS / 8, NUP = MP / 8, NUNITS = NUS + NUP;
    unsigned* chead = (unsigned*)(ws + CTL_QUEUE) + (l * 8 + 6) * 64;
    const float* cc_ak = GPT(IN_CAK); const float* cc_av = GPT(IN_CAV);
    bool cc_left = (qs == 0), a1_left = true; int iter = (int)blockIdx.x;
    for (;;) {
        __syncthreads();
        if (tidl == 0) { qslot[0] = a1_left ? (int)atomicAdd(qhead, 1u) : NUNITS; const bool t = cc_left && (!a1_left || (iter & 1) == 0); qslot[1] = t ? (int)atomicAdd(chead, 1u) : -1; }
        __syncthreads();
        const int u = qslot[0], ci = qslot[1]; ++iter;
        if (ci >= CC_N) cc_left = false;
        a1_left = u < NUNITS;
        if (ci >= 0 && ci < CC_N) { cache_conv_item(F, l, ci, ws, cc_ak, cc_av, tidl, lane); __syncthreads(); }
        if (!a1_left) { if (!cc_left) break; continue; }
        bool prompt; int b, row0, L, Ktop;
        if (u < NUS) { prompt = false; b = (u * 8) / ST; row0 = MP + u * 8; L = LS; Ktop = KTOP_S; }
        else { const int k = u - NUS, c = NC - 1 - k / (NB * 8), j = k % (NB * 8); prompt = true; b = j >> 3; row0 = b * T + 64 * c + 8 * (j & 7); L = 64 * (c + 1); Ktop = KTOP_P; }
        const int nb32 = (L + 31) / 32;
        if (tidl < 128) iwt[tidl] = IW[(size_t)row0 * 16 + tidl] * 0.125f;
        bf16x8 af[4][4];
#pragma unroll
        for (int rb = 0; rb < 4; ++rb) { const bf16_t* ap = IQ + (size_t)(row0 + 2 * rb + ((r32 >> 2) & 1)) * 1024 + ((r32 & 3) + 4 * (r32 >> 3)) * 64 + 8 * hh;
#pragma unroll
            for (int ks = 0; ks < 4; ++ks) af[rb][ks] = *(const bf16x8*)(ap + 16 * ks); }
        __syncthreads();
        const bf16_t* ikb = (prompt ? WSP(bf16_t, WS_IKBP) + (size_t)b * T * 64 : WSP(bf16_t, WS_IKBS) + ((size_t)l * SB + b) * LSP * 64) + (size_t)r32 * 64 + 8 * hh;
        bf16x8 ring[4][4];
#define A1_LOAD_B(dst, kb_) do { const bf16_t* kp_ = ikb + (size_t)(kb_) * 32 * 64; _Pragma("unroll") for (int ks_ = 0; ks_ < 4; ++ks_) dst[ks_] = *(const bf16x8*)(kp_ + 16 * ks_); } while (0)
#pragma unroll
        for (int j = 0; j < 4; ++j) { const int kl = wave + 8 * j; A1_LOAD_B(ring[j], kl < nb32 ? kl : nb32 - 1); }
#pragma unroll 1
        for (int kb0 = wave; kb0 < nb32; kb0 += 32) {
#pragma unroll
            for (int j = 0; j < 4; ++j) {
                const int kb = kb0 + 8 * j;
                if (kb < nb32) {
                    const int s = 32 * kb + r32; const bool kvalid = s < L;
#pragma unroll
                    for (int rb = 0; rb < 4; ++rb) {
                        f32x16 acc;
#pragma unroll
                        for (int i = 0; i < 16; ++i) acc[i] = 0.f;
#pragma unroll
                        for (int ks = 0; ks < 4; ++ks) acc = MFMA32(af[rb][ks], ring[j][ks], acc);
                        float score = 0.f;
#pragma unroll
                        for (int q = 0; q < 4; ++q) { const f32x4 w4 = *(const LAS f32x4*)(iwt + (2 * rb + hh) * 16 + 4 * q);
                            score += w4.x * fmaxf(acc[4 * q], 0.f) + w4.y * fmaxf(acc[4 * q + 1], 0.f) + w4.z * fmaxf(acc[4 * q + 2], 0.f) + w4.w * fmaxf(acc[4 * q + 3], 0.f); }
                        *(LAS unsigned*)(F.lds + (2 * rb + hh) * A1_WAVE_BYTES + (size_t)s * 4) = kvalid ? sortable_key(score) : 0u;
                    }
                }
                { const int kl = kb + 32; A1_LOAD_B(ring[j], kl < nb32 ? kl : nb32 - 1); }
            }
        }
        __syncthreads();
        const LAS unsigned* sc = (const LAS unsigned*)(F.lds + wave * A1_WAVE_BYTES);
        const int nt = (nb32 + 1) / 2, row = row0 + wave;
        if (2 * nt > nb32 && lane >= 32) ((LAS unsigned*)sc)[32 * nb32 + (lane - 32)] = 0u;
        WAVE_SYNC();
        const int n4 = nt / 4, nrem = nt - 4 * n4;
        constexpr int G4MAX = LPAD / 256;
        u32x4 kq[G4MAX]; unsigned kr_[3];
#pragma unroll
        for (int g = 0; g < G4MAX; ++g) kq[g] = (g < n4) ? *(const LAS u32x4*)(sc + 256 * g + 4 * lane) : (u32x4){0u, 0u, 0u, 0u};
#pragma unroll
        for (int r = 0; r < 3; ++r) kr_[r] = (r < nrem) ? sc[256 * n4 + 64 * r + lane] : 0u;
        unsigned tau = 1u;
        if (L > Ktop) {
            tau = 0u; int c_lo = 64 * nt, c_hi = 0, bit = 31; bool found = false;
            while (bit >= 0 && c_lo - c_hi > 64) {
                const unsigned cand = tau | (1u << bit); int cnt = 0;
#pragma unroll
                for (int g = 0; g < G4MAX; ++g) if (g < n4) cnt += __popcll(__ballot(kq[g].x >= cand)) + __popcll(__ballot(kq[g].y >= cand)) + __popcll(__ballot(kq[g].z >= cand)) + __popcll(__ballot(kq[g].w >= cand));
#pragma unroll
                for (int r = 0; r < 3; ++r) if (r < nrem) cnt += __popcll(__ballot(kr_[r] >= cand));
                if (cnt >= Ktop) { tau = cand; c_lo = cnt; } else c_hi = cnt;
                --bit;
                if (cnt == Ktop) { found = true; break; }
            }
            if (!found && bit >= 0) {
                const bool whole = (bit == 31); const unsigned hi_excl = whole ? 0u : tau + (2u << bit);
                int nb = 0;
#define A1_COMPACT(kval) do { const unsigned k_ = (kval); const bool in_ = (k_ >= tau) && (whole || k_ < hi_excl); const unsigned long long bal_ = __ballot(in_); \
                    if (in_) cand_list[nb + __popcll(bal_ & ((1ull << lane) - 1ull))] = k_; nb += __popcll(bal_); } while (0)
#pragma unroll
                for (int g = 0; g < G4MAX; ++g) if (g < n4) { A1_COMPACT(kq[g].x); A1_COMPACT(kq[g].y); A1_COMPACT(kq[g].z); A1_COMPACT(kq[g].w); }
#pragma unroll
                for (int r = 0; r < 3; ++r) if (r < nrem) A1_COMPACT(kr_[r]);
                WAVE_SYNC();
                const unsigned mine = (lane < nb) ? cand_list[lane] : 0u;
                for (; bit >= 0; --bit) {
                    const unsigned cand = tau | (1u << bit);
                    const int cnt = c_hi + __popcll(__ballot((lane < nb) && mine >= cand));
                    if (cnt >= Ktop) tau = cand;
                    if (cnt == Ktop) break;
                }
            }
            if (tau == 0u) tau = 1u;
        }
        unsigned* mrow = MASK + (size_t)row * MASK_W;
#pragma unroll
        for (int g = 0; g < G4MAX; ++g) if (g < n4) {
            unsigned nib = ((kq[g].x >= tau && kq[g].x != 0u) ? 1u : 0u) | ((kq[g].y >= tau && kq[g].y != 0u) ? 2u : 0u) | ((kq[g].z >= tau && kq[g].z != 0u) ? 4u : 0u) | ((kq[g].w >= tau && kq[g].w != 0u) ? 8u : 0u);
            unsigned wv = nib << (4 * (lane & 7));
            wv |= __shfl_xor(wv, 1); wv |= __shfl_xor(wv, 2); wv |= __shfl_xor(wv, 4);
            if ((lane & 7) == 0) mrow[8 * g + (lane >> 3)] = wv;
        }
#pragma unroll
        for (int r = 0; r < 3; ++r) if (r < nrem) {
            const unsigned long long bal = __ballot(kr_[r] >= tau && kr_[r] != 0u);
            if (lane == 0) { mrow[8 * n4 + 2 * r] = (unsigned)bal; mrow[8 * n4 + 2 * r + 1] = (unsigned)(bal >> 32); }
        }
    }
}
constexpr int A2_KP = 272, A2_VP = 136, A2_KT = 64 * A2_KP, A2_VT = 128 * A2_VP, A2_BUF = A2_KT + A2_VT;
static_assert(2 * A2_BUF <= LDS_PHASE_BYTES, "A2 LDS");
__device__ __forceinline__ void phase_a2(const Frame& F, int l, int qs = 0) {
    PHASE_BASES();
    const bf16_t* AQ = WSP(bf16_t, WS_AQ); const unsigned* MASK = WSP(unsigned, WS_MASK); bf16_t* MIX = WSP(bf16_t, WS_MIX);
    const float* kp_p = outp + O_PAK; const float* kp_s = outp + O_SAK; const float* kp_c = GPT(IN_CAK);
    const float* vp_p = outp + O_PAV; const float* vp_s = outp + O_SAV; const float* vp_c = GPT(IN_CAV);
    unsigned* qbase = (unsigned*)(ws + CTL_QUEUE2) + (size_t)(l * 8) * 64; (void)qs;
    volatile LAS int* qslot = (volatile LAS int*)(F.lds + MISC_OFF + 96);
    const int r32 = lane & 31, hh = lane >> 5, wave = F.wave, kvh = wave >> 2, qsub = wave & 3, qq = r32 & 15;
    constexpr int NUS = SB, NUP = NB * NC, NUNITS = NUS + NUP; (void)NUNITS; (void)NUP;
#ifdef HOST_EMU
    const int home = (int)(blockIdx.x % NB);
#else
    const int home = (int)(xb_xcc_id() % (unsigned)NB);
#endif
    int qstage = 0;
    const int kkey = tidl >> 3, kd = 16 * (tidl & 7), vkp = 2 * (tidl & 31), vd = 8 * (tidl >> 5);
    for (;;) {
        __syncthreads();
        if (tidl == 0) {
            int uu = -1;
            while (qstage <= NB) {
                const int qi = qstage == 0 ? NB : (home + qstage - 1) % NB;
                const int v = (int)atomicAdd(qbase + qi * 64, 1u);
                if (v < (qstage == 0 ? NUS : NC)) { uu = qstage == 0 ? v : NUS + v * NB + qi; break; }
                ++qstage;
            }
            qslot[0] = uu;
        }
        __syncthreads();
        const int u = qslot[0];
        if (u < 0) break;
        bool prompt; int b, row0, L, nq;
        if (u < NUS) { prompt = false; b = u; row0 = MP + u * ST; L = LS; nq = ST; }
        else { const int k = u - NUS, c = NC - 1 - k / NB; prompt = true; b = k % NB; row0 = b * T + 64 * c; L = 64 * (c + 1); nq = 64; }
        const int nt = (L + 63) / 64; const bool active = 16 * qsub < nq;
        const int qrow = row0 + (active ? 16 * qsub + qq : 0);
        bf16x8 qf[2][4];
#pragma unroll
        for (int cb = 0; cb < 2; ++cb)
#pragma unroll
            for (int ks = 0; ks < 4; ++ks) qf[cb][ks] = *(const bf16x8*)(AQ + (size_t)qrow * 512 + (kvh * 4 + 2 * cb + (r32 >> 4)) * 64 + 16 * ks + 8 * hh);
        f32x16 o[2][2]; float mrun[2] = {-1.0e30f, -1.0e30f}, lrun[2] = {0.f, 0.f};
#pragma unroll
        for (int db = 0; db < 2; ++db)
#pragma unroll
            for (int cb = 0; cb < 2; ++cb)
#pragma unroll
                for (int i = 0; i < 16; ++i) o[db][cb][i] = 0.f;
        const bf16_t* akb_base = prompt ? WSP(bf16_t, WS_AKBP) + (size_t)b * T * 128 : WSP(bf16_t, WS_AKBS) + ((size_t)l * SB + b) * LSP * 128;
        const bf16_t* avt_base = prompt ? WSP(bf16_t, WS_AVTP) + (size_t)b * 128 * T : WSP(bf16_t, WS_AVTS) + ((size_t)l * SB + b) * 128 * LSP; const size_t avt_pitch = prompt ? (size_t)T : (size_t)LSP;
        u32x4 kA[2], vA[2], kB[2], vB[2];
#define A2_LOAD_TT(K_, V_, t_) do { const bf16_t* kp_ = akb_base + (size_t)(64 * (t_) + kkey) * 128 + kd; K_[0] = *(const u32x4*)kp_; K_[1] = *(const u32x4*)(kp_ + 8); \
            const bf16_t* vp_ = avt_base + (size_t)(tidl >> 2) * avt_pitch + 64 * (t_) + 16 * (tidl & 3); V_[0] = *(const u32x4*)vp_; V_[1] = *(const u32x4*)(vp_ + 8); } while (0)
#define A2_STORE_TT(K_, V_, buf_) do { LAS unsigned char* kb_ = F.lds + (buf_) * A2_BUF + kkey * A2_KP + kd * 2; *(LAS u32x4*)kb_ = K_[0]; *(LAS u32x4*)(kb_ + 16) = K_[1]; \
            LAS unsigned char* vb_ = F.lds + (buf_) * A2_BUF + A2_KT + (tidl >> 2) * A2_VP + 32 * (tidl & 3); \
            *(LAS u32x2*)(vb_) = (u32x2){V_[0].x, V_[0].y}; *(LAS u32x2*)(vb_ + 8) = (u32x2){V_[0].z, V_[0].w}; *(LAS u32x2*)(vb_ + 16) = (u32x2){V_[1].x, V_[1].y}; *(LAS u32x2*)(vb_ + 24) = (u32x2){V_[1].z, V_[1].w}; } while (0)
#define A2_COMPUTE(BUF_) do { \
            if (active) { \
                const LAS unsigned char* kt = F.lds + (BUF_) * A2_BUF; const LAS unsigned char* vt = kt + A2_KT; \
                _Pragma("unroll") \
                for (int kblk = 0; kblk < 2; ++kblk) { \
                    f32x16 sacc[2]; \
                _Pragma("unroll") \
                    for (int cb = 0; cb < 2; ++cb) \
                _Pragma("unroll") \
                        for (int i = 0; i < 16; ++i) sacc[cb][i] = 0.f; \
                _Pragma("unroll") \
                    for (int ks = 0; ks < 4; ++ks) { const bf16x8 kf = *(const LAS bf16x8*)(kt + (32 * kblk + r32) * A2_KP + (kvh * 64 + 16 * ks + 8 * hh) * 2); \
                        sacc[0] = MFMA32(kf, qf[0][ks], sacc[0]); sacc[1] = MFMA32(kf, qf[1][ks], sacc[1]); } \
                    const unsigned mw = kblk ? mcur1 : mcur0; \
                    bf16x8 pf[2][2]; \
                _Pragma("unroll") \
                    for (int cb = 0; cb < 2; ++cb) { \
                        float sv[16]; float bm = -1.0e30f; const unsigned mwh = mw >> (4 * hh); \
                _Pragma("unroll") \
                        for (int i = 0; i < 16; ++i) { const bool on = (mwh & (1u << ((i & 3) + 8 * (i >> 2)))) != 0u; sv[i] = on ? sacc[cb][i] : -1.0e30f; bm = fmaxf(bm, sv[i]); } \
                        bm = fmaxf(bm, __shfl_xor(bm, 32)); \
                        const float mnew = fmaxf(mrun[cb], bm); \
                        float ps = 0.f; float pv[16]; \
                _Pragma("unroll") \
                        for (int i = 0; i < 16; ++i) { pv[i] = FAST_EXP2(sv[i] - mnew); ps += pv[i]; } \
                        if (mnew < -1.0e29f) { \
                _Pragma("unroll") \
                            for (int i = 0; i < 16; ++i) pv[i] = 0.f; \
                            ps = 0.f; } \
                        ps += __shfl_xor(ps, 32); \
                        if (!__all(mnew == mrun[cb])) { \
                            const float alpha = FAST_EXP2(mrun[cb] - mnew); \
                            lrun[cb] *= alpha; \
                _Pragma("unroll") \
                            for (int db = 0; db < 2; ++db) \
                _Pragma("unroll") \
                                for (int i = 0; i < 16; ++i) o[db][cb][i] *= alpha; \
                        } \
                        lrun[cb] += ps; mrun[cb] = mnew; \
                _Pragma("unroll") \
                        for (int ks2 = 0; ks2 < 2; ++ks2) { float t8[8]; \
                _Pragma("unroll") \
                            for (int j = 0; j < 8; ++j) t8[j] = pv[8 * ks2 + j]; \
                            pf[cb][ks2] = pack_bf16x8(t8); } \
                    } \
                _Pragma("unroll") \
                    for (int db = 0; db < 2; ++db) \
                _Pragma("unroll") \
                        for (int ks2 = 0; ks2 < 2; ++ks2) { \
                            const LAS unsigned char* vp = vt + (kvh * 64 + 32 * db + r32) * A2_VP + (32 * kblk + 16 * ks2 + 4 * hh) * 2; \
                            const u32x2 v0 = *(const LAS u32x2*)vp, v1 = *(const LAS u32x2*)(vp + 16); \
                            const bf16x8 vf = __builtin_bit_cast(bf16x8, ((u32x4){v0.x, v0.y, v1.x, v1.y})); \
                            o[db][0] = MFMA32(vf, pf[0][ks2], o[db][0]); o[db][1] = MFMA32(vf, pf[1][ks2], o[db][1]); \
                        } \
                } \
            } \
            } while (0)
        A2_LOAD_TT(kA, vA, 0); A2_STORE_TT(kA, vA, 0);
        A2_LOAD_TT(kB, vB, (nt > 1 ? 1 : 0));
        const unsigned* mrow = MASK + (size_t)qrow * MASK_W;
        unsigned mcur0 = mrow[0], mcur1 = mrow[1], mnx0 = 0u, mnx1 = 0u;
        __syncthreads();
#pragma unroll 1
        for (int t = 0; t < nt; t += 2) {
            A2_LOAD_TT(kA, vA, (t + 2 < nt ? t + 2 : nt - 1));
            { const int tm = (t + 1 < nt) ? t + 1 : nt - 1; mnx0 = mrow[2 * tm]; mnx1 = mrow[2 * tm + 1]; }
            A2_COMPUTE(0);
            if (t + 1 < nt) A2_STORE_TT(kB, vB, 1);
            mcur0 = mnx0; mcur1 = mnx1;
            __syncthreads();
            if (t + 1 >= nt) break;
            A2_LOAD_TT(kB, vB, (t + 3 < nt ? t + 3 : nt - 1));
            { const int tm = (t + 2 < nt) ? t + 2 : nt - 1; mnx0 = mrow[2 * tm]; mnx1 = mrow[2 * tm + 1]; }
            A2_COMPUTE(1);
            if (t + 2 < nt) A2_STORE_TT(kA, vA, 0);
            mcur0 = mnx0; mcur1 = mnx1;
            __syncthreads();
        }
        if (active) {
#pragma unroll
            for (int cb = 0; cb < 2; ++cb) { const float inv = 1.0f / lrun[cb];
#pragma unroll
                for (int db = 0; db < 2; ++db)
#pragma unroll
                    for (int g = 0; g < 4; ++g) { u32x2 w; w.x = pk2(o[db][cb][4 * g] * inv, o[db][cb][4 * g + 1] * inv); w.y = pk2(o[db][cb][4 * g + 2] * inv, o[db][cb][4 * g + 3] * inv);
                        *(u32x2*)(MIX + (size_t)qrow * 2048 + (kvh * 4 + 2 * cb + (r32 >> 4)) * 64 + 32 * db + 8 * g + 4 * hh) = w; } }
        }
    }
}
__device__ __forceinline__ void phase_b(const Frame& F, int l) {
    PHASE_BASES();
    const bf16_t* BQ = WSP(bf16_t, WS_BQ); bf16_t* MIX = WSP(bf16_t, WS_MIX);
    const float* kp_p = outp + O_PBK; const float* kp_s = outp + O_SBK; const float* kp_c = GPT(IN_CBK);
    const float* vp_p = outp + O_PBV; const float* vp_s = outp + O_SBV; const float* vp_c = GPT(IN_CBV);
    const int r32 = lane & 31, hh = lane >> 5;
    constexpr int NUP = NB * (T / 32) * 8, NUS = SB * 8;
    for (int unit = F.gw; unit < NUP + NUS; unit += F.NGW) {
        const bool prompt = unit < NUP; const int uu = prompt ? unit : unit - NUP; const int h = uu & 7; int b, row0, qbase;
        if (prompt) { const int qb = (uu >> 3) % (T / 32); b = (uu >> 3) / (T / 32); row0 = b * T + 32 * qb; qbase = 32 * qb; } else { b = uu >> 3; row0 = MP + b * ST; qbase = PAST; }
        const int nk = prompt ? T : LS;
        bf16x8 qf[4];
#pragma unroll
        for (int ks = 0; ks < 4; ++ks) qf[ks] = *(const bf16x8*)(BQ + (size_t)(row0 + r32) * 512 + h * 64 + 16 * ks + 8 * hh);
        f32x16 o[2];
#pragma unroll
        for (int db = 0; db < 2; ++db)
#pragma unroll
            for (int i = 0; i < 16; ++i) o[db][i] = 0.f;
        float R = 0.f; const int qpos = qbase + r32;
        f32x4 kraw[8];
#define B_LOAD_K(kb_) do { const int s_ = 32 * (kb_) + r32; const float* kp_ = kv_row<512>(kp_p, kp_s, kp_c, l, prompt, b, (s_ < nk) ? s_ : 0) + h * 64 + 8 * hh; \
            _Pragma("unroll") for (int ks_ = 0; ks_ < 4; ++ks_) { kraw[2 * ks_] = *(const f32x4*)(kp_ + 16 * ks_); kraw[2 * ks_ + 1] = *(const f32x4*)(kp_ + 16 * ks_ + 4); } } while (0)
        B_LOAD_K((qbase + 31) / 32);
        for (int kb = (qbase + 31) / 32; kb >= 0; --kb) {
            f32x16 sacc;
#pragma unroll
            for (int i = 0; i < 16; ++i) sacc[i] = 0.f;
            { const bool kvalid = 32 * kb + r32 < nk;
#pragma unroll
              for (int ks = 0; ks < 4; ++ks) { f32x4 k0 = kraw[2 * ks], k1 = kraw[2 * ks + 1];
                  if (!kvalid) { k0 = (f32x4){0.f, 0.f, 0.f, 0.f}; k1 = k0; }
                  float kv[8] = {k0.x, k0.y, k0.z, k0.w, k1.x, k1.y, k1.z, k1.w};
                  sacc = MFMA32(pack_bf16x8(kv), qf[ks], sacc); } }
            B_LOAD_K(kb > 0 ? kb - 1 : 0);
            float vv[2][2][8];
#pragma unroll
            for (int ks2 = 0; ks2 < 2; ++ks2)
#pragma unroll
                for (int db = 0; db < 2; ++db)
#pragma unroll
                    for (int j = 0; j < 8; ++j) { const int s = 32 * kb + 16 * ks2 + 8 * (j >> 2) + 4 * hh + (j & 3); vv[ks2][db][j] = (s < nk) ? kv_row<512>(vp_p, vp_s, vp_c, l, prompt, b, s)[h * 64 + 32 * db + r32] : 0.f; }
            float lk[16], zz[16];
#pragma unroll
            for (int i = 0; i < 16; ++i) { const int kpos = 32 * kb + (i & 3) + 8 * (i >> 2) + 4 * hh; const float z = sacc[i] * 0.125f; zz[i] = z; lk[i] = (kpos < qpos) ? -softplus_f(z) : 0.f; }
            float G[4], Go[4];
#pragma unroll
            for (int g = 0; g < 4; ++g) { G[g] = (lk[4 * g] + lk[4 * g + 1]) + (lk[4 * g + 2] + lk[4 * g + 3]); Go[g] = __shfl_xor(G[g], 32); }
            float a[16]; float tail = 0.f;
#pragma unroll
            for (int g = 3; g >= 0; --g) {
                const float tg = tail + (hh == 0 ? Go[g] : 0.f);
                const float s3 = 0.f, s2 = lk[4 * g + 3], s1 = s2 + lk[4 * g + 2], s0 = s1 + lk[4 * g + 1];
                const float sf[4] = {s0, s1, s2, s3};
#pragma unroll
                for (int e = 0; e < 4; ++e) { const int i = 4 * g + e; const int kpos = 32 * kb + e + 8 * g + 4 * hh; a[i] = (kpos < qpos) ? exp_f(zz[i] + lk[i] + R + tg + sf[e]) : 0.f; }
                tail += G[g] + Go[g];
            }
            R += tail;
#pragma unroll
            for (int ks2 = 0; ks2 < 2; ++ks2) {
                float pv[8];
#pragma unroll
                for (int j = 0; j < 8; ++j) pv[j] = a[8 * ks2 + j];
                const bf16x8 pf = pack_bf16x8(pv);
#pragma unroll
                for (int db = 0; db < 2; ++db) o[db] = MFMA32(pack_bf16x8(vv[ks2][db]), pf, o[db]);
            }
            if (__all(R < -40.f)) break;
        }
#pragma unroll
        for (int db = 0; db < 2; ++db)
#pragma unroll
            for (int g = 0; g < 4; ++g) { u32x2 w; w.x = pk2(o[db][4 * g], o[db][4 * g + 1]); w.y = pk2(o[db][4 * g + 2], o[db][4 * g + 3]);
                *(u32x2*)(MIX + (size_t)(row0 + r32) * 2048 + 512 + h * 64 + 32 * db + 8 * g + 4 * hh) = w; }
    }
}
__device__ __forceinline__ void phase_conv(const Frame& F, int l) {
    PHASE_BASES();
    const float* cw = GPT(IN_CONVW) + (size_t)l * 4 * 2048; const float* cb = GPT(IN_CONVB) + (size_t)l * 2048; const float* sconv = GPT(IN_SCONV);
    const bf16_t* CX = WSP(bf16_t, WS_CX); bf16_t* XC = WSP(bf16_t, WS_XC); bf16_t* XCT = WSP(bf16_t, WS_XCT);
    LAS bf16_t* tile = (LAS bf16_t*)(F.lds + F.wave * A1_WAVE_BYTES);
    constexpr int NTILE = (M / 64) * 32, NVT = (M / 64) * 2;
    { bf16_t* AVTP = WSP(bf16_t, WS_AVTP); bf16_t* AVTS = WSP(bf16_t, WS_AVTS) + (size_t)l * SB * 128 * LSP; const float* avp = outp + O_PAV + (size_t)l * MP * 128; const float* avs = outp + O_SAV + (size_t)l * MS * 128;
      for (int it = F.gw; it < NVT; it += F.NGW) {
          const int tc = it & 1, tr = it >> 1, rbase = tr * 64, g8 = lane & 7; const bool pr = rbase < MP;
#pragma unroll 2
          for (int ps = 0; ps < 8; ++ps) { const int rl = ps * 8 + (lane >> 3), row = rbase + rl; const float* sp = (pr ? avp + (size_t)row * 128 : avs + (size_t)(row - MP) * 128) + tc * 64 + 8 * g8;
              const f32x4 a = *(const f32x4*)sp, b4 = *(const f32x4*)(sp + 4); u32x4 w; w.x = pk2(a.x, a.y); w.y = pk2(a.z, a.w); w.z = pk2(b4.x, b4.y); w.w = pk2(b4.z, b4.w);
              *(LAS u32x4*)(tile + rl * 72 + 8 * g8) = w; }
          WAVE_SYNC();
#pragma unroll 2
          for (int rg = 0; rg < 8; ++rg) { unsigned short h[8];
#pragma unroll
              for (int k = 0; k < 8; ++k) h[k] = tile[(8 * rg + k) * 72 + lane];
              u32x4 w; w.x = h[0] | ((unsigned)h[1] << 16); w.y = h[2] | ((unsigned)h[3] << 16); w.z = h[4] | ((unsigned)h[5] << 16); w.w = h[6] | ((unsigned)h[7] << 16);
              const int row = rbase + 8 * rg;
              bf16_t* dst = pr ? AVTP + ((size_t)(row / T) * 128 + tc * 64 + lane) * T + (row % T) : AVTS + ((size_t)((row - MP) / ST) * 128 + tc * 64 + lane) * LSP + PAST + ((row - MP) % ST);
              *(u32x4*)dst = w; }
          WAVE_SYNC();
      } }
    for (int it = F.gw; it < NTILE; it += F.NGW) {
        const int tr = it >> 5, tc = it & 31, rbase = tr * 64, cbase = tc * 64;
        const int g8 = lane & 7, c0 = cbase + 8 * g8;
        float wj[4][8], bs[8];
#pragma unroll
        for (int e = 0; e < 8; ++e) bs[e] = cb[c0 + e];
#pragma unroll
        for (int j = 0; j < 4; ++j)
#pragma unroll
            for (int e = 0; e < 8; ++e) wj[j][e] = cw[j * 2048 + c0 + e];
#pragma unroll 4
        for (int ps = 0; ps < 8; ++ps) {
            const int rl = ps * 8 + (lane >> 3), row = rbase + rl; const RowInfo ri = row_info(row);
            float a[8];
#pragma unroll
            for (int e = 0; e < 8; ++e) a[e] = bs[e];
#pragma unroll
            for (int j = 0; j < 4; ++j) {
                const int tau = ri.t - 3 + j; float x[8];
                if (tau >= 0) { const u32x4 w = *(const u32x4*)(CX + (size_t)(row - ri.t + tau) * 2048 + c0);
                    x[0] = bflo(w.x); x[1] = bfhi(w.x); x[2] = bflo(w.y); x[3] = bfhi(w.y); x[4] = bflo(w.z); x[5] = bfhi(w.z); x[6] = bflo(w.w); x[7] = bfhi(w.w); }
                else if (!ri.prompt) { const float* sp = sconv + ((size_t)(l * SB + ri.b) * 3 + (3 + tau)) * 2048 + c0;
#pragma unroll
                    for (int e = 0; e < 8; ++e) x[e] = sp[e]; }
                else {
#pragma unroll
                    for (int e = 0; e < 8; ++e) x[e] = 0.f; }
#pragma unroll
                for (int e = 0; e < 8; ++e) a[e] += wj[j][e] * x[e];
            }
            float o[8];
#pragma unroll
            for (int e = 0; e < 8; ++e) o[e] = silu_f(a[e]);
            u32x4 w; w.x = pk2(o[0], o[1]); w.y = pk2(o[2], o[3]); w.z = pk2(o[4], o[5]); w.w = pk2(o[6], o[7]);
            if (tc >= 16) *(u32x4*)(XC + (size_t)row * 2048 + c0) = w;
            *(LAS u32x4*)(tile + rl * 72 + 8 * g8) = w;
        }
        WAVE_SYNC();
        if (tc < 24) {
#pragma unroll 2
        for (int rg = 0; rg < 8; ++rg) {
            unsigned short h[8];
#pragma unroll
            for (int k = 0; k < 8; ++k) h[k] = tile[(8 * rg + k) * 72 + lane];
            u32x4 w; w.x = h[0] | ((unsigned)h[1] << 16); w.y = h[2] | ((unsigned)h[3] << 16); w.z = h[4] | ((unsigned)h[5] << 16); w.w = h[6] | ((unsigned)h[7] << 16);
            *(u32x4*)(XCT + (size_t)(cbase + lane) * MPADT + rbase + 8 * rg) = w;
        }
        }
        if (tc < 24 && tr == M / 64 - 1) {
#pragma unroll 2
            for (int rg = 0; rg < 8; ++rg) *(u32x4*)(XCT + (size_t)(cbase + lane) * MPADT + M + 8 * rg) = (u32x4){0u, 0u, 0u, 0u};
        }
        WAVE_SYNC();
    }
}
struct CuInfo { int row0, Tv; bool prompt; int b; };
__device__ __forceinline__ CuInfo cu_info(int cu) { CuInfo c; c.prompt = cu < NB * NC; if (c.prompt) { c.b = cu / NC; c.row0 = c.b * T + (cu - c.b * NC) * 64; c.Tv = 64; } else { c.b = cu - NB * NC; c.row0 = MP + c.b * ST; c.Tv = ST; } return c; }
__device__ __forceinline__ void phase_c1(const Frame& F, int l) {
    PHASE_BASES();
    const float* DT = WSP(float, WS_DT); const bf16_t* XCT = WSP(bf16_t, WS_XCT); bf16_t* CS = WSP(bf16_t, WS_CS); float* CD = WSP(float, WS_CD);
    LAS float* wbuf = (LAS float*)(F.lds + F.wave * A1_WAVE_BYTES);
    const int r32 = lane & 31, hh = lane >> 5;
    for (int it = F.gw; it < NCU * 32; it += F.NGW) {
        const int pb = it & 1, h = (it >> 1) & 15, cu = it >> 5, g = h >> 2; const CuInfo ci = cu_info(cu);
        const float Aneg = -expf(GPT(IN_ALOG)[l * 16 + h]);
        const float dt = (lane < ci.Tv) ? DT[(size_t)(ci.row0 + lane) * 16 + h] : 0.f;
        u32x4 araw[4]; bf16x8 bfr[4][4];
#pragma unroll
        for (int ks = 0; ks < 4; ++ks) araw[ks] = *(const u32x4*)(XCT + (size_t)(h * 64 + 32 * pb + r32) * MPADT + ci.row0 + 16 * ks + 8 * hh);
#pragma unroll
        for (int nb = 0; nb < 4; ++nb)
#pragma unroll
            for (int ks = 0; ks < 4; ++ks) bfr[nb][ks] = *(const bf16x8*)(XCT + (size_t)(1024 + g * 128 + 32 * nb + r32) * MPADT + ci.row0 + 16 * ks + 8 * hh);
        const float acum = wave_incl_scan(dt * Aneg, lane), tot = __shfl(acum, 63);
        wbuf[lane] = dt * exp_f(tot - acum);
        if (pb == 0 && lane == 0) CD[cu * 16 + h] = exp_f(tot);
        WAVE_SYNC();
        bf16x8 af[4];
#pragma unroll
        for (int ks = 0; ks < 4; ++ks) {
            const u32x4 raw = araw[ks];
            const f32x4 w0 = *(const LAS f32x4*)(wbuf + 16 * ks + 8 * hh), w1 = *(const LAS f32x4*)(wbuf + 16 * ks + 8 * hh + 4);
            float v[8] = {bflo(raw.x) * w0[0], bfhi(raw.x) * w0[1], bflo(raw.y) * w0[2], bfhi(raw.y) * w0[3], bflo(raw.z) * w1[0], bfhi(raw.z) * w1[1], bflo(raw.w) * w1[2], bfhi(raw.w) * w1[3]};
            af[ks] = pack_bf16x8(v);
        }
        f32x16 acc[4];
#pragma unroll
        for (int nb = 0; nb < 4; ++nb) {
#pragma unroll
            for (int i = 0; i < 16; ++i) acc[nb][i] = 0.f;
#pragma unroll
            for (int ks = 0; ks < 4; ++ks) acc[nb] = MFMA32(af[ks], bfr[nb][ks], acc[nb]);
        }
        bf16_t* cs = CS + (size_t)(cu * 16 + h) * 8192;
#pragma unroll
        for (int nb = 0; nb < 4; ++nb)
#pragma unroll
            for (int i = 0; i < 16; ++i) cs[(32 * pb + (i & 3) + 8 * (i >> 2) + 4 * hh) * 128 + 32 * nb + r32] = (bf16_t)f2bf(acc[nb][i]);
        WAVE_SYNC();
    }
}
__device__ __forceinline__ void phase_c2(const Frame& F, int l) {
    PHASE_BASES();
    const bf16_t* CS = WSP(bf16_t, WS_CS); const float* CD = WSP(float, WS_CD); bf16_t* ENT = WSP(bf16_t, WS_ENT);
    constexpr int NEP = NB * 16 * 2048, NES = SB * 16 * 2048;
    for (int it = blockIdx.x * 512 + tidl; it < NEP + NES; it += F.G * 512) {
        const bool prompt = it < NEP; const int e = prompt ? it : it - NEP; const int q = e & 2047, h = (e >> 11) & 15, b = e >> 15;
        if (prompt) {
            f32x4 st = (f32x4){0.f, 0.f, 0.f, 0.f};
            constexpr int CB = (NC % 8 == 0) ? 8 : ((NC % 4 == 0) ? 4 : 1);
#pragma unroll 1
            for (int c0 = 0; c0 < NC; c0 += CB) {
                u32x2 cw[CB]; float cdv[CB];
#pragma unroll
                for (int k = 0; k < CB; ++k) { const size_t u = (size_t)((b * NC + c0 + k) * 16 + h); cw[k] = *(const u32x2*)(CS + u * 8192 + q * 4); cdv[k] = CD[u]; }
#pragma unroll
                for (int k = 0; k < CB; ++k) { const size_t u = (size_t)((b * NC + c0 + k) * 16 + h); const f32x4 cs = (f32x4){bflo(cw[k].x), bfhi(cw[k].x), bflo(cw[k].y), bfhi(cw[k].y)};
                    u32x2 w; w.x = pk2(st.x, st.y); w.y = pk2(st.z, st.w); *(u32x2*)(ENT + u * 8192 + q * 4) = w;
                    st = st * cdv[k] + cs; }
            }
            *(f32x4*)(outp + O_PSSM + (((size_t)l * NB + b) * 16 + h) * 8192 + q * 4) = st;
        } else {
            const size_t u = (size_t)((NB * NC + b) * 16 + h);
            f32x4 st = *(const f32x4*)(GPT(IN_SSM) + (((size_t)l * SB + b) * 16 + h) * 8192 + q * 4);
            u32x2 w; w.x = pk2(st.x, st.y); w.y = pk2(st.z, st.w); *(u32x2*)(ENT + u * 8192 + q * 4) = w;
            const u32x2 cw = *(const u32x2*)(CS + u * 8192 + q * 4); const f32x4 cs = (f32x4){bflo(cw.x), bfhi(cw.x), bflo(cw.y), bfhi(cw.y)};
            st = st * CD[u] + cs;
            *(f32x4*)(outp + O_SSSM + (((size_t)l * SB + b) * 16 + h) * 8192 + q * 4) = st;
        }
    }
}
__device__ __forceinline__ void phase_c3(const Frame& F, int l) {
    PHASE_BASES();
    const float* DT = WSP(float, WS_DT); const bf16_t* XC = WSP(bf16_t, WS_XC); const bf16_t* XCT = WSP(bf16_t, WS_XCT); const bf16_t* ENT = WSP(bf16_t, WS_ENT); bf16_t* YC = WSP(bf16_t, WS_YC);
    LAS float* abuf = (LAS float*)(F.lds + F.wave * A1_WAVE_BYTES);
    LAS float* dbuf = abuf + 64;
    const int r32 = lane & 31, hh = lane >> 5;
    for (int it = F.gw; it < NCU * 32; it += F.NGW) {
        const int tb = it & 1, h = (it >> 1) & 15, cu = it >> 5, g = h >> 2; const CuInfo ci = cu_info(cu);
        if (32 * tb >= ci.Tv) continue;
        const float Aneg = -expf(GPT(IN_ALOG)[l * 16 + h]), Dk = GPT(IN_CD)[l * 16 + h];
        const float dt = (lane < ci.Tv) ? DT[(size_t)(ci.row0 + lane) * 16 + h] : 0.f;
        bf16x8 cmf[8], entf[2][8];
#pragma unroll
        for (int ks = 0; ks < 8; ++ks) cmf[ks] = *(const bf16x8*)(XC + (size_t)(ci.row0 + 32 * tb + r32) * 2048 + 1536 + g * 128 + 16 * ks + 8 * hh);
#pragma unroll
        for (int pb = 0; pb < 2; ++pb)
#pragma unroll
            for (int ks = 0; ks < 8; ++ks) entf[pb][ks] = *(const bf16x8*)(ENT + ((size_t)(cu * 16 + h) * 64 + 32 * pb + r32) * 128 + 16 * ks + 8 * hh);
        const float acum = wave_incl_scan(dt * Aneg, lane);
        abuf[lane] = acum; dbuf[lane] = dt;
        const float acum_t = __shfl(acum, 32 * tb + r32);
        WAVE_SYNC();
        f32x16 y[2];
#pragma unroll
        for (int pb = 0; pb < 2; ++pb)
#pragma unroll
            for (int i = 0; i < 16; ++i) y[pb][i] = 0.f;
        for (int sb = 0; sb <= tb; ++sb) {
            f32x16 ga;
#pragma unroll
            for (int i = 0; i < 16; ++i) ga[i] = 0.f;
#pragma unroll
            for (int ks = 0; ks < 8; ++ks) { const bf16x8 bmf = *(const bf16x8*)(XC + (size_t)(ci.row0 + 32 * sb + r32) * 2048 + 1024 + g * 128 + 16 * ks + 8 * hh); ga = MFMA32(bmf, cmf[ks], ga); }
            const int tt = 32 * tb + r32;
#pragma unroll
            for (int q = 0; q < 4; ++q) {
                const f32x4 as = *(const LAS f32x4*)(abuf + 32 * sb + 8 * q + 4 * hh), ds = *(const LAS f32x4*)(dbuf + 32 * sb + 8 * q + 4 * hh);
#pragma unroll
                for (int e = 0; e < 4; ++e) { const int ss = 32 * sb + 8 * q + 4 * hh + e; ga[4 * q + e] = (ss <= tt) ? ga[4 * q + e] * exp_f(acum_t - as[e]) * ds[e] : 0.f; }
            }
#pragma unroll
            for (int ks2 = 0; ks2 < 2; ++ks2) {
                float pv[8];
#pragma unroll
                for (int j = 0; j < 8; ++j) pv[j] = ga[8 * ks2 + j];
                const bf16x8 pa = pack_bf16x8(pv);
#pragma unroll
                for (int pb = 0; pb < 2; ++pb) {
                    const bf16_t* xp = XCT + (size_t)(h * 64 + 32 * pb + r32) * MPADT + ci.row0 + 32 * sb + 16 * ks2 + 4 * hh;
                    const u32x2 x0 = *(const u32x2*)xp, x1 = *(const u32x2*)(xp + 8);
                    const u32x4 xw = (u32x4){x0.x, x0.y, x1.x, x1.y};
                    y[pb] = MFMA32(pa, __builtin_bit_cast(bf16x8, xw), y[pb]);
                }
            }
        }
        float ea[16];
#pragma unroll
        for (int q = 0; q < 4; ++q) { const f32x4 at = *(const LAS f32x4*)(abuf + 32 * tb + 8 * q + 4 * hh);
#pragma unroll
            for (int e = 0; e < 4; ++e) ea[4 * q + e] = exp_f(at[e]); }
#pragma unroll
        for (int pb = 0; pb < 2; ++pb) {
            f32x16 yo;
#pragma unroll
            for (int i = 0; i < 16; ++i) yo[i] = 0.f;
#pragma unroll
            for (int ks = 0; ks < 8; ++ks) yo = MFMA32(cmf[ks], entf[pb][ks], yo);
            const bf16_t* xp = XCT + (size_t)(h * 64 + 32 * pb + r32) * MPADT + ci.row0 + 32 * tb + 4 * hh;
#pragma unroll
            for (int q = 0; q < 4; ++q) { const u32x2 xw = *(const u32x2*)(xp + 8 * q); const float xs[4] = {bflo(xw.x), bfhi(xw.x), bflo(xw.y), bfhi(xw.y)};
#pragma unroll
                for (int e = 0; e < 4; ++e) { const int i = 4 * q + e; const float val = y[pb][i] + ea[i] * yo[i] + Dk * xs[e]; const int tl = 32 * tb + 8 * q + 4 * hh + e;
                    if (tl < ci.Tv) YC[(size_t)(ci.row0 + tl) * 1024 + h * 64 + 32 * pb + r32] = (bf16_t)f2bf(val); } }
        }
        WAVE_SYNC();
    }
}
__device__ __forceinline__ void phase_gn(const Frame& F, int l) {
    PHASE_BASES();
    const bf16_t* YC = WSP(bf16_t, WS_YC); const bf16_t* CZ = WSP(bf16_t, WS_CZ); bf16_t* MIX = WSP(bf16_t, WS_MIX); const float* cng = GPT(IN_CNG) + l * 1024;
    f32x4 ng[4];
#pragma unroll
    for (int g = 0; g < 4; ++g) ng[g] = *(const f32x4*)(cng + g * 256 + 4 * lane);
    u32x2 yw[4], zw[4], ywn[4], zwn[4];
#define GN_LOAD(Y_, Z_, row_) do { _Pragma("unroll") for (int g = 0; g < 4; ++g) { Y_[g] = *(const u32x2*)(YC + (size_t)(row_) * 1024 + g * 256 + 4 * lane); Z_[g] = *(const u32x2*)(CZ + (size_t)(row_) * 1024 + g * 256 + 4 * lane); } } while (0)
    if (F.gw < M) GN_LOAD(yw, zw, F.gw);
    for (int row = F.gw; row < M; row += F.NGW) {
        { const int rn = (row + F.NGW < M) ? row + F.NGW : row; GN_LOAD(ywn, zwn, rn); }
        float v[4][4], ss[4];
#pragma unroll
        for (int g = 0; g < 4; ++g) { v[g][0] = bflo(yw[g].x) * silu_f(bflo(zw[g].x)); v[g][1] = bfhi(yw[g].x) * silu_f(bfhi(zw[g].x)); v[g][2] = bflo(yw[g].y) * silu_f(bflo(zw[g].y)); v[g][3] = bfhi(yw[g].y) * silu_f(bfhi(zw[g].y));
            ss[g] = (v[g][0] * v[g][0] + v[g][1] * v[g][1]) + (v[g][2] * v[g][2] + v[g][3] * v[g][3]); }
#pragma unroll
        for (int o = 1; o < 64; o <<= 1) {
#pragma unroll
            for (int g = 0; g < 4; ++g) ss[g] += __shfl_xor(ss[g], o); }
#pragma unroll
        for (int g = 0; g < 4; ++g) { const float rn = FAST_RSQ(ss[g] * (1.0f / 256.0f) + EPSN);
            u32x2 o; o.x = pk2(v[g][0] * rn * ng[g].x, v[g][1] * rn * ng[g].y); o.y = pk2(v[g][2] * rn * ng[g].z, v[g][3] * rn * ng[g].w);
            *(u32x2*)(MIX + (size_t)row * 2048 + 1024 + g * 256 + 4 * lane) = o; }
#pragma unroll
        for (int g = 0; g < 4; ++g) { yw[g] = ywn[g]; zw[g] = zwn[g]; }
    }
}

#ifndef PHMASK
#define PHMASK 0xFFFFFFFFu
#endif
#ifndef PROBE_DUP
#define PROBE_DUP 0u
#endif
#define DUP(j) ((PROBE_DUP >> (j)) & 1u)
__global__ void __launch_bounds__(512, 2) mega(Args args) {
    DYN_LDS(lds);
    Frame F;
    F.lds = (LAS unsigned char*)lds;
    F.tid = threadIdx.x; F.lane = F.tid & 63;
#ifdef HOST_EMU
    F.wave = F.tid >> 6;
#else
    F.wave = __builtin_amdgcn_readfirstlane(F.tid >> 6);
#endif
    F.G = gridDim.x; F.gw = blockIdx.x * 8 + F.wave; F.NGW = F.G * 8;
    F.out = args.out; F.ws = args.ws;
#ifndef HOST_EMU
    volatile LAS unsigned* MISC = (volatile LAS unsigned*)(F.lds + MISC_OFF);
    if (F.tid < 64) MISC[F.tid] = 0u;
    __syncthreads();
    XcdBarrier bar = xcd_barrier_post((unsigned*)(args.ws + WS_CTL) + CW_BAR, MISC + 8);
#define GRID_BAR() xcd_barrier(bar)
#else
#define GRID_BAR() do { } while (0)
#endif
    const int lo = args.ph_lo, hi = args.ph_hi;
#define IN(k) (lo <= (k) && (k) < hi)
#define SEAM(k) do { if (IN(k) && IN((k) + 1)) GRID_BAR(); } while (0)
#define PHON(j) ((PHMASK >> (j)) & 1u)
    if (IN(0) && PHON(31)) { phase_prologue(F, args); if (DUP(31)) { GRID_BAR(); phase_prologue(F, args); } }
    SEAM(0);
    for (int l = 0; l < NL; ++l) {
        const int pb = 1 + l * PH_PER_LAYER;
        if (IN(pb + PH_G1) && PHON(PH_G1)) {
            PHASE_BASES();
            pg8::Gemm g{WSP(bf16_t, WS_XB), WSP(bf16_t, WS_WIN) + (size_t)l * NIN * D, M, NIN, D, D}; pg8::StaticOrder S; S.init(M, NIN, F.G, (int)blockIdx.x);
            EpiIn E{l, ws, outp};
            pg8::gemm_phase<EpiIn, pg8::StaticOrder, true, true>(F.lds, g, S, E);
            if (DUP(PH_G1)) { GRID_BAR(); pg8::gemm_phase<EpiIn, pg8::StaticOrder, true, true>(F.lds, g, S, E); }
        }
        SEAM(pb + PH_G1);
        if (IN(pb + PH_CONV) && PHON(PH_CONV)) { phase_conv(F, l); if (DUP(PH_CONV)) { GRID_BAR(); phase_conv(F, l); } }
        if (IN(pb + PH_A1) && PHON(PH_A1)) { phase_a1(F, l); if (DUP(PH_A1)) { GRID_BAR(); phase_a1(F, l, 2); } }
        SEAM(pb + PH_CONV);
        if (IN(pb + PH_B) && PHON(PH_B)) { phase_b(F, l); if (DUP(PH_B)) { GRID_BAR(); phase_b(F, l); } }
        if (IN(pb + PH_C1) && PHON(PH_C1)) { phase_c1(F, l); if (DUP(PH_C1)) { GRID_BAR(); phase_c1(F, l); } }
        if (IN(pb + PH_A2) && PHON(PH_A2)) { phase_a2(F, l); if (DUP(PH_A2)) { GRID_BAR(); phase_a2(F, l, 2); } }
        SEAM(pb + PH_C1);
        if (IN(pb + PH_C2) && PHON(PH_C2)) { phase_c2(F, l); if (DUP(PH_C2)) { GRID_BAR(); phase_c2(F, l); } }
        SEAM(pb + PH_C2);
        if (IN(pb + PH_C3) && PHON(PH_C3)) { phase_c3(F, l); if (DUP(PH_C3)) { GRID_BAR(); phase_c3(F, l); } }
        SEAM(pb + PH_C3);
        if (IN(pb + PH_GN) && PHON(PH_GN)) { phase_gn(F, l); if (DUP(PH_GN)) { GRID_BAR(); phase_gn(F, l); } }
        SEAM(pb + PH_GN);
        if (IN(pb + PH_G2) && PHON(PH_G2)) {
            PHASE_BASES();
            { pg8::Gemm g{WSP(bf16_t, WS_MIX), WSP(bf16_t, WS_WOUT) + (size_t)l * D * D, MP, D, D, D}; pg8::StaticOrder S; S.init(MP, D, F.G, (int)blockIdx.x);
              EpiOut E{outp + O_Y, ws, l};
              pg8::gemm_phase<EpiOut, pg8::StaticOrder, true, true>(F.lds, g, S, E); }
            { pg8::Gemm g{WSP(bf16_t, WS_MIX), WSP(bf16_t, WS_WOUT) + (size_t)l * D * D, M, D, D, D / NSL2}; pg8::TailOrder S; S.init(MP / 256, MS / 256, D, NSL2, D / NSL2, F.G, (int)blockIdx.x);
              EpiTail E{WSP(float, WS_PART), (D / NSL2) * 2};
              pg8::gemm_phase<EpiTail, pg8::TailOrder, true, true>(F.lds, g, S, E); }
        }
        SEAM(pb + PH_G2);
        if (IN(pb + PH_F2) && PHON(PH_F2)) phase_fin(F, 2 * l + 1, NSL2, true);
        SEAM(pb + PH_F2);
        if (IN(pb + PH_G3) && PHON(PH_G3)) {
            PHASE_BASES();
            pg8::Gemm g{WSP(bf16_t, WS_XB), WSP(bf16_t, WS_WGU) + (size_t)l * NGU * D, M, NGU, D, D}; pg8::StaticOrder S; S.init(M, NGU, F.G, (int)blockIdx.x);
            EpiGU E{ws, l};
            pg8::gemm_phase<EpiGU, pg8::StaticOrder, true, true>(F.lds, g, S, E);
            if (DUP(PH_G3)) { GRID_BAR(); pg8::gemm_phase<EpiGU, pg8::StaticOrder, true, true>(F.lds, g, S, E); }
        }
        SEAM(pb + PH_G3);
        if (IN(pb + PH_G4) && PHON(PH_G4)) {
            PHASE_BASES();
            { pg8::Gemm g{WSP(bf16_t, WS_HMID), WSP(bf16_t, WS_WDN) + (size_t)l * D * DFF, MP, D, DFF, DFF}; pg8::StaticOrder S; S.init(MP, D, F.G, (int)blockIdx.x);
              EpiDown E{outp + O_Y, ws, l};
              pg8::gemm_phase<EpiDown, pg8::StaticOrder, true, true>(F.lds, g, S, E); }
            { pg8::Gemm g{WSP(bf16_t, WS_HMID), WSP(bf16_t, WS_WDN) + (size_t)l * D * DFF, M, D, DFF, DFF / NSL4}; pg8::TailOrder S; S.init(MP / 256, MS / 256, D, NSL4, DFF / NSL4, F.G, (int)blockIdx.x);
              EpiTail E{WSP(float, WS_PART), (DFF / NSL4) * 2};
              pg8::gemm_phase<EpiTail, pg8::TailOrder, true, true>(F.lds, g, S, E); }
        }
        SEAM(pb + PH_G4);
        if (IN(pb + PH_F4) && PHON(PH_F4)) phase_fin(F, 2 * l + 2, NSL4, l + 1 < NL);
        SEAM(pb + PH_F4);
    }
#undef IN
#undef SEAM
}

#ifndef HOST_EMU
extern "C" void kernel_launch(void* const* d_in, const int* in_sizes, int n_in, void* d_out, int out_size, void* d_ws, size_t ws_size, hipStream_t stream) {
    static int grid = 0;
    if (grid == 0) {
        if (n_in != 27 || (size_t)out_size != O_END || ws_size < WS_END) { fprintf(stderr, "kernel_launch: unexpected sizes (n_in %d, out %d, ws %zu; need %zu / %zu)\n", n_in, out_size, ws_size, (size_t)O_END, (size_t)WS_END); grid = -1; return; }
        int dev = 0, cus = 0, per_cu = 0;
        if (hipGetDevice(&dev) != hipSuccess || hipDeviceGetAttribute(&cus, hipDeviceAttributeMultiprocessorCount, dev) != hipSuccess) { grid = -1; return; }
        if (hipFuncSetAttribute((const void*)mega, hipFuncAttributeMaxDynamicSharedMemorySize, LDS_BYTES) != hipSuccess) { fprintf(stderr, "kernel_launch: hipFuncSetAttribute failed\n"); grid = -1; return; }
        if (hipOccupancyMaxActiveBlocksPerMultiprocessor(&per_cu, (const void*)mega, 512, LDS_BYTES) != hipSuccess || per_cu < 1) fprintf(stderr, "kernel_launch: occupancy query reports %d\n", per_cu);
        (void)hipGetLastError();
        grid = cus;
    }
    if (grid < 0) return;
    if (hipMemsetAsync((char*)d_ws + WS_CTL, 0, CTL_ZERO_BYTES, stream) != hipSuccess) return;
    Args a{};
    for (int i = 0; i < 27; ++i) a.in[i] = (const float*)d_in[i];
    a.out = (float*)d_out; a.ws = (unsigned char*)d_ws;
#if ONE_LAUNCH
    a.ph_lo = 0; a.ph_hi = NPH;
    hipLaunchKernelGGL(mega, dim3(grid), dim3(512), LDS_BYTES, stream, a);
#else
    for (int ph = 0; ph < NPH; ++ph) { a.ph_lo = ph; a.ph_hi = ph + 1; hipLaunchKernelGGL(mega, dim3(grid), dim3(512), LDS_BYTES, stream, a); }
#endif
}
#endif
```

```cpp
#ifndef HOST_EMU
#include <hip/hip_runtime.h>
#endif
#include <cstdio>
#include <cstdint>
#include <cmath>

#ifndef CFG_BATCH
#define CFG_BATCH 4
#endif
#ifndef CFG_SEQ
#define CFG_SEQ 4096
#endif
#ifndef CFG_DEC_BATCH
#define CFG_DEC_BATCH 32
#endif
#ifndef CFG_PAST
#define CFG_PAST 4096
#endif
#ifndef CFG_DFF
#define CFG_DFF 5632
#endif
#ifndef ONE_LAUNCH
#define ONE_LAUNCH 1
#endif

#ifdef HOST_EMU
#define LAS
#define GAS
#define DYN_LDS(name) unsigned char* name = emu::B->lds
#define WAVE_SYNC() emu::wave_barrier()
#define MFMA32(a, b, c) emu_mfma32(a, b, c)
#define FAST_EXP2(x) exp2f(x)
#define FAST_LOG2(x) log2f(x)
#define FAST_RCP(x) (1.0f / (x))
#define FAST_RSQ(x) (1.0f / sqrtf(x))
#define MFMA16(a, b, c) emu_mfma16(a, b, c)
#else
#define LAS __attribute__((address_space(3)))
#define GAS __attribute__((address_space(1)))
#define DYN_LDS(name) extern __shared__ __attribute__((aligned(16))) unsigned char name[]
#define WAVE_SYNC() do { asm volatile("s_waitcnt lgkmcnt(0)" ::: "memory"); __builtin_amdgcn_wave_barrier(); } while (0)
#define MFMA32(a, b, c) __builtin_amdgcn_mfma_f32_32x32x16_bf16(a, b, c, 0, 0, 0)
#define FAST_EXP2(x) __builtin_amdgcn_exp2f(x)
#define FAST_LOG2(x) __builtin_amdgcn_logf(x)
#define FAST_RCP(x) __builtin_amdgcn_rcpf(x)
#define FAST_RSQ(x) __builtin_amdgcn_rsqf(x)
#define MFMA16(a, b, c) __builtin_amdgcn_mfma_f32_16x16x32_bf16(a, b, c, 0, 0, 0)
#endif
namespace pg8 {
#define PG8_LAS __attribute__((address_space(3)))
typedef unsigned short bf16_t;
typedef short bf16x8 __attribute__((ext_vector_type(8)));
typedef float f32x4 __attribute__((ext_vector_type(4)));
typedef unsigned u32x4 __attribute__((ext_vector_type(4)));
constexpr int BM = 256, BK = 64, HALF = 128, HTB = HALF * BK * 2  , STAGE_BYTES = 8 * HTB, NXCD = 8, WGM = 8;

__host__ __device__ __forceinline__ int lds_byte(int r, int c) { const int st = (r >> 4) * 2 + (c >> 5), rr = r & 15, cc = c & 31, ob = rr * 64 + cc * 2; return st * 1024 + (ob ^ (((ob >> 9) & 1) << 5)); }
__host__ __device__ __forceinline__ void stage_rc(int b, int& R, int& C) { const int st = b / 1024, sb = b % 1024, swz = sb ^ (((sb >> 9) & 1) << 5); R = (st >> 1) * 16 + swz / 64; C = (st & 1) * 32 + (swz % 64) / 2; }
__host__ __device__ __forceinline__ int perm32(int rho) { const int n = rho >> 4, i = rho & 15; return 8 * (i >> 2) + 4 * n + (i & 3); }

struct Unit { int pm, pn, kofs; };
struct Gemm { const bf16_t* A; const bf16_t* Bt; int M, N, K, Klen; };

struct StaticOrder {
    int nM, nN, nwg, G, c;
    __host__ __device__ void init(int M, int N, int G_, int c_) { nM = M / BM; nN = N / BM; nwg = nM * nN; G = G_; c = c_; }
    __host__ __device__ bool next(int i, Unit& u) const {
        const long L = (long)i * G + c; if (L >= nwg) return false;
        int wgid = (int)L; { const int q = nwg / NXCD, r = nwg % NXCD, xcd = wgid % NXCD, off = wgid / NXCD; wgid = (xcd < r ? xcd * (q + 1) : r * (q + 1) + (xcd - r) * q) + off; }
        const int nig = WGM * nN, gid = wgid / nig, fm = gid * WGM, gsz = (nM - fm) < WGM ? (nM - fm) : WGM;
        u.pm = fm + ((wgid % nig) % gsz); u.pn = (wgid % nig) / gsz; u.kofs = 0; return true;
    }
    __device__ __forceinline__ void a_ready(const Unit&) const {}
    __device__ __forceinline__ void done(const Unit&) const {}
};

struct TailOrder {
    int pm0, nN, ntile, nsl, klen_bytes, G, c;
    __host__ __device__ void init(int pm0_, int nM_, int N, int nsl_, int Klen, int G_, int c_) { pm0 = pm0_; nN = N / BM; ntile = nM_ * nN; nsl = nsl_; klen_bytes = Klen * 2; G = G_; c = c_; }
    __host__ __device__ bool next(int i, Unit& u) const {
        const long L = (long)i * G + c; if (L >= (long)ntile * nsl) return false;
        const int tile = (int)(L / nsl), sl = (int)(L % nsl); u.pm = pm0 + tile / nN; u.pn = tile % nN; u.kofs = sl * klen_bytes; return true;
    }
    __device__ __forceinline__ void a_ready(const Unit&) const {}
    __device__ __forceinline__ void done(const Unit&) const {}
};

#ifdef HOST_EMU
__device__ __forceinline__ unsigned cvt_pk_bf16(float lo, float hi) {
    auto f2b = [](float f) { unsigned u = __builtin_bit_cast(unsigned, f); return (u + 0x7fffu + ((u >> 16) & 1u)) >> 16; };
    return f2b(lo) | (f2b(hi) << 16);
}
#else
__device__ __forceinline__ unsigned cvt_pk_bf16(float lo, float hi) { unsigned r; asm volatile("v_cvt_pk_bf16_f32 %0, %1, %2" : "=v"(r) : "v"(lo), "v"(hi)); return r; }
#endif
typedef unsigned u32x4 __attribute__((ext_vector_type(4)));
#ifndef HOST_EMU
template <class Epi, class Sched, bool ALIGN_EPI = false, bool SP2 = false>
__device__ __forceinline__ void gemm_phase(PG8_LAS unsigned char* lds, const Gemm g, const Sched& S, const Epi& E) {
    int tid_l = threadIdx.x; asm volatile("" : "+v"(tid_l));
    const int tid = tid_l, wid = __builtin_amdgcn_readfirstlane(tid >> 6), lane = tid & 63, wr = wid >> 2, wc = wid & 3, fr = lane & 15, fq = lane >> 4;
    const int K = g.K, nt = g.Klen / BK;
    unsigned voffA[2], voffB[2];
#pragma unroll
    for (int i = 0; i < 2; ++i) { int R, C; stage_rc(tid * 16 + i * 8192, R, C); const int Rb = Epi::PERM ? ((R & ~31) + perm32(R & 31)) : R;
        voffA[i] = (unsigned)(R * K + C) * 2u; voffB[i] = (unsigned)(Rb * K + C) * 2u; }
    const size_t kstep = (size_t)(BK * 2);
    const size_t hstep = (size_t)HALF * K * 2;
    const size_t tstep = 2 * hstep;
    const unsigned ldsw = (unsigned)wid * 1024u;
    const int aoff = lds_byte(wr * 64 + fr, fq * 8), boff = lds_byte(wc * 32 + fr, fq * 8);
#define PG8_SA(b, h) (((b) * 2 + (h)) * HTB)
#define PG8_SB(b, h) ((4 + (b) * 2 + (h)) * HTB)
#define PG8_STAGE(bufoff, gbase, voff) do { _Pragma("unroll") for (int _i = 0; _i < 2; ++_i) \
        __builtin_amdgcn_global_load_lds((const unsigned*)((const char*)(gbase) + (voff)[_i]), (PG8_LAS unsigned*)(lds + (bufoff) + ldsw + _i * 8192), 16, 0, 0); } while (0)
#define PG8_LDA(dst, b, h) do { _Pragma("unroll") for (int m = 0; m < 4; ++m) _Pragma("unroll") for (int k = 0; k < 2; ++k) dst[m][k] = *(const PG8_LAS bf16x8*)(lds + PG8_SA(b, h) + aoff + m * 2048 + k * 1024); } while (0)
#define PG8_LDB(dst, b, h) do { _Pragma("unroll") for (int n = 0; n < 2; ++n) _Pragma("unroll") for (int k = 0; k < 2; ++k) dst[n][k] = *(const PG8_LAS bf16x8*)(lds + PG8_SB(b, h) + boff + n * 2048 + k * 1024); } while (0)
#define PG8_MMA(ai, bj, At, Bt) do { __builtin_amdgcn_s_setprio(1); _Pragma("unroll") for (int m = 0; m < 4; ++m) _Pragma("unroll") for (int n = 0; n < 2; ++n) _Pragma("unroll") for (int k = 0; k < 2; ++k) \
        acc[ai][bj][m][n] = __builtin_amdgcn_mfma_f32_16x16x32_bf16(Bt[n][k], At[m][k], acc[ai][bj][m][n], 0, 0, 0); __builtin_amdgcn_s_setprio(0); } while (0)
#define PG8_WAIT_V(n) asm volatile("s_waitcnt vmcnt(" #n ")" ::: "memory")
#define PG8_WAIT_L(n) asm volatile("s_waitcnt lgkmcnt(" #n ")" ::: "memory")
#define PG8_BAR __builtin_amdgcn_s_barrier()
#define PG8_SCHED __builtin_amdgcn_sched_barrier(0)
    Unit cur, nxt; int ui = 0;
    if (!S.next(0, cur)) return;
    f32x4 acc[2][2][4][2];
#pragma unroll
    for (int a = 0; a < 2; ++a)
#pragma unroll
        for (int b = 0; b < 2; ++b)
#pragma unroll
            for (int m = 0; m < 4; ++m)
#pragma unroll
                for (int n = 0; n < 2; ++n) acc[a][b][m][n] = (f32x4){0.f, 0.f, 0.f, 0.f};
    bf16x8 At[4][2], B0[2][2], B1[2][2];
    const char* cA = (const char*)g.A + (size_t)cur.pm * tstep + cur.kofs; const char* cB = (const char*)g.Bt + (size_t)cur.pn * tstep + cur.kofs;
    S.a_ready(cur);
    if constexpr (SP2) {
        PG8_STAGE(PG8_SB(0, 0), cB, voffB); PG8_STAGE(PG8_SB(0, 1), cB + hstep, voffB); PG8_STAGE(PG8_SA(0, 0), cA, voffA); PG8_STAGE(PG8_SA(0, 1), cA + hstep, voffA);
        if (wr == 1) PG8_BAR;
        PG8_WAIT_V(2); PG8_BAR;
        PG8_STAGE(PG8_SB(1, 0), cB + kstep, voffB); PG8_STAGE(PG8_SA(1, 0), cA + kstep, voffA); PG8_STAGE(PG8_SB(1, 1), cB + hstep + kstep, voffB);
        PG8_WAIT_V(6); PG8_BAR;
    } else {
        PG8_STAGE(PG8_SB(0, 0), cB, voffB); PG8_STAGE(PG8_SA(0, 0), cA, voffA); PG8_STAGE(PG8_SB(0, 1), cB + hstep, voffB); PG8_STAGE(PG8_SA(0, 1), cA + hstep, voffA);
        if (wr == 1) PG8_BAR;
        PG8_WAIT_V(4); PG8_BAR;
        PG8_STAGE(PG8_SB(1, 0), cB + kstep, voffB); PG8_STAGE(PG8_SA(1, 0), cA + kstep, voffA); PG8_STAGE(PG8_SB(1, 1), cB + hstep + kstep, voffB);
        PG8_WAIT_V(6); PG8_BAR;
    }
    for (;;) {
        const bool has_next = S.next(ui + 1, nxt);
        const char* nA = has_next ? (const char*)g.A + (size_t)nxt.pm * tstep + nxt.kofs : cA; const char* nB = has_next ? (const char*)g.Bt + (size_t)nxt.pn * tstep + nxt.kofs : cB;
        for (int t = 0; t < nt; t += 2) {
            const bool last = (t == nt - 2);
            const char* a1 = cA + (size_t)(t + 1) * kstep;
            const char* a2 = last ? nA : cA + (size_t)(t + 2) * kstep; const char* b2 = last ? nB : cB + (size_t)(t + 2) * kstep;
            const char* a3 = a2 + kstep; const char* b3 = b2 + kstep;
            if (last && has_next) S.a_ready(nxt);
            if constexpr (SP2) {
            PG8_LDB(B0, 0, 0); PG8_LDB(B1, 0, 1); PG8_SCHED; PG8_LDA(At, 0, 0); PG8_STAGE(PG8_SA(1, 1), a1 + hstep, voffA);
            PG8_WAIT_V(8); PG8_WAIT_L(0); PG8_BAR; PG8_MMA(0, 0, At, B0); PG8_MMA(0, 1, At, B1); PG8_BAR; PG8_SCHED;
            PG8_LDA(At, 0, 1); PG8_STAGE(PG8_SB(0, 0), b2, voffB); PG8_STAGE(PG8_SB(0, 1), b2 + hstep, voffB); PG8_STAGE(PG8_SA(0, 0), a2, voffA);
            PG8_WAIT_V(8); PG8_WAIT_L(0); PG8_BAR; PG8_MMA(1, 0, At, B0); PG8_MMA(1, 1, At, B1); PG8_BAR; PG8_SCHED;
            PG8_LDB(B0, 1, 0); PG8_LDB(B1, 1, 1); PG8_SCHED; PG8_LDA(At, 1, 0); PG8_STAGE(PG8_SA(0, 1), a2 + hstep, voffA);
            PG8_WAIT_V(8); PG8_WAIT_L(0); PG8_BAR; PG8_MMA(0, 0, At, B0); PG8_MMA(0, 1, At, B1); PG8_BAR; PG8_SCHED;
            PG8_LDA(At, 1, 1); PG8_STAGE(PG8_SB(1, 0), b3, voffB); PG8_STAGE(PG8_SB(1, 1), b3 + hstep, voffB); PG8_STAGE(PG8_SA(1, 0), a3, voffA);
            PG8_WAIT_V(8); PG8_WAIT_L(0); PG8_BAR; PG8_MMA(1, 0, At, B0); PG8_MMA(1, 1, At, B1); PG8_BAR; PG8_SCHED;
            } else {
            PG8_LDB(B0, 0, 0); PG8_SCHED; PG8_LDA(At, 0, 0); PG8_STAGE(PG8_SA(1, 1), a1 + hstep, voffA);
            PG8_WAIT_L(8); PG8_BAR; PG8_WAIT_L(0); PG8_MMA(0, 0, At, B0); PG8_BAR; PG8_SCHED;
            PG8_LDB(B1, 0, 1); PG8_STAGE(PG8_SB(0, 0), b2, voffB);
            PG8_BAR; PG8_WAIT_L(0); PG8_MMA(0, 1, At, B1); PG8_BAR;
            PG8_LDA(At, 0, 1); PG8_STAGE(PG8_SA(0, 0), a2, voffA);
            PG8_BAR; PG8_WAIT_L(0); PG8_MMA(1, 0, At, B0); PG8_BAR; PG8_SCHED;
            PG8_STAGE(PG8_SB(0, 1), b2 + hstep, voffB);
            PG8_WAIT_V(6); PG8_BAR; PG8_MMA(1, 1, At, B1); PG8_BAR;
            PG8_LDB(B0, 1, 0); PG8_SCHED; PG8_LDA(At, 1, 0); PG8_STAGE(PG8_SA(0, 1), a2 + hstep, voffA);
            PG8_WAIT_L(8); PG8_BAR; PG8_WAIT_L(0); PG8_MMA(0, 0, At, B0); PG8_BAR; PG8_SCHED;
            PG8_LDB(B1, 1, 1); PG8_STAGE(PG8_SB(1, 0), b3, voffB);
            PG8_BAR; PG8_WAIT_L(0); PG8_MMA(0, 1, At, B1); PG8_BAR;
            PG8_LDA(At, 1, 1); PG8_STAGE(PG8_SA(1, 0), a3, voffA);
            PG8_BAR; PG8_WAIT_L(0); PG8_MMA(1, 0, At, B0); PG8_BAR; PG8_SCHED;
            PG8_STAGE(PG8_SB(1, 1), b3 + hstep, voffB);
            PG8_WAIT_V(6); PG8_BAR; PG8_MMA(1, 1, At, B1); PG8_BAR;
            }
        }
        if constexpr (ALIGN_EPI) { if (wr == 0) PG8_BAR; }
        if constexpr (!Epi::AFTER_DRAIN) { int fr_e = fr, fq_e = fq; asm volatile("" : "+v"(fr_e), "+v"(fq_e));
            E(acc, cur, wr, wc, fr_e, fq_e); S.done(cur); }
        if (!has_next) break;
#pragma unroll
        for (int a = 0; a < 2; ++a)
#pragma unroll
            for (int b = 0; b < 2; ++b)
#pragma unroll
                for (int m = 0; m < 4; ++m)
#pragma unroll
                    for (int n = 0; n < 2; ++n) acc[a][b][m][n] = (f32x4){0.f, 0.f, 0.f, 0.f};
        cur = nxt; cA = nA; cB = nB; ++ui;
        if constexpr (ALIGN_EPI) { if (wr == 1) PG8_BAR; }
    }
    PG8_WAIT_V(0);
    if constexpr (!ALIGN_EPI) { if (wr == 0) PG8_BAR; }
    PG8_BAR;
    if constexpr (Epi::AFTER_DRAIN) { E.fused(acc, cur, wr, wc, fr, fq, lds, wid, lane); S.done(cur); }
#undef PG8_SA
#undef PG8_SB
#undef PG8_STAGE
#undef PG8_LDA
#undef PG8_LDB
#undef PG8_MMA
#undef PG8_WAIT_V
#undef PG8_WAIT_L
#undef PG8_BAR
#undef PG8_SCHED
}
#else
template <class Epi, class Sched, bool ALIGN_EPI = false, bool SP2 = false>
inline void gemm_phase(unsigned char* lds, const Gemm g, const Sched& S, const Epi& E) {
    (void)lds;
    static thread_local float* pa = nullptr; static thread_local float* pb = nullptr;
    const int tid = threadIdx.x, wid = tid >> 6, lane = tid & 63, wr = wid >> 2, wc = wid & 3, fr = lane & 15, fq = lane >> 4;
    const int K = g.K, KL = g.Klen;
    if (tid == 0 && !pa) { pa = (float*)malloc(256 * 8192 * 4); pb = (float*)malloc(256 * 8192 * 4); }
    __syncthreads();
    Unit cur;
    for (int ui = 0; S.next(ui, cur); ++ui) {
        { const int r = tid >> 1, h = tid & 1; const bf16_t* ar = g.A + (size_t)(cur.pm * 256 + r) * K + h * (K / 2); const bf16_t* br = g.Bt + (size_t)(cur.pn * 256 + r) * K + h * (K / 2);
          for (int k = 0; k < K / 2; ++k) { unsigned ua = (unsigned)ar[k] << 16, ub = (unsigned)br[k] << 16; pa[(size_t)r * K + h * (K / 2) + k] = __builtin_bit_cast(float, ua); pb[(size_t)r * K + h * (K / 2) + k] = __builtin_bit_cast(float, ub); } }
        __syncthreads();
        f32x4 acc[2][2][4][2];
        for (int ai = 0; ai < 2; ++ai) for (int bj = 0; bj < 2; ++bj) for (int m = 0; m < 4; ++m) for (int n = 0; n < 2; ++n) for (int e = 0; e < 4; ++e) {
            const int r = ai * 128 + wr * 64 + m * 16 + fr; const int c = bj * 128 + wc * 32 + (Epi::PERM ? 8 * fq + 4 * n + e : 16 * n + 4 * fq + e);
            const float* x = pa + (size_t)r * K + cur.kofs / 2; const float* y = pb + (size_t)c * K + cur.kofs / 2; float s = 0.f; for (int k = 0; k < KL; ++k) s += x[k] * y[k]; acc[ai][bj][m][n][e] = s; }
        E(acc, cur, wr, wc, fr, fq);
        __syncthreads();
    }
}
#endif
}
constexpr int D = 2048, NB = CFG_BATCH, T = CFG_SEQ, NL = 2, SB = CFG_DEC_BATCH, ST = 32, PAST = CFG_PAST, DFF = CFG_DFF;
constexpr int MP = NB * T, MS = SB * ST, M = MP + MS, LS = PAST + ST;
constexpr int NIN = 6656, NGU = 2 * DFF, WIN_COLS = 6496;
constexpr int KTOP_P = (T / 4 < 256) ? T / 4 : 256, KTOP_S = (LS / 4 < 256) ? LS / 4 : 256;
constexpr int LMAXV = (T > LS) ? T : LS, LPAD = (LMAXV + 63) / 64 * 64;
constexpr float EPSN = 1e-6f;
static_assert(M % 256 == 0 && T % 64 == 0 && DFF % 128 == 0 && PAST % 64 == 0, "tile divisibility");
constexpr size_t O_Y = 0;
constexpr size_t O_PAK = (size_t)M * D, O_PAV = O_PAK + (size_t)NL * MP * 128, O_PIK = O_PAV + (size_t)NL * MP * 128, O_PBK = O_PIK + (size_t)NL * MP * 64,
                 O_PBV = O_PBK + (size_t)NL * MP * 512, O_PSSM = O_PBV + (size_t)NL * MP * 512, O_PCONV = O_PSSM + (size_t)NL * NB * 131072,
                 O_SAK = O_PCONV + (size_t)NL * NB * 6144, O_SAV = O_SAK + (size_t)NL * MS * 128, O_SIK = O_SAV + (size_t)NL * MS * 128, O_SBK = O_SIK + (size_t)NL * MS * 64,
                 O_SBV = O_SBK + (size_t)NL * MS * 512, O_SSSM = O_SBV + (size_t)NL * MS * 512, O_SCONV = O_SSSM + (size_t)NL * SB * 131072, O_END = O_SCONV + (size_t)NL * SB * 6144;
constexpr size_t al256(size_t x) { return (x + 255) & ~(size_t)255; }
constexpr size_t WS_CTL = 0, CTL_ZERO_BYTES = 1u << 20;
constexpr int CW_BAR = 4096;
constexpr size_t CTL_QUEUE = 8192;
constexpr size_t CTL_QUEUE2 = 12288;
static_assert(NB + 1 <= 8 && CTL_QUEUE2 + (size_t)NL * 8 * 256 <= (size_t)CW_BAR * 4, "attention queues fit below the barrier words");
constexpr size_t CTL_RSS = 65536;
static_assert(CTL_RSS + (size_t)4 * M * 4 <= CTL_ZERO_BYTES, "RSS inside the memset region");
constexpr size_t WS_WIN = CTL_ZERO_BYTES;
constexpr size_t WS_WOUT = WS_WIN + al256((size_t)NL * NIN * D * 2);
constexpr size_t WS_WGU = WS_WOUT + al256((size_t)NL * D * D * 2);
constexpr size_t WS_WDN = WS_WGU + al256((size_t)NL * NGU * D * 2);
constexpr size_t WS_XB = WS_WDN + al256((size_t)NL * D * DFF * 2);
constexpr size_t WS_ROPE = WS_XB + al256((size_t)M * D * 2);
constexpr size_t WS_AQ = WS_ROPE + al256((size_t)LS * 16 * 4);
constexpr size_t WS_IQ = WS_AQ + al256((size_t)M * 512 * 2);
constexpr size_t WS_IW = WS_IQ + al256((size_t)M * 1024 * 2);
constexpr size_t WS_BQ = WS_IW + al256((size_t)M * 16 * 4);
constexpr size_t WS_CZ = WS_BQ + al256((size_t)M * 512 * 2);
constexpr size_t WS_CX = WS_CZ + al256((size_t)M * 1024 * 2);
constexpr size_t WS_DT = WS_CX + al256((size_t)M * 2048 * 2);
constexpr int NC = T / 64, NCU = NB * NC + SB, MPADT = M + 64;
constexpr size_t WS_XC = WS_DT + al256((size_t)M * 16 * 4);
constexpr size_t WS_XCT = WS_XC + al256((size_t)M * 2048 * 2);
constexpr size_t WS_CS = WS_XCT + al256((size_t)2048 * MPADT * 2);
constexpr size_t WS_CD = WS_CS + al256((size_t)NCU * 16 * 8192 * 4);
constexpr size_t WS_ENT = WS_CD + al256((size_t)NCU * 16 * 4);
constexpr size_t WS_YC = WS_ENT + al256((size_t)NCU * 16 * 8192 * 2);
constexpr int LSP = LPAD;
constexpr size_t WS_IKBP = WS_YC + al256((size_t)M * 1024 * 4);
constexpr size_t WS_IKBS = WS_IKBP + al256((size_t)MP * 64 * 2);
constexpr size_t WS_AKBP = WS_IKBS + al256((size_t)NL * SB * LSP * 64 * 2);
constexpr size_t WS_AKBS = WS_AKBP + al256((size_t)MP * 128 * 2);
constexpr size_t WS_AVTP = WS_AKBS + al256((size_t)NL * SB * LSP * 128 * 2);
constexpr size_t WS_AVTS = WS_AVTP + al256((size_t)NB * 128 * T * 2);
constexpr size_t WS_NSEL = WS_AVTS + al256((size_t)NL * SB * 128 * LSP * 2);
constexpr int MASK_W = LPAD / 32;
constexpr size_t WS_MASK = WS_NSEL + al256((size_t)M * 4);
constexpr size_t WS_MIX = WS_MASK + al256((size_t)M * MASK_W * 4);
constexpr size_t WS_HMID = WS_MIX + al256((size_t)M * 2048 * 2);
constexpr size_t WS_PART = WS_HMID + al256((size_t)M * DFF * 2);
constexpr size_t WS_GT = WS_PART + al256((size_t)4 * MS * D * 4);
constexpr size_t WS_PT = WS_GT + 4096;
constexpr size_t WS_END = WS_PT + 4096;
constexpr int A1_NEED = LPAD * 4;
constexpr int A1_WAVE_BYTES = (A1_NEED > 9216) ? A1_NEED : 9216;
constexpr int A1_TILE_OFF = 8 * A1_WAVE_BYTES, A1_TILE_B = 64 * 144;
constexpr int LDS_PHASE_BYTES = (A1_TILE_OFF + 2 * A1_TILE_B > 139264) ? A1_TILE_OFF + 2 * A1_TILE_B : 139264;
constexpr int MISC_OFF = (LDS_PHASE_BYTES + 255) / 256 * 256, LDS_BYTES = MISC_OFF + 256;
static_assert(LDS_BYTES <= 163840 && A1_WAVE_BYTES >= 6144, "LDS budget");
constexpr int PH_PER_LAYER = 14, NPH = 1 + NL * PH_PER_LAYER;
enum { PH_G1 = 0, PH_A1, PH_CONV, PH_A2, PH_B, PH_C1, PH_C2, PH_C3, PH_GN, PH_G2, PH_F2, PH_G3, PH_G4, PH_F4 };
constexpr int NSL2 = 4, NSL4 = ((DFF / 4) % 128 == 0) ? 4 : (((DFF / 2) % 128 == 0) ? 2 : 1);

typedef unsigned short bf16_t;
typedef float f32x4 __attribute__((ext_vector_type(4)));
typedef unsigned u32x4 __attribute__((ext_vector_type(4)));
typedef unsigned u32x2 __attribute__((ext_vector_type(2)));
typedef short bf16x8 __attribute__((ext_vector_type(8)));
typedef float f32x16 __attribute__((ext_vector_type(16)));

__device__ __forceinline__ unsigned f2bf(float f) { unsigned u = __builtin_bit_cast(unsigned, f); return (u + 0x7fffu + ((u >> 16) & 1u)) >> 16; }
__device__ __forceinline__ float bf2f(unsigned h) { return __builtin_bit_cast(float, h << 16); }
__device__ __forceinline__ float bflo(unsigned w) { return __builtin_bit_cast(float, w << 16); }
__device__ __forceinline__ float bfhi(unsigned w) { return __builtin_bit_cast(float, w & 0xffff0000u); }
#ifdef HOST_EMU
__device__ __forceinline__ unsigned pk2(float lo, float hi) { return f2bf(lo) | (f2bf(hi) << 16); }
#else
__device__ __forceinline__ unsigned pk2(float lo, float hi) { unsigned r; asm("v_cvt_pk_bf16_f32 %0, %1, %2" : "=v"(r) : "v"(lo), "v"(hi)); return r; }
#endif
__device__ __forceinline__ float exp_f(float x) { return FAST_EXP2(x * 1.4426950408889634f); }
__device__ __forceinline__ float silu_f(float x) { return x * FAST_RCP(1.f + FAST_EXP2(-1.4426950408889634f * x)); }
__device__ __forceinline__ float softplus_f(float x) { return fmaxf(x, 0.f) + 0.6931471805599453f * FAST_LOG2(1.f + FAST_EXP2(-1.4426950408889634f * fabsf(x))); }
__device__ __forceinline__ float wave_sum(float v) {
#pragma unroll
    for (int o = 1; o < 64; o <<= 1) v += __shfl_xor(v, o);
    return v;
}
__device__ __forceinline__ float wave_max(float v) {
#pragma unroll
    for (int o = 1; o < 64; o <<= 1) v = fmaxf(v, __shfl_xor(v, o));
    return v;
}
__device__ __forceinline__ float wave_incl_scan(float v, int lane) {
#pragma unroll
    for (int off = 1; off < 64; off <<= 1) { const float tt = __shfl_up(v, off); if (lane >= off) v += tt; }
    return v;
}
__device__ __forceinline__ bf16x8 pack_bf16x8(const float (&v)[8]) { u32x4 w; w.x = pk2(v[0], v[1]); w.y = pk2(v[2], v[3]); w.z = pk2(v[4], v[5]); w.w = pk2(v[6], v[7]); return __builtin_bit_cast(bf16x8, w); }
__device__ __forceinline__ unsigned sortable_key(float s) { const unsigned u = __builtin_bit_cast(unsigned, s); return (u & 0x80000000u) ? ~u : (u | 0x80000000u); }

#ifndef HOST_EMU
#define XB_TMO      128
#define XB_XCNT(j)  (256  + 64 * (j))
#define XB_XSUB(j)  (1280 + 64 * (j))
#define XB_XGEN(j)  (2304 + 64 * (j))
#define XB_TOP      3328
#define XB_TOPGEN   3392
#define XCD_BAR_WORDS 3456
#define XB_SPIN_CAP (1u << 18)

__device__ __forceinline__ unsigned xb_ld(unsigned* p)              { return __hip_atomic_load(p, __ATOMIC_RELAXED, __HIP_MEMORY_SCOPE_AGENT); }
__device__ __forceinline__ unsigned xb_add(unsigned* p, unsigned v) { return __hip_atomic_fetch_add(p, v, __ATOMIC_RELAXED, __HIP_MEMORY_SCOPE_AGENT); }
__device__ __forceinline__ unsigned xb_xcc_id() { return (unsigned)__builtin_amdgcn_s_getreg((3 << 11) | 20) & 0xFu; }
#define XB_SPIN(cond, bar) do { unsigned _sp = 0; while (cond) { __builtin_amdgcn_s_sleep(1); \
    if ((++_sp & 255u) == 0u) { if (xb_ld(&(bar)[XB_TMO])) break; if (_sp > XB_SPIN_CAP) { atomicAdd(&(bar)[XB_TMO], 1u); break; } } } } while (0)

struct XcdBarrier {
    unsigned* bar; unsigned x;
    volatile LAS unsigned* st;
};

__device__ __forceinline__ XcdBarrier xcd_barrier_post(unsigned* bar, volatile LAS unsigned* st) {
    XcdBarrier b; b.bar = bar; b.x = xb_xcc_id(); b.st = st;
    if (threadIdx.x == 0) (void)xb_add(&bar[XB_XCNT(b.x)], 1u);
    return b;
}
__device__ __forceinline__ void xcd_barrier_complete(unsigned* bar, unsigned x, unsigned& nloc, unsigned& nx) {
    const unsigned G = gridDim.x * gridDim.y * gridDim.z;
    unsigned sum, cnt, mine, sp = 0u;
    for (;;) {
        sum = 0u; cnt = 0u; mine = 0u;
#pragma unroll
        for (unsigned j = 0; j < 16; ++j) { const unsigned c = xb_ld(&bar[XB_XCNT(j)]); sum += c; cnt += (c > 0u) ? 1u : 0u; mine = (j == x) ? c : mine; }
        if (sum == G) break;
        __builtin_amdgcn_s_sleep(1);
        if ((++sp & 255u) == 0u) { if (xb_ld(&bar[XB_TMO])) break; if (sp > XB_SPIN_CAP) { atomicAdd(&bar[XB_TMO], 1u); break; } }
    }
    nloc = mine > 0u ? mine : 1u; nx = cnt > 0u ? cnt : 1u;
}

__device__ __forceinline__ void xcd_barrier(const XcdBarrier& b) {
    asm volatile("s_waitcnt vmcnt(0)" ::: "memory");
    __syncthreads();
    if (threadIdx.x == 0) {
        unsigned* bar = b.bar;
        __builtin_amdgcn_s_waitcnt(0);
        unsigned nloc = b.st[0], nx = b.st[1];
        if (nloc == 0u) { xcd_barrier_complete(bar, b.x, nloc, nx); b.st[0] = nloc; b.st[1] = nx; }
        const unsigned old = xb_add(&bar[XB_XSUB(b.x)], 1u);
        const unsigned gen = old / nloc;
        if (old + 1u == (gen + 1u) * nloc) {
            __builtin_amdgcn_fence(__ATOMIC_RELEASE, "agent");
            asm volatile("s_waitcnt vmcnt(0)" ::: "memory");
            const unsigned og = xb_add(&bar[XB_TOP], 1u);
            const unsigned tg = og / nx;
            if (og + 1u == (tg + 1u) * nx) xb_add(&bar[XB_TOPGEN], 1u);
            else XB_SPIN(xb_ld(&bar[XB_TOPGEN]) == tg, bar);
            __builtin_amdgcn_fence(__ATOMIC_ACQUIRE, "agent");
            xb_add(&bar[XB_XGEN(b.x)], 1u);
            asm volatile("s_waitcnt vmcnt(0)" ::: "memory");
        } else {
            XB_SPIN(xb_ld(&bar[XB_XGEN(b.x)]) == gen, bar);
            __builtin_amdgcn_fence(__ATOMIC_ACQUIRE, "agent");
            asm volatile("s_waitcnt vmcnt(0)" ::: "memory");
        }
    }
    __syncthreads();
}
#endif

struct Args { const float* in[27]; float* out; unsigned char* ws; int ph_lo, ph_hi; };
struct Frame {
    LAS unsigned char* lds;
    int tid, lane, wave, G, gw, NGW;
    float* out; unsigned char* ws;
};
#define WSP(Tp, off) ((Tp*)(ws + (off)))
#ifdef HOST_EMU
#define EPI_FENCE() do { } while (0)
#define LAUNDER(p) do { } while (0)
#define LAUNDER_V(p) do { } while (0)
#else
#define EPI_FENCE() asm volatile("" ::: "memory")
#define LAUNDER(p) asm volatile("" : "+s"(p))
#define LAUNDER_V(p) asm volatile("" : "+v"(p))
#endif
#ifdef HOST_EMU
#define GPT(k) (PT[k])
#define PHASE_BASES() unsigned char* ws = F.ws; float* outp = F.out; const float* const* PT = (const float* const*)(ws + WS_PT); (void)PT; (void)outp; int tidl = threadIdx.x; LAUNDER_V(tidl); const int lane = tidl & 63; (void)lane
#else
#define GPT(k) ((const float*)(GAS const float*)PT[k])
#define PHASE_BASES() unsigned long long ws_u_ = (unsigned long long)F.ws, out_u_ = (unsigned long long)F.out; LAUNDER(ws_u_); LAUNDER(out_u_); unsigned char* ws = (unsigned char*)(GAS unsigned char*)ws_u_; float* outp = (float*)(GAS float*)out_u_; const unsigned long long* PT = (const unsigned long long*)(ws + WS_PT); (void)PT; (void)outp; int tidl = threadIdx.x; LAUNDER_V(tidl); const int lane = tidl & 63; (void)lane
#endif
enum { IN_XP = 0, IN_XS, IN_CAK, IN_CAV, IN_CAIK, IN_CBK, IN_CBV, IN_SSM, IN_SCONV, IN_N1G, IN_WIN, IN_GAQ, IN_GAK, IN_GIK, IN_GBQ, IN_GBK, IN_CONVW, IN_CONVB, IN_DTB, IN_ALOG, IN_CD, IN_CNG, IN_WOUT, IN_N2G, IN_WGATE, IN_WUP, IN_WDOWN };
constexpr int GT_STRIDE = 384;

struct RowInfo { bool prompt; int b, t, pos, rg; };
__device__ __forceinline__ RowInfo row_info(int row) {
    RowInfo r; r.prompt = row < MP;
    if (r.prompt) { r.rg = row; r.b = row / T; r.t = row - r.b * T; r.pos = r.t; }
    else { r.rg = row - MP; r.b = r.rg / ST; r.t = r.rg - r.b * ST; r.pos = PAST + r.t; }
    return r;
}
template <int W> __device__ __forceinline__ const float* kv_row(const float* outp, const float* outs, const float* cache, int l, bool prompt, int b, int s) {
    if (prompt) return outp + ((size_t)l * MP + (size_t)b * T + s) * W;
    if (s < PAST) return cache + (((size_t)l * SB + b) * PAST + s) * W;
    return outs + ((size_t)l * MS + (size_t)b * ST + (s - PAST)) * W;
}

__device__ __forceinline__ int inproj_src_col(int p) {
    const int pl = p & 255, L = (p & ~255) + 64 * ((pl >> 5) & 3) + 32 * ((pl >> 7) & 1) + (pl & 31);
    if (L < 1856) return L;
    if (L < 6464) return L + 16;
    if (L < 6480) return 1856 + (L - 6464);
    if (L < 6496) return L;
    return -1;
}
template <class ColFn>
__device__ __forceinline__ void transpose_load(f32x4 (&v)[2][8], const float* W, int ldw, ColFn colfn, const float* gain, int k0, int n0, int lane) {
    const int nq = lane & 15, kq = lane >> 4;
#pragma unroll
    for (int h = 0; h < 2; ++h) { const int col = colfn(n0 + 64 * h + 4 * nq);
#pragma unroll
        for (int j = 0; j < 8; ++j) v[h][j] = (col >= 0) ? *(const f32x4*)(W + (size_t)(k0 + 4 * j + kq) * ldw + col) : (f32x4){0.f, 0.f, 0.f, 0.f}; }
    if (gain) {
#pragma unroll
        for (int j = 0; j < 8; ++j) { const float g = gain[k0 + 4 * j + kq]; v[0][j] = v[0][j] * g; v[1][j] = v[1][j] * g; } }
}
__device__ __forceinline__ void transpose_store(const f32x4 (&v)[2][8], int K, bf16_t* WT, LAS float* scr, int k0, int n0, int lane) {
    const int nq = lane & 15, kq = lane >> 4;
#pragma unroll
    for (int h = 0; h < 2; ++h) {
#pragma unroll
        for (int j = 0; j < 8; ++j) *(LAS f32x4*)(scr + (4 * j + kq) * 68 + 4 * nq) = v[h][j];
        WAVE_SYNC();
        bf16_t* orow = WT + (size_t)(n0 + 64 * h + lane) * K + k0;
#pragma unroll
        for (int q = 0; q < 4; ++q) { u32x4 o;
            o.x = pk2(scr[(8 * q + 0) * 68 + lane], scr[(8 * q + 1) * 68 + lane]); o.y = pk2(scr[(8 * q + 2) * 68 + lane], scr[(8 * q + 3) * 68 + lane]);
            o.z = pk2(scr[(8 * q + 4) * 68 + lane], scr[(8 * q + 5) * 68 + lane]); o.w = pk2(scr[(8 * q + 6) * 68 + lane], scr[(8 * q + 7) * 68 + lane]);
            *(u32x4*)(orow + 8 * q) = o; }
        WAVE_SYNC();
    }
}
#define TRANSPOSE_MATRIX(NIT_, NBLK_, KB_, W_OF_NB, LDW_, COLFN_, GAIN_, KDIM_, WT_) do { const int nit_ = (NIT_); f32x4 va_[2][8], vb_[2][8]; \
        { const int c_ = (F.gw < nit_) ? F.gw : nit_ - 1; const int kb_ = c_ / (NBLK_), nb_ = c_ % (NBLK_); transpose_load(va_, W_OF_NB(nb_), (LDW_), COLFN_, (GAIN_), (KB_) * kb_, 128 * nb_, lane); } \
        for (int it_ = F.gw; it_ < nit_; it_ += 2 * F.NGW) { \
            { const int n_ = it_ + F.NGW, c_ = (n_ < nit_) ? n_ : nit_ - 1; const int kb_ = c_ / (NBLK_), nb_ = c_ % (NBLK_); transpose_load(vb_, W_OF_NB(nb_), (LDW_), COLFN_, (GAIN_), (KB_) * kb_, 128 * nb_, lane); } \
            { const int kb_ = it_ / (NBLK_), nb_ = it_ % (NBLK_); transpose_store(va_, (KDIM_), (WT_), scr, (KB_) * kb_, 128 * nb_, lane); } \
            { const int n_ = it_ + 2 * F.NGW, c_ = (n_ < nit_) ? n_ : nit_ - 1; const int kb_ = c_ / (NBLK_), nb_ = c_ % (NBLK_); transpose_load(va_, W_OF_NB(nb_), (LDW_), COLFN_, (GAIN_), (KB_) * kb_, 128 * nb_, lane); } \
            if (it_ + F.NGW < nit_) { const int n_ = it_ + F.NGW; const int kb_ = n_ / (NBLK_), nb_ = n_ % (NBLK_); transpose_store(vb_, (KDIM_), (WT_), scr, (KB_) * kb_, 128 * nb_, lane); } \
        } } while (0)
__device__ __forceinline__ void sincos_d(double x, double& s, double& c) {
    const double k = rint(x * 0.63661977236758134308); const double r = (x - k * 1.57079632679489655800) - k * 6.123233995736766036e-17; const double r2 = r * r;
    const double sp = r * (1.0 + r2 * (-1.0 / 6 + r2 * (1.0 / 120 + r2 * (-1.0 / 5040 + r2 * (1.0 / 362880 + r2 * (-1.0 / 39916800 + r2 * (1.0 / 6227020800.0)))))));
    const double cp = 1.0 + r2 * (-0.5 + r2 * (1.0 / 24 + r2 * (-1.0 / 720 + r2 * (1.0 / 40320 + r2 * (-1.0 / 3628800 + r2 * (1.0 / 479001600 + r2 * (-1.0 / 87178291200.0)))))));
    const int q = ((int)k) & 3;
    s = (q == 0) ? sp : (q == 1) ? cp : (q == 2) ? -sp : -cp; c = (q == 0) ? cp : (q == 1) ? -sp : (q == 2) ? -cp : sp;
}
__device__ __forceinline__ void phase_prologue(const Frame& F, const Args& A) {
    unsigned char* ws = F.ws;
    if (blockIdx.x == 0 && F.tid == 0) { const float** pt = (const float**)(ws + WS_PT);
#pragma unroll
        for (int i = 0; i < 27; ++i) pt[i] = A.in[i]; }
    LAS float* scr = (LAS float*)(F.lds + F.wave * 16384);
    const int lane = F.lane;
    for (int l = 0; l < NL; ++l) {
        { const float* W = A.in[IN_WIN] + (size_t)l * D * WIN_COLS; const float* gain = A.in[IN_N1G] + l * D; bf16_t* WT = WSP(bf16_t, WS_WIN) + (size_t)l * NIN * D;
#define W_SAME(nb_) W
          TRANSPOSE_MATRIX((D / 32) * (NIN / 128), (NIN / 128), 32, W_SAME, WIN_COLS, [](int p) { return inproj_src_col(p); }, gain, D, WT); }
        { const float* Wg = A.in[IN_WGATE] + (size_t)l * D * DFF; const float* Wu = A.in[IN_WUP] + (size_t)l * D * DFF; const float* gain = A.in[IN_N2G] + l * D; bf16_t* WT = WSP(bf16_t, WS_WGU) + (size_t)l * NGU * D;
#define W_GU(nb_) (((nb_) & 1) ? Wu : Wg)
          TRANSPOSE_MATRIX((D / 32) * (NGU / 128), (NGU / 128), 32, W_GU, DFF, [](int p) { const int pl = p & 255; return 128 * (p >> 8) + 32 * ((pl >> 5) & 3) + (pl & 31); }, gain, D, WT); }
        { const float* W = A.in[IN_WOUT] + (size_t)l * D * D; bf16_t* WT = WSP(bf16_t, WS_WOUT) + (size_t)l * D * D;
          TRANSPOSE_MATRIX((D / 32) * (D / 128), (D / 128), 32, W_SAME, D, [](int p) { return p; }, (const float*)nullptr, D, WT); }
        { const float* W = A.in[IN_WDOWN] + (size_t)l * DFF * D; bf16_t* WT = WSP(bf16_t, WS_WDN) + (size_t)l * D * DFF;
          TRANSPOSE_MATRIX((DFF / 32) * (D / 128), (D / 128), 32, W_SAME, D, [](int p) { return p; }, (const float*)nullptr, DFF, WT); }
    }
    { const float* cik = A.in[IN_CAIK];
      bf16_t* IKBS = WSP(bf16_t, WS_IKBS);
      const size_t gt_ = (size_t)blockIdx.x * 512 + F.tid, gs_ = (size_t)F.G * 512;
      for (size_t i = gt_; i < (size_t)NL * SB * PAST * 8; i += gs_) { const size_t rowi = i >> 3; const int c8 = (int)(i & 7) * 8; const size_t lb = rowi / PAST; const int sidx = (int)(rowi - lb * PAST);
          const f32x4 a = *(const f32x4*)(cik + rowi * 64 + c8), b4 = *(const f32x4*)(cik + rowi * 64 + c8 + 4);
          u32x4 w; w.x = pk2(a.x, a.y); w.y = pk2(a.z, a.w); w.z = pk2(b4.x, b4.y); w.w = pk2(b4.z, b4.w); *(u32x4*)(IKBS + (lb * LSP + sidx) * 64 + c8) = w; }
      for (size_t i = gt_; i < (size_t)NL * SB * (LSP - LS) * 8; i += gs_) { const size_t pr = i >> 3; const int c8 = (int)(i & 7) * 8; const size_t lb = pr / (LSP - LS); const int sidx = LS + (int)(pr - lb * (LSP - LS));
          *(u32x4*)(IKBS + (lb * LSP + sidx) * 64 + c8) = (u32x4){0u, 0u, 0u, 0u}; }
    }
    { const float* cak = A.in[IN_CAK]; bf16_t* AKBS = WSP(bf16_t, WS_AKBS); const size_t gt_ = (size_t)blockIdx.x * 512 + F.tid, gs_ = (size_t)F.G * 512;
      (void)cak;
      for (size_t i = gt_; i < (size_t)NL * SB * (LSP - LS) * 16; i += gs_) { const size_t pr = i >> 4; const int c8 = (int)(i & 15) * 8; const size_t lb = pr / (LSP - LS); const int sidx = LS + (int)(pr - lb * (LSP - LS));
          *(u32x4*)(AKBS + (lb * LSP + sidx) * 128 + c8) = (u32x4){0u, 0u, 0u, 0u}; }
    }
    { const float* cav = A.in[IN_CAV]; bf16_t* AVTS = WSP(bf16_t, WS_AVTS); const size_t gt_ = (size_t)blockIdx.x * 512 + F.tid, gs_ = (size_t)F.G * 512;
      (void)cav;
      for (size_t i = gt_; i < (size_t)NL * SB * 128 * ((LSP - LS) / 8); i += gs_) { const size_t rw = i / ((LSP - LS) / 8); const int c8 = (int)(i % ((LSP - LS) / 8)) * 8; *(u32x4*)(AVTS + rw * LSP + LS + c8) = (u32x4){0u, 0u, 0u, 0u}; }
    }
    if (blockIdx.x == 0) {
        float* gt = WSP(float, WS_GT);
        for (int i = F.tid; i < NL * GT_STRIDE; i += 512) { const int l = i / GT_STRIDE, j = i % GT_STRIDE; float v = 0.f;
            if (j < 64) v = A.in[IN_GAQ][l * 64 + j]; else if (j < 128) v = A.in[IN_GAK][l * 64 + j - 64]; else if (j < 192) v = A.in[IN_GIK][l * 64 + j - 128];
            else if (j < 256) v = A.in[IN_GBQ][l * 64 + j - 192]; else if (j < 320) v = A.in[IN_GBK][l * 64 + j - 256]; else if (j < 336) v = A.in[IN_DTB][l * 16 + j - 320];
            gt[i] = v; }
    }
    { const float* xs = A.in[IN_XS]; float* X = F.out + O_Y + (size_t)MP * D;
      for (size_t i = (size_t)blockIdx.x * 512 + F.tid; i < (size_t)MS * D / 4; i += (size_t)F.G * 512) *(f32x4*)(X + 4 * i) = *(const f32x4*)(xs + 4 * i); }
    { const float* xp = A.in[IN_XP]; const float* xs = A.in[IN_XS]; bf16_t* XB = WSP(bf16_t, WS_XB); float* RSS = WSP(float, CTL_RSS);
      for (int row0 = F.gw; row0 < M; row0 += 2 * F.NGW) {
        const int rowb = row0 + F.NGW; const bool hasb = rowb < M; const int rb2 = hasb ? rowb : row0;
        const float* xa = (row0 < MP) ? xp + (size_t)row0 * D : xs + (size_t)(row0 - MP) * D; const float* xb = (rb2 < MP) ? xp + (size_t)rb2 * D : xs + (size_t)(rb2 - MP) * D;
        f32x4 va[8], vb[8];
#pragma unroll
        for (int j = 0; j < 8; ++j) va[j] = *(const f32x4*)(xa + 4 * lane + 256 * j);
#pragma unroll
        for (int j = 0; j < 8; ++j) vb[j] = *(const f32x4*)(xb + 4 * lane + 256 * j);
        float sa = 0.f, sb = 0.f;
#pragma unroll
        for (int j = 0; j < 8; ++j) { sa += (va[j].x * va[j].x + va[j].y * va[j].y) + (va[j].z * va[j].z + va[j].w * va[j].w); u32x2 o; o.x = pk2(va[j].x, va[j].y); o.y = pk2(va[j].z, va[j].w); *(u32x2*)(XB + (size_t)row0 * D + 4 * lane + 256 * j) = o; }
        if (hasb) {
#pragma unroll
            for (int j = 0; j < 8; ++j) { sb += (vb[j].x * vb[j].x + vb[j].y * vb[j].y) + (vb[j].z * vb[j].z + vb[j].w * vb[j].w); u32x2 o; o.x = pk2(vb[j].x, vb[j].y); o.y = pk2(vb[j].z, vb[j].w); *(u32x2*)(XB + (size_t)rowb * D + 4 * lane + 256 * j) = o; } }
        sa = wave_sum(sa); sb = wave_sum(sb);
        if (lane == 0) { RSS[row0] = sa; if (hasb) RSS[rowb] = sb; }
      } }
    { float* ROPE = WSP(float, WS_ROPE);
      for (int i = blockIdx.x * 512 + F.tid; i < LS * 8; i += F.G * 512) {
        const int pos = i >> 3, j = i & 7;
        const float invf = (j == 0) ? 1.0f : (j == 1) ? 0.193922758102417f : (j == 2) ? 0.03760603070259094f : (j == 3) ? 0.00729266507551074f : (j == 4) ? 0.001414213445968926f
                         : (j == 5) ? 0.00027424818836152554f : (j == 6) ? 5.318296462064609e-05f : 1.0313385246263351e-05f;
        const float ang = (float)pos * invf; double sn, cs; sincos_d((double)ang, sn, cs);
        ROPE[pos * 16 + j] = (float)cs; ROPE[pos * 16 + 8 + j] = (float)sn;
      } }
}

__device__ __forceinline__ void st_bf16x8(bf16_t* p, const float (&v)[8]) { u32x4 w; w.x = pk2(v[0], v[1]); w.y = pk2(v[2], v[3]); w.z = pk2(v[4], v[5]); w.w = pk2(v[6], v[7]); *(u32x4*)p = w; }
__device__ __forceinline__ void st_f32x8(float* p, const float (&v)[8]) { *(f32x4*)p = (f32x4){v[0], v[1], v[2], v[3]}; *(f32x4*)(p + 4) = (f32x4){v[4], v[5], v[6], v[7]}; }

struct EpiIn {
    static constexpr bool PERM = true, AFTER_DRAIN = false;
    int l; unsigned char* ws; float* out;
    __device__ __forceinline__ void operator()(const f32x4 (&acc)[2][2][4][2], const pg8::Unit& u, int wr, int wc, int fr, int fq) const {
        const int grp = u.pn * 4 + wc;
        if (grp >= 102) return;
        const float* rss = (const float*)(ws + CTL_RSS) + (size_t)(2 * l) * M; const float* rope = (const float*)(ws + WS_ROPE); const float* gt = (const float*)(ws + WS_GT) + l * GT_STRIDE;
        int kind = 0, coff = 0, bstride = 0, fstride = 0; bool do_norm = false, do_rope = false, conv_tail = false; const float* gain = gt;
        bf16_t* bb = nullptr; float* fP = nullptr; float* fS = nullptr;
        int side = 0, sstride = 0; bf16_t* sP = nullptr; bf16_t* sS = nullptr;
        bool qscale = false;
        if (grp < 8) { kind = 0; bb = (bf16_t*)(ws + WS_AQ); bstride = 512; coff = grp * 64; do_norm = true; do_rope = true; gain = gt; qscale = true; }
        else if (grp < 10) { kind = 1; fP = out + O_PAK + (size_t)l * MP * 128; fS = out + O_SAK + (size_t)l * MS * 128; fstride = 128; coff = (grp - 8) * 64; do_norm = true; do_rope = true; gain = gt + 64;
            side = 1; sstride = 128; sP = (bf16_t*)(ws + WS_AKBP); sS = (bf16_t*)(ws + WS_AKBS) + (size_t)l * SB * LSP * 128; }
        else if (grp < 12) { kind = 1; fP = out + O_PAV + (size_t)l * MP * 128; fS = out + O_SAV + (size_t)l * MS * 128; fstride = 128; coff = (grp - 10) * 64; }
        else if (grp < 28) { kind = 0; bb = (bf16_t*)(ws + WS_IQ); bstride = 1024; coff = (grp - 12) * 64; do_rope = true; }
        else if (grp < 29) { kind = 1; fP = out + O_PIK + (size_t)l * MP * 64; fS = out + O_SIK + (size_t)l * MS * 64; fstride = 64; coff = 0; do_norm = true; do_rope = true; gain = gt + 128;
            side = 1; sstride = 64; sP = (bf16_t*)(ws + WS_IKBP); sS = (bf16_t*)(ws + WS_IKBS) + (size_t)l * SB * LSP * 64; }
        else if (grp < 37) { kind = 0; bb = (bf16_t*)(ws + WS_BQ); bstride = 512; coff = (grp - 29) * 64; do_norm = true; gain = gt + 192; }
        else if (grp < 45) { kind = 1; fP = out + O_PBK + (size_t)l * MP * 512; fS = out + O_SBK + (size_t)l * MS * 512; fstride = 512; coff = (grp - 37) * 64; do_norm = true; gain = gt + 256; }
        else if (grp < 53) { kind = 1; fP = out + O_PBV + (size_t)l * MP * 512; fS = out + O_SBV + (size_t)l * MS * 512; fstride = 512; coff = (grp - 45) * 64; }
        else if (grp < 69) { kind = 0; bb = (bf16_t*)(ws + WS_CZ); bstride = 1024; coff = (grp - 53) * 64; }
        else if (grp < 101) { kind = 0; bb = (bf16_t*)(ws + WS_CX); bstride = 2048; coff = (grp - 69) * 64; conv_tail = true; }
        else { kind = 2; }
        const int d0 = 8 * fq;
        float rsv[8];
#pragma unroll
        for (int q = 0; q < 8; ++q) rsv[q] = rss[u.pm * 256 + (q >> 2) * 128 + wr * 64 + (q & 3) * 16 + fr];
#pragma unroll
        for (int ai = 0; ai < 2; ++ai)
#pragma unroll
            for (int m = 0; m < 4; ++m) {
                const int r = u.pm * 256 + ai * 128 + wr * 64 + m * 16 + fr;
                const RowInfo ri = row_info(r);
                const float rs = FAST_RSQ(rsv[ai * 4 + m] * (1.0f / D) + EPSN);
                float v[2][8];
#pragma unroll
                for (int bj = 0; bj < 2; ++bj)
#pragma unroll
                    for (int n = 0; n < 2; ++n)
#pragma unroll
                        for (int e = 0; e < 4; ++e) v[bj][4 * n + e] = acc[ai][bj][m][n][e] * rs;
                if (do_norm) {
                    float ss = 0.f;
#pragma unroll
                    for (int bj = 0; bj < 2; ++bj)
#pragma unroll
                        for (int i = 0; i < 8; ++i) ss += v[bj][i] * v[bj][i];
                    ss += __shfl_xor(ss, 16); ss += __shfl_xor(ss, 32);
                    const float rn = FAST_RSQ(ss * (1.0f / 64.0f) + EPSN);
#pragma unroll
                    for (int bj = 0; bj < 2; ++bj) { const f32x4 g0 = *(const f32x4*)(gain + 32 * bj + d0), g1 = *(const f32x4*)(gain + 32 * bj + d0 + 4);
#pragma unroll
                        for (int e = 0; e < 4; ++e) { v[bj][e] = v[bj][e] * rn * g0[e]; v[bj][4 + e] = v[bj][4 + e] * rn * g1[e]; } }
                }
                if (do_rope) {
                    const float* rp = rope + (size_t)ri.pos * 16;
                    const f32x4 c0 = *(const f32x4*)rp, c1 = *(const f32x4*)(rp + 4), s0 = *(const f32x4*)(rp + 8), s1 = *(const f32x4*)(rp + 12);
                    const float sgn = (fq == 0) ? -1.f : 1.f;
#pragma unroll
                    for (int i = 0; i < 8; ++i) {
                        const float pv = __shfl_xor(v[0][i], 16);
                        const float c = (i < 4) ? c0[i & 3] : c1[i & 3], sn = (i < 4) ? s0[i & 3] : s1[i & 3];
                        if (fq < 2) v[0][i] = v[0][i] * c + sgn * pv * sn;
                    }
                }
                if (kind == 0) {
                    if (qscale) {
#pragma unroll
                        for (int bj = 0; bj < 2; ++bj)
#pragma unroll
                            for (int i = 0; i < 8; ++i) v[bj][i] *= 0.18033688011112042f; }
                    bf16_t* o = bb + (size_t)r * bstride + coff + d0; st_bf16x8(o, v[0]); st_bf16x8(o + 32, v[1]);
                    if (conv_tail) { const int Tg = ri.prompt ? T : ST;
                        if (ri.t >= Tg - 3) { float* of = (ri.prompt ? out + O_PCONV + ((size_t)(l * NB + ri.b) * 3 + (ri.t - (Tg - 3))) * 2048 : out + O_SCONV + ((size_t)(l * SB + ri.b) * 3 + (ri.t - (Tg - 3))) * 2048) + coff + d0;
                            st_f32x8(of, v[0]); st_f32x8(of + 32, v[1]); } }
                } else if (kind == 1) {
                    float* o = (ri.prompt ? fP : fS) + (size_t)ri.rg * fstride + coff + d0; st_f32x8(o, v[0]); st_f32x8(o + 32, v[1]);
                    if (side == 1) { bf16_t* o2 = (ri.prompt ? sP + (size_t)r * sstride : sS + ((size_t)ri.b * LSP + PAST + ri.t) * sstride) + coff + d0; st_bf16x8(o2, v[0]); st_bf16x8(o2 + 32, v[1]); }
                } else {
                    float w[8];
                    if (fq < 2) {
#pragma unroll
                        for (int i = 0; i < 8; ++i) w[i] = v[0][i] * 0.25f;
                        st_f32x8((float*)(ws + WS_IW) + (size_t)r * 16 + d0, w); }
                    else {
#pragma unroll
                        for (int i = 0; i < 8; ++i) w[i] = softplus_f(v[0][i] + gt[320 + (d0 - 16) + i]);
                        st_f32x8((float*)(ws + WS_DT) + (size_t)r * 16 + (d0 - 16), w); }
                }
                if (m & 1) EPI_FENCE();
            }
    }
};
struct EpiOut {
    static constexpr bool PERM = true, AFTER_DRAIN = false;
    float* X; unsigned char* ws; int l;
    __device__ __forceinline__ void operator()(const f32x4 (&acc)[2][2][4][2], const pg8::Unit& u, int wr, int wc, int fr, int fq) const {
        bf16_t* XB = (bf16_t*)(ws + WS_XB); float* rss = (float*)(ws + CTL_RSS) + (size_t)(2 * l + 1) * M;
        const float* const* PT = (const float* const*)(ws + WS_PT); const float* xp = GPT(IN_XP);
#pragma unroll
        for (int ai = 0; ai < 2; ++ai)
#pragma unroll
            for (int m = 0; m < 4; ++m) {
                const int r = u.pm * 256 + ai * 128 + wr * 64 + m * 16 + fr;
                const float* xr = (l == 0) ? xp + (size_t)r * D : X + (size_t)r * D;
                float ss = 0.f;
#pragma unroll
                for (int bj = 0; bj < 2; ++bj) {
                    const int c = u.pn * 256 + bj * 128 + wc * 32 + 8 * fq; float v[8];
                    const f32x4 a0 = *(const f32x4*)(xr + c), a1 = *(const f32x4*)(xr + c + 4);
#pragma unroll
                    for (int e = 0; e < 4; ++e) { v[e] = a0[e] + acc[ai][bj][m][0][e]; v[4 + e] = a1[e] + acc[ai][bj][m][1][e]; }
#pragma unroll
                    for (int i = 0; i < 8; ++i) ss += v[i] * v[i];
                    st_f32x8(X + (size_t)r * D + c, v); st_bf16x8(XB + (size_t)r * D + c, v);
                }
                ss += __shfl_xor(ss, 16); ss += __shfl_xor(ss, 32);
                if (fq == 0) atomicAdd(rss + r, ss);
                if (m & 1) EPI_FENCE();
            }
    }
};
struct EpiGU {
    static constexpr bool PERM = true, AFTER_DRAIN = false;
    unsigned char* ws; int l;
    __device__ __forceinline__ void operator()(const f32x4 (&acc)[2][2][4][2], const pg8::Unit& u, int wr, int wc, int fr, int fq) const {
        const float* rss = (const float*)(ws + CTL_RSS) + (size_t)(2 * l + 1) * M; bf16_t* H = (bf16_t*)(ws + WS_HMID);
        float rsv[8];
#pragma unroll
        for (int q = 0; q < 8; ++q) rsv[q] = rss[u.pm * 256 + (q >> 2) * 128 + wr * 64 + (q & 3) * 16 + fr];
#pragma unroll
        for (int ai = 0; ai < 2; ++ai)
#pragma unroll
            for (int m = 0; m < 4; ++m) {
                const int r = u.pm * 256 + ai * 128 + wr * 64 + m * 16 + fr;
                const float rs = FAST_RSQ(rsv[ai * 4 + m] * (1.0f / D) + EPSN);
                float v[8];
#pragma unroll
                for (int n = 0; n < 2; ++n)
#pragma unroll
                    for (int e = 0; e < 4; ++e) { const float g = acc[ai][0][m][n][e] * rs, up = acc[ai][1][m][n][e] * rs; v[4 * n + e] = silu_f(g) * up; }
                st_bf16x8(H + (size_t)r * DFF + u.pn * 128 + wc * 32 + 8 * fq, v);
                EPI_FENCE();
            }
    }
};
struct EpiDown {
    static constexpr bool PERM = true, AFTER_DRAIN = false;
    float* X; unsigned char* ws; int l;
    __device__ __forceinline__ void operator()(const f32x4 (&acc)[2][2][4][2], const pg8::Unit& u, int wr, int wc, int fr, int fq) const {
        bf16_t* XB = (bf16_t*)(ws + WS_XB); float* rss = (float*)(ws + CTL_RSS) + (size_t)(2 * l + 2) * M; const bool next = l + 1 < NL;
#pragma unroll
        for (int ai = 0; ai < 2; ++ai)
#pragma unroll
            for (int m = 0; m < 4; ++m) {
                const int r = u.pm * 256 + ai * 128 + wr * 64 + m * 16 + fr;
                float ss = 0.f;
#pragma unroll
                for (int bj = 0; bj < 2; ++bj) {
                    const int c = u.pn * 256 + bj * 128 + wc * 32 + 8 * fq; float v[8];
                    const f32x4 a0 = *(const f32x4*)(X + (size_t)r * D + c), a1 = *(const f32x4*)(X + (size_t)r * D + c + 4);
#pragma unroll
                    for (int e = 0; e < 4; ++e) { v[e] = a0[e] + acc[ai][bj][m][0][e]; v[4 + e] = a1[e] + acc[ai][bj][m][1][e]; }
#pragma unroll
                    for (int i = 0; i < 8; ++i) ss += v[i] * v[i];
                    st_f32x8(X + (size_t)r * D + c, v);
                    if (next) st_bf16x8(XB + (size_t)r * D + c, v);
                }
                if (next) { ss += __shfl_xor(ss, 16); ss += __shfl_xor(ss, 32); if (fq == 0) atomicAdd(rss + r, ss); }
                if (m & 1) EPI_FENCE();
            }
    }
};

struct EpiTail {
    static constexpr bool PERM = true, AFTER_DRAIN = false;
    float* P; int klen_bytes;
    __device__ __forceinline__ void operator()(const f32x4 (&acc)[2][2][4][2], const pg8::Unit& u, int wr, int wc, int fr, int fq) const {
        float* slab = P + (size_t)(u.kofs / klen_bytes) * MS * D;
#pragma unroll
        for (int ai = 0; ai < 2; ++ai)
#pragma unroll
            for (int m = 0; m < 4; ++m) {
                const int r = u.pm * 256 + ai * 128 + wr * 64 + m * 16 + fr - MP;
#pragma unroll
                for (int bj = 0; bj < 2; ++bj) { float* xo = slab + (size_t)r * D + u.pn * 256 + bj * 128 + wc * 32 + 8 * fq; *(f32x4*)xo = acc[ai][bj][m][0]; *(f32x4*)(xo + 4) = acc[ai][bj][m][1]; }
                EPI_FENCE();
            }
    }
};
__device__ __forceinline__ void phase_fin(const Frame& F, int idx, int nsl, bool next) {
    PHASE_BASES();
    float* X = outp + O_Y; bf16_t* XB = WSP(bf16_t, WS_XB); float* RSS = WSP(float, CTL_RSS) + (size_t)idx * M; const float* P = WSP(float, WS_PART);
    for (int row = MP + F.gw; row < M; row += F.NGW) {
        float ss = 0.f;
#pragma unroll
        for (int j = 0; j < 8; ++j) { const size_t o = (size_t)row * D + 4 * lane + 256 * j; f32x4 v = *(const f32x4*)(X + o);
            for (int sl = 0; sl < nsl; ++sl) v += *(const f32x4*)(P + ((size_t)sl * MS + (row - MP)) * D + 4 * lane + 256 * j);
            *(f32x4*)(X + o) = v; ss += (v.x * v.x + v.y * v.y) + (v.z * v.z + v.w * v.w);
            if (next) { u32x2 w; w.x = pk2(v.x, v.y); w.y = pk2(v.z, v.w); *(u32x2*)(XB + o) = w; } }
        ss = wave_sum(ss);
        if (next && lane == 0) RSS[row] = ss;
    }
}

constexpr int CC_NAV = SB * (PAST / 64) * 2 / 8, CC_NAK = SB * PAST * 16 / 4096, CC_N = CC_NAV + CC_NAK;
static_assert((SB * (PAST / 64) * 2) % 8 == 0 && (SB * PAST * 16) % 4096 == 0, "cache conversion items");
__device__ __forceinline__ void cache_conv_item(const Frame& F, int l, int ci, unsigned char* ws, const float* cak, const float* cav, int tidl, int lane) {
    if (ci < CC_NAV) {
        bf16_t* AVTS = WSP(bf16_t, WS_AVTS); LAS bf16_t* tile = (LAS bf16_t*)(F.lds + F.wave * 16384);
        const int it = l * (SB * (PAST / 64) * 2) + ci * 8 + F.wave;
        const int tc = it & 1, tr = (it >> 1) % (PAST / 64), lb = (it >> 1) / (PAST / 64); const int g8 = lane & 7;
#pragma unroll 2
        for (int ps = 0; ps < 8; ++ps) { const int rl = ps * 8 + (lane >> 3); const float* sp = cav + ((size_t)lb * PAST + tr * 64 + rl) * 128 + tc * 64 + 8 * g8;
            const f32x4 a = *(const f32x4*)sp, b4 = *(const f32x4*)(sp + 4); u32x4 w; w.x = pk2(a.x, a.y); w.y = pk2(a.z, a.w); w.z = pk2(b4.x, b4.y); w.w = pk2(b4.z, b4.w);
            *(LAS u32x4*)(tile + rl * 72 + 8 * g8) = w; }
        WAVE_SYNC();
#pragma unroll 2
        for (int rg = 0; rg < 8; ++rg) { unsigned short h[8];
#pragma unroll
            for (int k = 0; k < 8; ++k) h[k] = tile[(8 * rg + k) * 72 + lane];
            u32x4 w; w.x = h[0] | ((unsigned)h[1] << 16); w.y = h[2] | ((unsigned)h[3] << 16); w.z = h[4] | ((unsigned)h[5] << 16); w.w = h[6] | ((unsigned)h[7] << 16);
            *(u32x4*)(AVTS + ((size_t)lb * 128 + tc * 64 + lane) * LSP + tr * 64 + 8 * rg) = w; }
        WAVE_SYNC();
    } else {
        bf16_t* AKBS = WSP(bf16_t, WS_AKBS); const size_t base = (size_t)l * SB * PAST * 16 + (size_t)(ci - CC_NAV) * 4096 + tidl;
#pragma unroll 4
        for (int k = 0; k < 8; ++k) { const size_t i = base + (size_t)k * 512; const size_t rowi = i >> 4; const int c8 = (int)(i & 15) * 8; const size_t lb = rowi / PAST; const int sidx = (int)(rowi - lb * PAST);
            const f32x4 a = *(const f32x4*)(cak + rowi * 128 + c8), b4 = *(const f32x4*)(cak + rowi * 128 + c8 + 4);
            u32x4 w; w.x = pk2(a.x, a.y); w.y = pk2(a.z, a.w); w.z = pk2(b4.x, b4.y); w.w = pk2(b4.z, b4.w); *(u32x4*)(AKBS + (lb * LSP + sidx) * 128 + c8) = w; }
    }
}
__device__ __forceinline__ void phase_a1(const Frame& F, int l, int qs = 0) {
    PHASE_BASES();
    const bf16_t* IQ = WSP(bf16_t, WS_IQ); const float* IW = WSP(float, WS_IW); unsigned* MASK = WSP(unsigned, WS_MASK);
    unsigned* qhead = (unsigned*)(ws + CTL_QUEUE) + (l * 8 + 0 + qs) * 64;
    volatile LAS int* qslot = (volatile LAS int*)(F.lds + MISC_OFF + 64);
    LAS float* iwt = (LAS float*)(F.lds + A1_TILE_OFF);
    LAS unsigned* cand_list = (LAS unsigned*)(F.lds + A1_TILE_OFF + 1024) + F.wave * 64;
    const int r32 = lane & 31, hh = lane >> 5, wave = F.wave;
    constexpr int NUS = MS / 8, NUP = MP / 8, NUNITS = NUS + NUP;
    unsigned* chead = (unsigned*)(ws + CTL_QUEUE) + (l * 8 + 6) * 64;
    const float* cc_ak = GPT(IN_CAK); const float* cc_av = GPT(IN_CAV);
    bool cc_left = (qs == 0), a1_left = true; int iter = (int)blockIdx.x;
    for (;;) {
        __syncthreads();
        if (tidl == 0) { qslot[0] = a1_left ? (int)atomicAdd(qhead, 1u) : NUNITS; const bool t = cc_left && (!a1_left || (iter & 1) == 0); qslot[1] = t ? (int)atomicAdd(chead, 1u) : -1; }
        __syncthreads();
        const int u = qslot[0], ci = qslot[1]; ++iter;
        if (ci >= CC_N) cc_left = false;
        a1_left = u < NUNITS;
        if (ci >= 0 && ci < CC_N) { cache_conv_item(F, l, ci, ws, cc_ak, cc_av, tidl, lane); __syncthreads(); }
        if (!a1_left) { if (!cc_left) break; continue; }
        bool prompt; int b, row0, L, Ktop;
        if (u < NUS) { prompt = false; b = (u * 8) / ST; row0 = MP + u * 8; L = LS; Ktop = KTOP_S; }
        else { const int k = u - NUS, c = NC - 1 - k / (NB * 8), j = k % (NB * 8); prompt = true; b = j >> 3; row0 = b * T + 64 * c + 8 * (j & 7); L = 64 * (c + 1); Ktop = KTOP_P; }
        const int nb32 = (L + 31) / 32;
        if (tidl < 128) iwt[tidl] = IW[(size_t)row0 * 16 + tidl] * 0.125f;
        bf16x8 af[4][4];
#pragma unroll
        for (int rb = 0; rb < 4; ++rb) { const bf16_t* ap = IQ + (size_t)(row0 + 2 * rb + ((r32 >> 2) & 1)) * 1024 + ((r32 & 3) + 4 * (r32 >> 3)) * 64 + 8 * hh;
#pragma unroll
            for (int ks = 0; ks < 4; ++ks) af[rb][ks] = *(const bf16x8*)(ap + 16 * ks); }
        __syncthreads();
        const bf16_t* ikb = (prompt ? WSP(bf16_t, WS_IKBP) + (size_t)b * T * 64 : WSP(bf16_t, WS_IKBS) + ((size_t)l * SB + b) * LSP * 64) + (size_t)r32 * 64 + 8 * hh;
        bf16x8 ring[4][4];
#define A1_LOAD_B(dst, kb_) do { const bf16_t* kp_ = ikb + (size_t)(kb_) * 32 * 64; _Pragma("unroll") for (int ks_ = 0; ks_ < 4; ++ks_) dst[ks_] = *(const bf16x8*)(kp_ + 16 * ks_); } while (0)
#pragma unroll
        for (int j = 0; j < 4; ++j) { const int kl = wave + 8 * j; A1_LOAD_B(ring[j], kl < nb32 ? kl : nb32 - 1); }
#pragma unroll 1
        for (int kb0 = wave; kb0 < nb32; kb0 += 32) {
#pragma unroll
            for (int j = 0; j < 4; ++j) {
                const int kb = kb0 + 8 * j;
                if (kb < nb32) {
                    const int s = 32 * kb + r32; const bool kvalid = s < L;
#pragma unroll
                    for (int rb = 0; rb < 4; ++rb) {
                        f32x16 acc;
#pragma unroll
                        for (int i = 0; i < 16; ++i) acc[i] = 0.f;
#pragma unroll
                        for (int ks = 0; ks < 4; ++ks) acc = MFMA32(af[rb][ks], ring[j][ks], acc);
                        float score = 0.f;
#pragma unroll
                        for (int q = 0; q < 4; ++q) { const f32x4 w4 = *(const LAS f32x4*)(iwt + (2 * rb + hh) * 16 + 4 * q);
                            score += w4.x * fmaxf(acc[4 * q], 0.f) + w4.y * fmaxf(acc[4 * q + 1], 0.f) + w4.z * fmaxf(acc[4 * q + 2], 0.f) + w4.w * fmaxf(acc[4 * q + 3], 0.f); }
                        *(LAS unsigned*)(F.lds + (2 * rb + hh) * A1_WAVE_BYTES + (size_t)s * 4) = kvalid ? sortable_key(score) : 0u;
                    }
                }
                { const int kl = kb + 32; A1_LOAD_B(ring[j], kl < nb32 ? kl : nb32 - 1); }
            }
        }
        __syncthreads();
        const LAS unsigned* sc = (const LAS unsigned*)(F.lds + wave * A1_WAVE_BYTES);
        const int nt = (nb32 + 1) / 2, row = row0 + wave;
        if (2 * nt > nb32 && lane >= 32) ((LAS unsigned*)sc)[32 * nb32 + (lane - 32)] = 0u;
        WAVE_SYNC();
        const int n4 = nt / 4, nrem = nt - 4 * n4;
        constexpr int G4MAX = LPAD / 256;
        u32x4 kq[G4MAX]; unsigned kr_[3];
#pragma unroll
        for (int g = 0; g < G4MAX; ++g) kq[g] = (g < n4) ? *(const LAS u32x4*)(sc + 256 * g + 4 * lane) : (u32x4){0u, 0u, 0u, 0u};
#pragma unroll
        for (int r = 0; r < 3; ++r) kr_[r] = (r < nrem) ? sc[256 * n4 + 64 * r + lane] : 0u;
        unsigned tau = 1u;
        if (L > Ktop) {
            tau = 0u; int c_lo = 64 * nt, c_hi = 0, bit = 31; bool found = false;
            while (bit >= 0 && c_lo - c_hi > 64) {
                const unsigned cand = tau | (1u << bit); int cnt = 0;
#pragma unroll
                for (int g = 0; g < G4MAX; ++g) if (g < n4) cnt += __popcll(__ballot(kq[g].x >= cand)) + __popcll(__ballot(kq[g].y >= cand)) + __popcll(__ballot(kq[g].z >= cand)) + __popcll(__ballot(kq[g].w >= cand));
#pragma unroll
                for (int r = 0; r < 3; ++r) if (r < nrem) cnt += __popcll(__ballot(kr_[r] >= cand));
                if (cnt >= Ktop) { tau = cand; c_lo = cnt; } else c_hi = cnt;
                --bit;
                if (cnt == Ktop) { found = true; break; }
            }
            if (!found && bit >= 0) {
                const bool whole = (bit == 31); const unsigned hi_excl = whole ? 0u : tau + (2u << bit);
                int nb = 0;
#define A1_COMPACT(kval) do { const unsigned k_ = (kval); const bool in_ = (k_ >= tau) && (whole || k_ < hi_excl); const unsigned long long bal_ = __ballot(in_); \
                    if (in_) cand_list[nb + __popcll(bal_ & ((1ull << lane) - 1ull))] = k_; nb += __popcll(bal_); } while (0)
#pragma unroll
                for (int g = 0; g < G4MAX; ++g) if (g < n4) { A1_COMPACT(kq[g].x); A1_COMPACT(kq[g].y); A1_COMPACT(kq[g].z); A1_COMPACT(kq[g].w); }
#pragma unroll
                for (int r = 0; r < 3; ++r) if (r < nrem) A1_COMPACT(kr_[r]);
                WAVE_SYNC();
                const unsigned mine = (lane < nb) ? cand_list[lane] : 0u;
                for (; bit >= 0; --bit) {
                    const unsigned cand = tau | (1u << bit);
                    const int cnt = c_hi + __popcll(__ballot((lane < nb) && mine >= cand));
                    if (cnt >= Ktop) tau = cand;
                    if (cnt == Ktop) break;
                }
            }
            if (tau == 0u) tau = 1u;
        }
        unsigned* mrow = MASK + (size_t)row * MASK_W;
#pragma unroll
        for (int g = 0; g < G4MAX; ++g) if (g < n4) {
            unsigned nib = ((kq[g].x >= tau && kq[g].x != 0u) ? 1u : 0u) | ((kq[g].y >= tau && kq[g].y != 0u) ? 2u : 0u) | ((kq[g].z >= tau && kq[g].z != 0u) ? 4u : 0u) | ((kq[g].w >= tau && kq[g].w != 0u) ? 8u : 0u);
            unsigned wv = nib << (4 * (lane & 7));
            wv |= __shfl_xor(wv, 1); wv |= __shfl_xor(wv, 2); wv |= __shfl_xor(wv, 4);
            if ((lane & 7) == 0) mrow[8 * g + (lane >> 3)] = wv;
        }
#pragma unroll
        for (int r = 0; r < 3; ++r) if (r < nrem) {
            const unsigned long long bal = __ballot(kr_[r] >= tau && kr_[r] != 0u);
            if (lane == 0) { mrow[8 * n4 + 2 * r] = (unsigned)bal; mrow[8 * n4 + 2 * r + 1] = (unsigned)(bal >> 32); }
        }
    }
}
constexpr int A2_KP = 272, A2_VP = 136, A2_KT = 64 * A2_KP, A2_VT = 128 * A2_VP, A2_BUF = A2_KT + A2_VT;
static_assert(2 * A2_BUF <= LDS_PHASE_BYTES, "A2 LDS");
__device__ __forceinline__ void phase_a2(const Frame& F, int l, int qs = 0) {
    PHASE_BASES();
    const bf16_t* AQ = WSP(bf16_t, WS_AQ); const unsigned* MASK = WSP(unsigned, WS_MASK); bf16_t* MIX = WSP(bf16_t, WS_MIX);
    const float* kp_p = outp + O_PAK; const float* kp_s = outp + O_SAK; const float* kp_c = GPT(IN_CAK);
    const float* vp_p = outp + O_PAV; const float* vp_s = outp + O_SAV; const float* vp_c = GPT(IN_CAV);
    unsigned* qbase = (unsigned*)(ws + CTL_QUEUE2) + (size_t)(l * 8) * 64; (void)qs;
    volatile LAS int* qslot = (volatile LAS int*)(F.lds + MISC_OFF + 96);
    const int r32 = lane & 31, hh = lane >> 5, wave = F.wave, kvh = wave >> 2, qsub = wave & 3, qq = r32 & 15;
    constexpr int NUS = SB, NUP = NB * NC, NUNITS = NUS + NUP; (void)NUNITS; (void)NUP;
#ifdef HOST_EMU
    const int home = (int)(blockIdx.x % NB);
#else
    const int home = (int)(xb_xcc_id() % (unsigned)NB);
#endif
    int qstage = 0;
    const int kkey = tidl >> 3, kd = 16 * (tidl & 7), vkp = 2 * (tidl & 31), vd = 8 * (tidl >> 5);
    for (;;) {
        __syncthreads();
        if (tidl == 0) {
            int uu = -1;
            while (qstage <= NB) {
                const int qi = qstage == 0 ? NB : (home + qstage - 1) % NB;
                const int v = (int)atomicAdd(qbase + qi * 64, 1u);
                if (v < (qstage == 0 ? NUS : NC)) { uu = qstage == 0 ? v : NUS + v * NB + qi; break; }
                ++qstage;
            }
            qslot[0] = uu;
        }
        __syncthreads();
        const int u = qslot[0];
        if (u < 0) break;
        bool prompt; int b, row0, L, nq;
        if (u < NUS) { prompt = false; b = u; row0 = MP + u * ST; L = LS; nq = ST; }
        else { const int k = u - NUS, c = NC - 1 - k / NB; prompt = true; b = k % NB; row0 = b * T + 64 * c; L = 64 * (c + 1); nq = 64; }
        const int nt = (L + 63) / 64; const bool active = 16 * qsub < nq;
        const int qrow = row0 + (active ? 16 * qsub + qq : 0);
        bf16x8 qf[2][4];
#pragma unroll
        for (int cb = 0; cb < 2; ++cb)
#pragma unroll
            for (int ks = 0; ks < 4; ++ks) qf[cb][ks] = *(const bf16x8*)(AQ + (size_t)qrow * 512 + (kvh * 4 + 2 * cb + (r32 >> 4)) * 64 + 16 * ks + 8 * hh);
        f32x16 o[2][2]; float mrun[2] = {-1.0e30f, -1.0e30f}, lrun[2] = {0.f, 0.f};
#pragma unroll
        for (int db = 0; db < 2; ++db)
#pragma unroll
            for (int cb = 0; cb < 2; ++cb)
#pragma unroll
                for (int i = 0; i < 16; ++i) o[db][cb][i] = 0.f;
        const bf16_t* akb_base = prompt ? WSP(bf16_t, WS_AKBP) + (size_t)b * T * 128 : WSP(bf16_t, WS_AKBS) + ((size_t)l * SB + b) * LSP * 128;
        const bf16_t* avt_base = prompt ? WSP(bf16_t, WS_AVTP) + (size_t)b * 128 * T : WSP(bf16_t, WS_AVTS) + ((size_t)l * SB + b) * 128 * LSP; const size_t avt_pitch = prompt ? (size_t)T : (size_t)LSP;
        u32x4 kA[2], vA[2], kB[2], vB[2];
#define A2_LOAD_TT(K_, V_, t_) do { const bf16_t* kp_ = akb_base + (size_t)(64 * (t_) + kkey) * 128 + kd; K_[0] = *(const u32x4*)kp_; K_[1] = *(const u32x4*)(kp_ + 8); \
            const bf16_t* vp_ = avt_base + (size_t)(tidl >> 2) * avt_pitch + 64 * (t_) + 16 * (tidl & 3); V_[0] = *(const u32x4*)vp_; V_[1] = *(const u32x4*)(vp_ + 8); } while (0)
#define A2_STORE_TT(K_, V_, buf_) do { LAS unsigned char* kb_ = F.lds + (buf_) * A2_BUF + kkey * A2_KP + kd * 2; *(LAS u32x4*)kb_ = K_[0]; *(LAS u32x4*)(kb_ + 16) = K_[1]; \
            LAS unsigned char* vb_ = F.lds + (buf_) * A2_BUF + A2_KT + (tidl >> 2) * A2_VP + 32 * (tidl & 3); \
            *(LAS u32x2*)(vb_) = (u32x2){V_[0].x, V_[0].y}; *(LAS u32x2*)(vb_ + 8) = (u32x2){V_[0].z, V_[0].w}; *(LAS u32x2*)(vb_ + 16) = (u32x2){V_[1].x, V_[1].y}; *(LAS u32x2*)(vb_ + 24) = (u32x2){V_[1].z, V_[1].w}; } while (0)
#define A2_COMPUTE(BUF_) do { \
            if (active) { \
                const LAS unsigned char* kt = F.lds + (BUF_) * A2_BUF; const LAS unsigned char* vt = kt + A2_KT; \
                _Pragma("unroll") \
                for (int kblk = 0; kblk < 2; ++kblk) { \
                    f32x16 sacc[2]; \
                _Pragma("unroll") \
                    for (int cb = 0; cb < 2; ++cb) \
                _Pragma("unroll") \
                        for (int i = 0; i < 16; ++i) sacc[cb][i] = 0.f; \
                _Pragma("unroll") \
                    for (int ks = 0; ks < 4; ++ks) { const bf16x8 kf = *(const LAS bf16x8*)(kt + (32 * kblk + r32) * A2_KP + (kvh * 64 + 16 * ks + 8 * hh) * 2); \
                        sacc[0] = MFMA32(kf, qf[0][ks], sacc[0]); sacc[1] = MFMA32(kf, qf[1][ks], sacc[1]); } \
                    const unsigned mw = kblk ? mcur1 : mcur0; \
                    bf16x8 pf[2][2]; \
                _Pragma("unroll") \
                    for (int cb = 0; cb < 2; ++cb) { \
                        float sv[16]; float bm = -1.0e30f; const unsigned mwh = mw >> (4 * hh); \
                _Pragma("unroll") \
                        for (int i = 0; i < 16; ++i) { const bool on = (mwh & (1u << ((i & 3) + 8 * (i >> 2)))) != 0u; sv[i] = on ? sacc[cb][i] : -1.0e30f; bm = fmaxf(bm, sv[i]); } \
                        bm = fmaxf(bm, __shfl_xor(bm, 32)); \
                          \
                        if (__any(bm - mrun[cb] > 8.0f)) { \
                            const float mnew = fmaxf(mrun[cb], bm); \
                            const float alpha = FAST_EXP2(mrun[cb] - mnew); \
                            lrun[cb] *= alpha; mrun[cb] = mnew; \
                _Pragma("unroll") \
                            for (int db = 0; db < 2; ++db) \
                _Pragma("unroll") \
                                for (int i = 0; i < 16; ++i) o[db][cb][i] *= alpha; \
                        } \
                        const float mref = mrun[cb]; \
                        float ps = 0.f; float pv[16]; \
                _Pragma("unroll") \
                        for (int i = 0; i < 16; ++i) { pv[i] = FAST_EXP2(sv[i] - mref); ps += pv[i]; } \
                        if (mref < -1.0e29f) { \
                _Pragma("unroll") \
                            for (int i = 0; i < 16; ++i) pv[i] = 0.f; \
                            ps = 0.f; } \
                        ps += __shfl_xor(ps, 32); \
                        lrun[cb] += ps; \
                _Pragma("unroll") \
                        for (int ks2 = 0; ks2 < 2; ++ks2) { float t8[8]; \
                _Pragma("unroll") \
                            for (int j = 0; j < 8; ++j) t8[j] = pv[8 * ks2 + j]; \
                            pf[cb][ks2] = pack_bf16x8(t8); } \
                    } \
                _Pragma("unroll") \
                    for (int db = 0; db < 2; ++db) \
                _Pragma("unroll") \
                        for (int ks2 = 0; ks2 < 2; ++ks2) { \
                            const LAS unsigned char* vp = vt + (kvh * 64 + 32 * db + r32) * A2_VP + (32 * kblk + 16 * ks2 + 4 * hh) * 2; \
                            const u32x2 v0 = *(const LAS u32x2*)vp, v1 = *(const LAS u32x2*)(vp + 16); \
                            const bf16x8 vf = __builtin_bit_cast(bf16x8, ((u32x4){v0.x, v0.y, v1.x, v1.y})); \
                            o[db][0] = MFMA32(vf, pf[0][ks2], o[db][0]); o[db][1] = MFMA32(vf, pf[1][ks2], o[db][1]); \
                        } \
                } \
            } \
            } while (0)
        A2_LOAD_TT(kA, vA, 0); A2_STORE_TT(kA, vA, 0);
        A2_LOAD_TT(kB, vB, (nt > 1 ? 1 : 0));
        const unsigned* mrow = MASK + (size_t)qrow * MASK_W;
        unsigned mcur0 = mrow[0], mcur1 = mrow[1], mnx0 = 0u, mnx1 = 0u;
        __syncthreads();
#pragma unroll 1
        for (int t = 0; t < nt; t += 2) {
            A2_LOAD_TT(kA, vA, (t + 2 < nt ? t + 2 : nt - 1));
            { const int tm = (t + 1 < nt) ? t + 1 : nt - 1; mnx0 = mrow[2 * tm]; mnx1 = mrow[2 * tm + 1]; }
            A2_COMPUTE(0);
            if (t + 1 < nt) A2_STORE_TT(kB, vB, 1);
            mcur0 = mnx0; mcur1 = mnx1;
            __syncthreads();
            if (t + 1 >= nt) break;
            A2_LOAD_TT(kB, vB, (t + 3 < nt ? t + 3 : nt - 1));
            { const int tm = (t + 2 < nt) ? t + 2 : nt - 1; mnx0 = mrow[2 * tm]; mnx1 = mrow[2 * tm + 1]; }
            A2_COMPUTE(1);
            if (t + 2 < nt) A2_STORE_TT(kA, vA, 0);
            mcur0 = mnx0; mcur1 = mnx1;
            __syncthreads();
        }
        if (active) {
#pragma unroll
            for (int cb = 0; cb < 2; ++cb) { const float inv = 1.0f / lrun[cb];
#pragma unroll
                for (int db = 0; db < 2; ++db)
#pragma unroll
                    for (int g = 0; g < 4; ++g) { u32x2 w; w.x = pk2(o[db][cb][4 * g] * inv, o[db][cb][4 * g + 1] * inv); w.y = pk2(o[db][cb][4 * g + 2] * inv, o[db][cb][4 * g + 3] * inv);
                        *(u32x2*)(MIX + (size_t)qrow * 2048 + (kvh * 4 + 2 * cb + (r32 >> 4)) * 64 + 32 * db + 8 * g + 4 * hh) = w; } }
        }
    }
}
__device__ __forceinline__ void phase_b(const Frame& F, int l) {
    PHASE_BASES();
    const bf16_t* BQ = WSP(bf16_t, WS_BQ); bf16_t* MIX = WSP(bf16_t, WS_MIX);
    const float* kp_p = outp + O_PBK; const float* kp_s = outp + O_SBK; const float* kp_c = GPT(IN_CBK);
    const float* vp_p = outp + O_PBV; const float* vp_s = outp + O_SBV; const float* vp_c = GPT(IN_CBV);
    const int r32 = lane & 31, hh = lane >> 5;
    constexpr int NUP = NB * (T / 32) * 8, NUS = SB * 8;
    for (int unit = F.gw; unit < NUP + NUS; unit += F.NGW) {
        const bool prompt = unit < NUP; const int uu = prompt ? unit : unit - NUP; const int h = uu & 7; int b, row0, qbase;
        if (prompt) { const int qb = (uu >> 3) % (T / 32); b = (uu >> 3) / (T / 32); row0 = b * T + 32 * qb; qbase = 32 * qb; } else { b = uu >> 3; row0 = MP + b * ST; qbase = PAST; }
        const int nk = prompt ? T : LS;
        bf16x8 qf[4];
#pragma unroll
        for (int ks = 0; ks < 4; ++ks) qf[ks] = *(const bf16x8*)(BQ + (size_t)(row0 + r32) * 512 + h * 64 + 16 * ks + 8 * hh);
        f32x16 o[2];
#pragma unroll
        for (int db = 0; db < 2; ++db)
#pragma unroll
            for (int i = 0; i < 16; ++i) o[db][i] = 0.f;
        float R = 0.f; const int qpos = qbase + r32;
        f32x4 kraw[8];
#define B_LOAD_K(kb_) do { const int s_ = 32 * (kb_) + r32; const float* kp_ = kv_row<512>(kp_p, kp_s, kp_c, l, prompt, b, (s_ < nk) ? s_ : 0) + h * 64 + 8 * hh; \
            _Pragma("unroll") for (int ks_ = 0; ks_ < 4; ++ks_) { kraw[2 * ks_] = *(const f32x4*)(kp_ + 16 * ks_); kraw[2 * ks_ + 1] = *(const f32x4*)(kp_ + 16 * ks_ + 4); } } while (0)
        B_LOAD_K((qbase + 31) / 32);
        for (int kb = (qbase + 31) / 32; kb >= 0; --kb) {
            f32x16 sacc;
#pragma unroll
            for (int i = 0; i < 16; ++i) sacc[i] = 0.f;
            { const bool kvalid = 32 * kb + r32 < nk;
#pragma unroll
              for (int ks = 0; ks < 4; ++ks) { f32x4 k0 = kraw[2 * ks], k1 = kraw[2 * ks + 1];
                  if (!kvalid) { k0 = (f32x4){0.f, 0.f, 0.f, 0.f}; k1 = k0; }
                  float kv[8] = {k0.x, k0.y, k0.z, k0.w, k1.x, k1.y, k1.z, k1.w};
                  sacc = MFMA32(pack_bf16x8(kv), qf[ks], sacc); } }
            B_LOAD_K(kb > 0 ? kb - 1 : 0);
            float vv[2][2][8];
#pragma unroll
            for (int ks2 = 0; ks2 < 2; ++ks2)
#pragma unroll
                for (int db = 0; db < 2; ++db)
#pragma unroll
                    for (int j = 0; j < 8; ++j) { const int s = 32 * kb + 16 * ks2 + 8 * (j >> 2) + 4 * hh + (j & 3); vv[ks2][db][j] = (s < nk) ? kv_row<512>(vp_p, vp_s, vp_c, l, prompt, b, s)[h * 64 + 32 * db + r32] : 0.f; }
            float lk[16], zz[16];
#pragma unroll
            for (int i = 0; i < 16; ++i) { const int kpos = 32 * kb + (i & 3) + 8 * (i >> 2) + 4 * hh; const float z = sacc[i] * 0.125f; zz[i] = z; lk[i] = (kpos < qpos) ? -softplus_f(z) : 0.f; }
            float G[4], Go[4];
#pragma unroll
            for (int g = 0; g < 4; ++g) { G[g] = (lk[4 * g] + lk[4 * g + 1]) + (lk[4 * g + 2] + lk[4 * g + 3]); Go[g] = __shfl_xor(G[g], 32); }
            float a[16]; float tail = 0.f;
#pragma unroll
            for (int g = 3; g >= 0; --g) {
                const float tg = tail + (hh == 0 ? Go[g] : 0.f);
                const float s3 = 0.f, s2 = lk[4 * g + 3], s1 = s2 + lk[4 * g + 2], s0 = s1 + lk[4 * g + 1];
                const float sf[4] = {s0, s1, s2, s3};
#pragma unroll
                for (int e = 0; e < 4; ++e) { const int i = 4 * g + e; const int kpos = 32 * kb + e + 8 * g + 4 * hh; a[i] = (kpos < qpos) ? exp_f(zz[i] + lk[i] + R + tg + sf[e]) : 0.f; }
                tail += G[g] + Go[g];
            }
            R += tail;
#pragma unroll
            for (int ks2 = 0; ks2 < 2; ++ks2) {
                float pv[8];
#pragma unroll
                for (int j = 0; j < 8; ++j) pv[j] = a[8 * ks2 + j];
                const bf16x8 pf = pack_bf16x8(pv);
#pragma unroll
                for (int db = 0; db < 2; ++db) o[db] = MFMA32(pack_bf16x8(vv[ks2][db]), pf, o[db]);
            }
            if (__all(R < -40.f)) break;
        }
#pragma unroll
        for (int db = 0; db < 2; ++db)
#pragma unroll
            for (int g = 0; g < 4; ++g) { u32x2 w; w.x = pk2(o[db][4 * g], o[db][4 * g + 1]); w.y = pk2(o[db][4 * g + 2], o[db][4 * g + 3]);
                *(u32x2*)(MIX + (size_t)(row0 + r32) * 2048 + 512 + h * 64 + 32 * db + 8 * g + 4 * hh) = w; }
    }
}
__device__ __forceinline__ void phase_conv(const Frame& F, int l) {
    PHASE_BASES();
    const float* cw = GPT(IN_CONVW) + (size_t)l * 4 * 2048; const float* cb = GPT(IN_CONVB) + (size_t)l * 2048; const float* sconv = GPT(IN_SCONV);
    const bf16_t* CX = WSP(bf16_t, WS_CX); bf16_t* XC = WSP(bf16_t, WS_XC); bf16_t* XCT = WSP(bf16_t, WS_XCT);
    LAS bf16_t* tile = (LAS bf16_t*)(F.lds + F.wave * A1_WAVE_BYTES);
    constexpr int NTILE = (M / 64) * 32, NVT = (M / 64) * 2;
    { bf16_t* AVTP = WSP(bf16_t, WS_AVTP); bf16_t* AVTS = WSP(bf16_t, WS_AVTS) + (size_t)l * SB * 128 * LSP; const float* avp = outp + O_PAV + (size_t)l * MP * 128; const float* avs = outp + O_SAV + (size_t)l * MS * 128;
      for (int it = F.gw; it < NVT; it += F.NGW) {
          const int tc = it & 1, tr = it >> 1, rbase = tr * 64, g8 = lane & 7; const bool pr = rbase < MP;
#pragma unroll 2
          for (int ps = 0; ps < 8; ++ps) { const int rl = ps * 8 + (lane >> 3), row = rbase + rl; const float* sp = (pr ? avp + (size_t)row * 128 : avs + (size_t)(row - MP) * 128) + tc * 64 + 8 * g8;
              const f32x4 a = *(const f32x4*)sp, b4 = *(const f32x4*)(sp + 4); u32x4 w; w.x = pk2(a.x, a.y); w.y = pk2(a.z, a.w); w.z = pk2(b4.x, b4.y); w.w = pk2(b4.z, b4.w);
              *(LAS u32x4*)(tile + rl * 72 + 8 * g8) = w; }
          WAVE_SYNC();
#pragma unroll 2
          for (int rg = 0; rg < 8; ++rg) { unsigned short h[8];
#pragma unroll
              for (int k = 0; k < 8; ++k) h[k] = tile[(8 * rg + k) * 72 + lane];
              u32x4 w; w.x = h[0] | ((unsigned)h[1] << 16); w.y = h[2] | ((unsigned)h[3] << 16); w.z = h[4] | ((unsigned)h[5] << 16); w.w = h[6] | ((unsigned)h[7] << 16);
              const int row = rbase + 8 * rg;
              bf16_t* dst = pr ? AVTP + ((size_t)(row / T) * 128 + tc * 64 + lane) * T + (row % T) : AVTS + ((size_t)((row - MP) / ST) * 128 + tc * 64 + lane) * LSP + PAST + ((row - MP) % ST);
              *(u32x4*)dst = w; }
          WAVE_SYNC();
      } }
    for (int it = F.gw; it < NTILE; it += F.NGW) {
        const int tr = it >> 5, tc = it & 31, rbase = tr * 64, cbase = tc * 64;
        const int g8 = lane & 7, c0 = cbase + 8 * g8;
        float wj[4][8], bs[8];
#pragma unroll
        for (int e = 0; e < 8; ++e) bs[e] = cb[c0 + e];
#pragma unroll
        for (int j = 0; j < 4; ++j)
#pragma unroll
            for (int e = 0; e < 8; ++e) wj[j][e] = cw[j * 2048 + c0 + e];
#pragma unroll 4
        for (int ps = 0; ps < 8; ++ps) {
            const int rl = ps * 8 + (lane >> 3), row = rbase + rl; const RowInfo ri = row_info(row);
            float a[8];
#pragma unroll
            for (int e = 0; e < 8; ++e) a[e] = bs[e];
#pragma unroll
            for (int j = 0; j < 4; ++j) {
                const int tau = ri.t - 3 + j; float x[8];
                if (tau >= 0) { const u32x4 w = *(const u32x4*)(CX + (size_t)(row - ri.t + tau) * 2048 + c0);
                    x[0] = bflo(w.x); x[1] = bfhi(w.x); x[2] = bflo(w.y); x[3] = bfhi(w.y); x[4] = bflo(w.z); x[5] = bfhi(w.z); x[6] = bflo(w.w); x[7] = bfhi(w.w); }
                else if (!ri.prompt) { const float* sp = sconv + ((size_t)(l * SB + ri.b) * 3 + (3 + tau)) * 2048 + c0;
#pragma unroll
                    for (int e = 0; e < 8; ++e) x[e] = sp[e]; }
                else {
#pragma unroll
                    for (int e = 0; e < 8; ++e) x[e] = 0.f; }
#pragma unroll
                for (int e = 0; e < 8; ++e) a[e] += wj[j][e] * x[e];
            }
            float o[8];
#pragma unroll
            for (int e = 0; e < 8; ++e) o[e] = silu_f(a[e]);
            u32x4 w; w.x = pk2(o[0], o[1]); w.y = pk2(o[2], o[3]); w.z = pk2(o[4], o[5]); w.w = pk2(o[6], o[7]);
            if (tc >= 16) *(u32x4*)(XC + (size_t)row * 2048 + c0) = w;
            *(LAS u32x4*)(tile + rl * 72 + 8 * g8) = w;
        }
        WAVE_SYNC();
        if (tc < 24) {
#pragma unroll 2
        for (int rg = 0; rg < 8; ++rg) {
            unsigned short h[8];
#pragma unroll
            for (int k = 0; k < 8; ++k) h[k] = tile[(8 * rg + k) * 72 + lane];
            u32x4 w; w.x = h[0] | ((unsigned)h[1] << 16); w.y = h[2] | ((unsigned)h[3] << 16); w.z = h[4] | ((unsigned)h[5] << 16); w.w = h[6] | ((unsigned)h[7] << 16);
            *(u32x4*)(XCT + (size_t)(cbase + lane) * MPADT + rbase + 8 * rg) = w;
        }
        }
        if (tc < 24 && tr == M / 64 - 1) {
#pragma unroll 2
            for (int rg = 0; rg < 8; ++rg) *(u32x4*)(XCT + (size_t)(cbase + lane) * MPADT + M + 8 * rg) = (u32x4){0u, 0u, 0u, 0u};
        }
        WAVE_SYNC();
    }
}
struct CuInfo { int row0, Tv; bool prompt; int b; };
__device__ __forceinline__ CuInfo cu_info(int cu) { CuInfo c; c.prompt = cu < NB * NC; if (c.prompt) { c.b = cu / NC; c.row0 = c.b * T + (cu - c.b * NC) * 64; c.Tv = 64; } else { c.b = cu - NB * NC; c.row0 = MP + c.b * ST; c.Tv = ST; } return c; }
__device__ __forceinline__ void phase_c1(const Frame& F, int l) {
    PHASE_BASES();
    const float* DT = WSP(float, WS_DT); const bf16_t* XCT = WSP(bf16_t, WS_XCT); bf16_t* CS = WSP(bf16_t, WS_CS); float* CD = WSP(float, WS_CD);
    LAS float* wbuf = (LAS float*)(F.lds + F.wave * A1_WAVE_BYTES);
    const int r32 = lane & 31, hh = lane >> 5;
    for (int it = F.gw; it < NCU * 32; it += F.NGW) {
        const int pb = it & 1, h = (it >> 1) & 15, cu = it >> 5, g = h >> 2; const CuInfo ci = cu_info(cu);
        const float Aneg = -expf(GPT(IN_ALOG)[l * 16 + h]);
        const float dt = (lane < ci.Tv) ? DT[(size_t)(ci.row0 + lane) * 16 + h] : 0.f;
        u32x4 araw[4]; bf16x8 bfr[4][4];
#pragma unroll
        for (int ks = 0; ks < 4; ++ks) araw[ks] = *(const u32x4*)(XCT + (size_t)(h * 64 + 32 * pb + r32) * MPADT + ci.row0 + 16 * ks + 8 * hh);
#pragma unroll
        for (int nb = 0; nb < 4; ++nb)
#pragma unroll
            for (int ks = 0; ks < 4; ++ks) bfr[nb][ks] = *(const bf16x8*)(XCT + (size_t)(1024 + g * 128 + 32 * nb + r32) * MPADT + ci.row0 + 16 * ks + 8 * hh);
        const float acum = wave_incl_scan(dt * Aneg, lane), tot = __shfl(acum, 63);
        wbuf[lane] = dt * exp_f(tot - acum);
        if (pb == 0 && lane == 0) CD[cu * 16 + h] = exp_f(tot);
        WAVE_SYNC();
        bf16x8 af[4];
#pragma unroll
        for (int ks = 0; ks < 4; ++ks) {
            const u32x4 raw = araw[ks];
            const f32x4 w0 = *(const LAS f32x4*)(wbuf + 16 * ks + 8 * hh), w1 = *(const LAS f32x4*)(wbuf + 16 * ks + 8 * hh + 4);
            float v[8] = {bflo(raw.x) * w0[0], bfhi(raw.x) * w0[1], bflo(raw.y) * w0[2], bfhi(raw.y) * w0[3], bflo(raw.z) * w1[0], bfhi(raw.z) * w1[1], bflo(raw.w) * w1[2], bfhi(raw.w) * w1[3]};
            af[ks] = pack_bf16x8(v);
        }
        f32x16 acc[4];
#pragma unroll
        for (int nb = 0; nb < 4; ++nb) {
#pragma unroll
            for (int i = 0; i < 16; ++i) acc[nb][i] = 0.f;
#pragma unroll
            for (int ks = 0; ks < 4; ++ks) acc[nb] = MFMA32(af[ks], bfr[nb][ks], acc[nb]);
        }
        bf16_t* cs = CS + (size_t)(cu * 16 + h) * 8192;
#pragma unroll
        for (int nb = 0; nb < 4; ++nb)
#pragma unroll
            for (int i = 0; i < 16; ++i) cs[(32 * pb + (i & 3) + 8 * (i >> 2) + 4 * hh) * 128 + 32 * nb + r32] = (bf16_t)f2bf(acc[nb][i]);
        WAVE_SYNC();
    }
}
__device__ __forceinline__ void phase_c2(const Frame& F, int l) {
    PHASE_BASES();
    const bf16_t* CS = WSP(bf16_t, WS_CS); const float* CD = WSP(float, WS_CD); bf16_t* ENT = WSP(bf16_t, WS_ENT);
    constexpr int NEP = NB * 16 * 2048, NES = SB * 16 * 2048;
    for (int it = blockIdx.x * 512 + tidl; it < NEP + NES; it += F.G * 512) {
        const bool prompt = it < NEP; const int e = prompt ? it : it - NEP; const int q = e & 2047, h = (e >> 11) & 15, b = e >> 15;
        if (prompt) {
            f32x4 st = (f32x4){0.f, 0.f, 0.f, 0.f};
            constexpr int CB = (NC % 8 == 0) ? 8 : ((NC % 4 == 0) ? 4 : 1);
#pragma unroll 1
            for (int c0 = 0; c0 < NC; c0 += CB) {
                u32x2 cw[CB]; float cdv[CB];
#pragma unroll
                for (int k = 0; k < CB; ++k) { const size_t u = (size_t)((b * NC + c0 + k) * 16 + h); cw[k] = *(const u32x2*)(CS + u * 8192 + q * 4); cdv[k] = CD[u]; }
#pragma unroll
                for (int k = 0; k < CB; ++k) { const size_t u = (size_t)((b * NC + c0 + k) * 16 + h); const f32x4 cs = (f32x4){bflo(cw[k].x), bfhi(cw[k].x), bflo(cw[k].y), bfhi(cw[k].y)};
                    u32x2 w; w.x = pk2(st.x, st.y); w.y = pk2(st.z, st.w); *(u32x2*)(ENT + u * 8192 + q * 4) = w;
                    st = st * cdv[k] + cs; }
            }
            *(f32x4*)(outp + O_PSSM + (((size_t)l * NB + b) * 16 + h) * 8192 + q * 4) = st;
        } else {
            const size_t u = (size_t)((NB * NC + b) * 16 + h);
            f32x4 st = *(const f32x4*)(GPT(IN_SSM) + (((size_t)l * SB + b) * 16 + h) * 8192 + q * 4);
            u32x2 w; w.x = pk2(st.x, st.y); w.y = pk2(st.z, st.w); *(u32x2*)(ENT + u * 8192 + q * 4) = w;
            const u32x2 cw = *(const u32x2*)(CS + u * 8192 + q * 4); const f32x4 cs = (f32x4){bflo(cw.x), bfhi(cw.x), bflo(cw.y), bfhi(cw.y)};
            st = st * CD[u] + cs;
            *(f32x4*)(outp + O_SSSM + (((size_t)l * SB + b) * 16 + h) * 8192 + q * 4) = st;
        }
    }
}
__device__ __forceinline__ void phase_c3(const Frame& F, int l) {
    PHASE_BASES();
    const float* DT = WSP(float, WS_DT); const bf16_t* XC = WSP(bf16_t, WS_XC); const bf16_t* XCT = WSP(bf16_t, WS_XCT); const bf16_t* ENT = WSP(bf16_t, WS_ENT); bf16_t* YC = WSP(bf16_t, WS_YC);
    LAS float* abuf = (LAS float*)(F.lds + F.wave * A1_WAVE_BYTES);
    LAS float* dbuf = abuf + 64;
    const int r32 = lane & 31, hh = lane >> 5;
    for (int it = F.gw; it < NCU * 32; it += F.NGW) {
        const int tb = it & 1, h = (it >> 1) & 15, cu = it >> 5, g = h >> 2; const CuInfo ci = cu_info(cu);
        if (32 * tb >= ci.Tv) continue;
        const float Aneg = -expf(GPT(IN_ALOG)[l * 16 + h]), Dk = GPT(IN_CD)[l * 16 + h];
        const float dt = (lane < ci.Tv) ? DT[(size_t)(ci.row0 + lane) * 16 + h] : 0.f;
        bf16x8 cmf[8], entf[2][8];
#pragma unroll
        for (int ks = 0; ks < 8; ++ks) cmf[ks] = *(const bf16x8*)(XC + (size_t)(ci.row0 + 32 * tb + r32) * 2048 + 1536 + g * 128 + 16 * ks + 8 * hh);
#pragma unroll
        for (int pb = 0; pb < 2; ++pb)
#pragma unroll
            for (int ks = 0; ks < 8; ++ks) entf[pb][ks] = *(const bf16x8*)(ENT + ((size_t)(cu * 16 + h) * 64 + 32 * pb + r32) * 128 + 16 * ks + 8 * hh);
        const float acum = wave_incl_scan(dt * Aneg, lane);
        abuf[lane] = acum; dbuf[lane] = dt;
        const float acum_t = __shfl(acum, 32 * tb + r32);
        WAVE_SYNC();
        f32x16 y[2];
#pragma unroll
        for (int pb = 0; pb < 2; ++pb)
#pragma unroll
            for (int i = 0; i < 16; ++i) y[pb][i] = 0.f;
        for (int sb = 0; sb <= tb; ++sb) {
            f32x16 ga;
#pragma unroll
            for (int i = 0; i < 16; ++i) ga[i] = 0.f;
#pragma unroll
            for (int ks = 0; ks < 8; ++ks) { const bf16x8 bmf = *(const bf16x8*)(XC + (size_t)(ci.row0 + 32 * sb + r32) * 2048 + 1024 + g * 128 + 16 * ks + 8 * hh); ga = MFMA32(bmf, cmf[ks], ga); }
            const int tt = 32 * tb + r32;
#pragma unroll
            for (int q = 0; q < 4; ++q) {
                const f32x4 as = *(const LAS f32x4*)(abuf + 32 * sb + 8 * q + 4 * hh), ds = *(const LAS f32x4*)(dbuf + 32 * sb + 8 * q + 4 * hh);
#pragma unroll
                for (int e = 0; e < 4; ++e) { const int ss = 32 * sb + 8 * q + 4 * hh + e; ga[4 * q + e] = (ss <= tt) ? ga[4 * q + e] * exp_f(acum_t - as[e]) * ds[e] : 0.f; }
            }
#pragma unroll
            for (int ks2 = 0; ks2 < 2; ++ks2) {
                float pv[8];
#pragma unroll
                for (int j = 0; j < 8; ++j) pv[j] = ga[8 * ks2 + j];
                const bf16x8 pa = pack_bf16x8(pv);
#pragma unroll
                for (int pb = 0; pb < 2; ++pb) {
                    const bf16_t* xp = XCT + (size_t)(h * 64 + 32 * pb + r32) * MPADT + ci.row0 + 32 * sb + 16 * ks2 + 4 * hh;
                    const u32x2 x0 = *(const u32x2*)xp, x1 = *(const u32x2*)(xp + 8);
                    const u32x4 xw = (u32x4){x0.x, x0.y, x1.x, x1.y};
                    y[pb] = MFMA32(pa, __builtin_bit_cast(bf16x8, xw), y[pb]);
                }
            }
        }
        float ea[16];
#pragma unroll
        for (int q = 0; q < 4; ++q) { const f32x4 at = *(const LAS f32x4*)(abuf + 32 * tb + 8 * q + 4 * hh);
#pragma unroll
            for (int e = 0; e < 4; ++e) ea[4 * q + e] = exp_f(at[e]); }
#pragma unroll
        for (int pb = 0; pb < 2; ++pb) {
            f32x16 yo;
#pragma unroll
            for (int i = 0; i < 16; ++i) yo[i] = 0.f;
#pragma unroll
            for (int ks = 0; ks < 8; ++ks) yo = MFMA32(cmf[ks], entf[pb][ks], yo);
            const bf16_t* xp = XCT + (size_t)(h * 64 + 32 * pb + r32) * MPADT + ci.row0 + 32 * tb + 4 * hh;
#pragma unroll
            for (int q = 0; q < 4; ++q) { const u32x2 xw = *(const u32x2*)(xp + 8 * q); const float xs[4] = {bflo(xw.x), bfhi(xw.x), bflo(xw.y), bfhi(xw.y)};
#pragma unroll
                for (int e = 0; e < 4; ++e) { const int i = 4 * q + e; const float val = y[pb][i] + ea[i] * yo[i] + Dk * xs[e]; const int tl = 32 * tb + 8 * q + 4 * hh + e;
                    if (tl < ci.Tv) YC[(size_t)(ci.row0 + tl) * 1024 + h * 64 + 32 * pb + r32] = (bf16_t)f2bf(val); } }
        }
        WAVE_SYNC();
    }
}
__device__ __forceinline__ void phase_gn(const Frame& F, int l) {
    PHASE_BASES();
    const bf16_t* YC = WSP(bf16_t, WS_YC); const bf16_t* CZ = WSP(bf16_t, WS_CZ); bf16_t* MIX = WSP(bf16_t, WS_MIX); const float* cng = GPT(IN_CNG) + l * 1024;
    f32x4 ng[4];
#pragma unroll
    for (int g = 0; g < 4; ++g) ng[g] = *(const f32x4*)(cng + g * 256 + 4 * lane);
    u32x2 yw[4], zw[4], ywn[4], zwn[4];
#define GN_LOAD(Y_, Z_, row_) do { _Pragma("unroll") for (int g = 0; g < 4; ++g) { Y_[g] = *(const u32x2*)(YC + (size_t)(row_) * 1024 + g * 256 + 4 * lane); Z_[g] = *(const u32x2*)(CZ + (size_t)(row_) * 1024 + g * 256 + 4 * lane); } } while (0)
    if (F.gw < M) GN_LOAD(yw, zw, F.gw);
    for (int row = F.gw; row < M; row += F.NGW) {
        { const int rn = (row + F.NGW < M) ? row + F.NGW : row; GN_LOAD(ywn, zwn, rn); }
        float v[4][4], ss[4];
#pragma unroll
        for (int g = 0; g < 4; ++g) { v[g][0] = bflo(yw[g].x) * silu_f(bflo(zw[g].x)); v[g][1] = bfhi(yw[g].x) * silu_f(bfhi(zw[g].x)); v[g][2] = bflo(yw[g].y) * silu_f(bflo(zw[g].y)); v[g][3] = bfhi(yw[g].y) * silu_f(bfhi(zw[g].y));
            ss[g] = (v[g][0] * v[g][0] + v[g][1] * v[g][1]) + (v[g][2] * v[g][2] + v[g][3] * v[g][3]); }
#pragma unroll
        for (int o = 1; o < 64; o <<= 1) {
#pragma unroll
            for (int g = 0; g < 4; ++g) ss[g] += __shfl_xor(ss[g], o); }
#pragma unroll
        for (int g = 0; g < 4; ++g) { const float rn = FAST_RSQ(ss[g] * (1.0f / 256.0f) + EPSN);
            u32x2 o; o.x = pk2(v[g][0] * rn * ng[g].x, v[g][1] * rn * ng[g].y); o.y = pk2(v[g][2] * rn * ng[g].z, v[g][3] * rn * ng[g].w);
            *(u32x2*)(MIX + (size_t)row * 2048 + 1024 + g * 256 + 4 * lane) = o; }
#pragma unroll
        for (int g = 0; g < 4; ++g) { yw[g] = ywn[g]; zw[g] = zwn[g]; }
    }
}

#ifndef PHMASK
#define PHMASK 0xFFFFFFFFu
#endif
#ifndef PROBE_DUP
#define PROBE_DUP 0u
#endif
#define DUP(j) ((PROBE_DUP >> (j)) & 1u)
__global__ void __launch_bounds__(512, 2) mega(Args args) {
    DYN_LDS(lds);
    Frame F;
    F.lds = (LAS unsigned char*)lds;
    F.tid = threadIdx.x; F.lane = F.tid & 63;
#ifdef HOST_EMU
    F.wave = F.tid >> 6;
#else
    F.wave = __builtin_amdgcn_readfirstlane(F.tid >> 6);
#endif
    F.G = gridDim.x; F.gw = blockIdx.x * 8 + F.wave; F.NGW = F.G * 8;
    F.out = args.out; F.ws = args.ws;
#ifndef HOST_EMU
    volatile LAS unsigned* MISC = (volatile LAS unsigned*)(F.lds + MISC_OFF);
    if (F.tid < 64) MISC[F.tid] = 0u;
    __syncthreads();
    XcdBarrier bar = xcd_barrier_post((unsigned*)(args.ws + WS_CTL) + CW_BAR, MISC + 8);
#define GRID_BAR() xcd_barrier(bar)
#else
#define GRID_BAR() do { } while (0)
#endif
    const int lo = args.ph_lo, hi = args.ph_hi;
#define IN(k) (lo <= (k) && (k) < hi)
#define SEAM(k) do { if (IN(k) && IN((k) + 1)) GRID_BAR(); } while (0)
#define PHON(j) ((PHMASK >> (j)) & 1u)
    if (IN(0) && PHON(31)) { phase_prologue(F, args); if (DUP(31)) { GRID_BAR(); phase_prologue(F, args); } }
    SEAM(0);
    for (int l = 0; l < NL; ++l) {
        const int pb = 1 + l * PH_PER_LAYER;
        if (IN(pb + PH_G1) && PHON(PH_G1)) {
            PHASE_BASES();
            pg8::Gemm g{WSP(bf16_t, WS_XB), WSP(bf16_t, WS_WIN) + (size_t)l * NIN * D, M, NIN, D, D}; pg8::StaticOrder S; S.init(M, NIN, F.G, (int)blockIdx.x);
            EpiIn E{l, ws, outp};
            pg8::gemm_phase<EpiIn, pg8::StaticOrder, true, true>(F.lds, g, S, E);
            if (DUP(PH_G1)) { GRID_BAR(); pg8::gemm_phase<EpiIn, pg8::StaticOrder, true, true>(F.lds, g, S, E); }
        }
        SEAM(pb + PH_G1);
        if (IN(pb + PH_CONV) && PHON(PH_CONV)) { phase_conv(F, l); if (DUP(PH_CONV)) { GRID_BAR(); phase_conv(F, l); } }
        if (IN(pb + PH_A1) && PHON(PH_A1)) { phase_a1(F, l); if (DUP(PH_A1)) { GRID_BAR(); phase_a1(F, l, 2); } }
        SEAM(pb + PH_CONV);
        if (IN(pb + PH_B) && PHON(PH_B)) { phase_b(F, l); if (DUP(PH_B)) { GRID_BAR(); phase_b(F, l); } }
        if (IN(pb + PH_C1) && PHON(PH_C1)) { phase_c1(F, l); if (DUP(PH_C1)) { GRID_BAR(); phase_c1(F, l); } }
        if (IN(pb + PH_A2) && PHON(PH_A2)) { phase_a2(F, l); if (DUP(PH_A2)) { GRID_BAR(); phase_a2(F, l, 2); } }
        SEAM(pb + PH_C1);
        if (IN(pb + PH_C2) && PHON(PH_C2)) { phase_c2(F, l); if (DUP(PH_C2)) { GRID_BAR(); phase_c2(F, l); } }
        SEAM(pb + PH_C2);
        if (IN(pb + PH_C3) && PHON(PH_C3)) { phase_c3(F, l); if (DUP(PH_C3)) { GRID_BAR(); phase_c3(F, l); } }
        SEAM(pb + PH_C3);
        if (IN(pb + PH_GN) && PHON(PH_GN)) { phase_gn(F, l); if (DUP(PH_GN)) { GRID_BAR(); phase_gn(F, l); } }
        SEAM(pb + PH_GN);
        if (IN(pb + PH_G2) && PHON(PH_G2)) {
            PHASE_BASES();
            { pg8::Gemm g{WSP(bf16_t, WS_MIX), WSP(bf16_t, WS_WOUT) + (size_t)l * D * D, MP, D, D, D}; pg8::StaticOrder S; S.init(MP, D, F.G, (int)blockIdx.x);
              EpiOut E{outp + O_Y, ws, l};
              pg8::gemm_phase<EpiOut, pg8::StaticOrder, true, true>(F.lds, g, S, E); }
            { pg8::Gemm g{WSP(bf16_t, WS_MIX), WSP(bf16_t, WS_WOUT) + (size_t)l * D * D, M, D, D, D / NSL2}; pg8::TailOrder S; S.init(MP / 256, MS / 256, D, NSL2, D / NSL2, F.G, (int)blockIdx.x);
              EpiTail E{WSP(float, WS_PART), (D / NSL2) * 2};
              pg8::gemm_phase<EpiTail, pg8::TailOrder, true, true>(F.lds, g, S, E); }
        }
        SEAM(pb + PH_G2);
        if (IN(pb + PH_F2) && PHON(PH_F2)) phase_fin(F, 2 * l + 1, NSL2, true);
        SEAM(pb + PH_F2);
        if (IN(pb + PH_G3) && PHON(PH_G3)) {
            PHASE_BASES();
            pg8::Gemm g{WSP(bf16_t, WS_XB), WSP(bf16_t, WS_WGU) + (size_t)l * NGU * D, M, NGU, D, D}; pg8::StaticOrder S; S.init(M, NGU, F.G, (int)blockIdx.x);
            EpiGU E{ws, l};
            pg8::gemm_phase<EpiGU, pg8::StaticOrder, true, true>(F.lds, g, S, E);
            if (DUP(PH_G3)) { GRID_BAR(); pg8::gemm_phase<EpiGU, pg8::StaticOrder, true, true>(F.lds, g, S, E); }
        }
        SEAM(pb + PH_G3);
        if (IN(pb + PH_G4) && PHON(PH_G4)) {
            PHASE_BASES();
            { pg8::Gemm g{WSP(bf16_t, WS_HMID), WSP(bf16_t, WS_WDN) + (size_t)l * D * DFF, MP, D, DFF, DFF}; pg8::StaticOrder S; S.init(MP, D, F.G, (int)blockIdx.x);
              EpiDown E{outp + O_Y, ws, l};
              pg8::gemm_phase<EpiDown, pg8::StaticOrder, true, true>(F.lds, g, S, E); }
            { pg8::Gemm g{WSP(bf16_t, WS_HMID), WSP(bf16_t, WS_WDN) + (size_t)l * D * DFF, M, D, DFF, DFF / NSL4}; pg8::TailOrder S; S.init(MP / 256, MS / 256, D, NSL4, DFF / NSL4, F.G, (int)blockIdx.x);
              EpiTail E{WSP(float, WS_PART), (DFF / NSL4) * 2};
              pg8::gemm_phase<EpiTail, pg8::TailOrder, true, true>(F.lds, g, S, E); }
        }
        SEAM(pb + PH_G4);
        if (IN(pb + PH_F4) && PHON(PH_F4)) phase_fin(F, 2 * l + 2, NSL4, l + 1 < NL);
        SEAM(pb + PH_F4);
    }
#undef IN
#undef SEAM
}

#ifndef HOST_EMU
extern "C" void kernel_launch(void* const* d_in, const int* in_sizes, int n_in, void* d_out, int out_size, void* d_ws, size_t ws_size, hipStream_t stream) {
    static int grid = 0;
    if (grid == 0) {
        if (n_in != 27 || (size_t)out_size != O_END || ws_size < WS_END) { fprintf(stderr, "kernel_launch: unexpected sizes (n_in %d, out %d, ws %zu; need %zu / %zu)\n", n_in, out_size, ws_size, (size_t)O_END, (size_t)WS_END); grid = -1; return; }
        int dev = 0, cus = 0, per_cu = 0;
        if (hipGetDevice(&dev) != hipSuccess || hipDeviceGetAttribute(&cus, hipDeviceAttributeMultiprocessorCount, dev) != hipSuccess) { grid = -1; return; }
        if (hipFuncSetAttribute((const void*)mega, hipFuncAttributeMaxDynamicSharedMemorySize, LDS_BYTES) != hipSuccess) { fprintf(stderr, "kernel_launch: hipFuncSetAttribute failed\n"); grid = -1; return; }
        if (hipOccupancyMaxActiveBlocksPerMultiprocessor(&per_cu, (const void*)mega, 512, LDS_BYTES) != hipSuccess || per_cu < 1) fprintf(stderr, "kernel_launch: occupancy query reports %d\n", per_cu);
        (void)hipGetLastError();
        grid = cus;
    }
    if (grid < 0) return;
    if (hipMemsetAsync((char*)d_ws + WS_CTL, 0, CTL_ZERO_BYTES, stream) != hipSuccess) return;
    Args a{};
    for (int i = 0; i < 27; ++i) a.in[i] = (const float*)d_in[i];
    a.out = (float*)d_out; a.ws = (unsigned char*)d_ws;
#if ONE_LAUNCH
    a.ph_lo = 0; a.ph_hi = NPH;
    hipLaunchKernelGGL(mega, dim3(grid), dim3(512), LDS_BYTES, stream, a);
#else
    for (int ph = 0; ph < NPH; ++ph) { a.ph_lo = ph; a.ph_hi = ph + 1; hipLaunchKernelGGL(mega, dim3(grid), dim3(512), LDS_BYTES, stream, a); }
#endif
}
#endif
```
